# Optimizing an MI355X kernel written in HIP

```python
import jax
import jax.numpy as jnp
from jax import lax
import numpy as np

D_MODEL = 1024
BATCH = 16
SEQ = 4096
DEPTH = 1

ATTN_WIDTH = D_MODEL // 2
ATTN_HEADS = 8
HEAD_DIM = ATTN_WIDTH // ATTN_HEADS
DILATED_BRANCHES = ((128, 1), (512, 4), (2048, 16))
ATTN_BLOCK = 128
SGU_WIDTH = D_MODEL - ATTN_WIDTH
SGU_GROUPS = 4
SGU_GROUP_DIM = SGU_WIDTH // SGU_GROUPS
CHUNK = 128
MIX_WIDTH = ATTN_WIDTH + SGU_WIDTH
IN_PROJ_WIDTH = 3 * ATTN_WIDTH + 2 * SGU_WIDTH
N_EXPERTS = 256
TOP_K = 8
N_EXPERT_GROUPS = 8
TOPK_GROUPS = 4
EXPERT_DIM = D_MODEL // 4
SHARED_DIM = EXPERT_DIM
ROUTED_SCALE = 2.5
EXPERT_BLOCK = 128
EPS = 1e-6

kernel_name = 'hybrid_dilated_attn_sgu_moe_adaln'


def _rmsnorm(x, g):
    xf = x.astype(jnp.float32)
    y = xf * lax.rsqrt(jnp.mean(xf * xf, axis=-1, keepdims=True) + EPS)
    return (y * g.astype(jnp.float32)).astype(x.dtype)


def _layernorm(x, g, b):
    xf = x.astype(jnp.float32)
    mu = jnp.mean(xf, axis=-1, keepdims=True)
    var = jnp.mean(jnp.square(xf - mu), axis=-1, keepdims=True)
    y = (xf - mu) * lax.rsqrt(var + EPS) * g.astype(jnp.float32) + b.astype(jnp.float32)
    return y.astype(x.dtype)


def _modulate(n, shift, scale):
    return n * (1 + scale[:, None, :]) + shift[:, None, :]


def _alibi_slopes():
    return jnp.exp2(-8.0 * jnp.arange(1, ATTN_HEADS + 1, dtype=jnp.float32) / ATTN_HEADS)


def _strided_window_branch(q, k, v, window, dil, slopes):
    B, S, H, Dh = q.shape
    steps = window // dil
    L = S // dil
    nb = -(-L // ATTN_BLOCK)
    Lp = nb * ATTN_BLOCK

    def to_classes(a):
        a = a.astype(jnp.float32).reshape(B, L, dil, H, Dh).transpose(0, 2, 3, 1, 4)
        a = jnp.pad(a, ((0, 0), (0, 0), (0, 0), (0, Lp - L), (0, 0)))
        return a.reshape(B, dil, H, nb, ATTN_BLOCK, Dh)

    def with_prev(a):
        prev = jnp.pad(a, ((0, 0), (0, 0), (0, 0), (1, 0), (0, 0), (0, 0)))[:, :, :, :-1]
        return jnp.concatenate([prev, a], axis=4)

    qb = to_classes(q)
    kc = with_prev(to_classes(k))
    vc = with_prev(to_classes(v))
    s = jnp.einsum('brhnqd,brhnkd->brhnqk', qb, kc) * (HEAD_DIM ** -0.5)
    back = ATTN_BLOCK + jnp.arange(ATTN_BLOCK)[:, None] - jnp.arange(2 * ATTN_BLOCK)[None, :]
    valid = (back >= 0) & (back <= steps)
    not_before_start = (jnp.arange(nb)[:, None, None] > 0) | (jnp.arange(2 * ATTN_BLOCK)[None, None, :] >= ATTN_BLOCK)
    mask = valid[None] & not_before_start
    bias = -slopes[:, None, None, None] * (back * dil).astype(jnp.float32)
    s = jnp.where(mask, s + bias, -jnp.inf)
    m = jnp.max(s, axis=-1, keepdims=True)
    p = jnp.exp(s - m)
    denom = jnp.sum(p, axis=-1, keepdims=True)
    o = jnp.einsum('brhnqk,brhnkd->brhnqd', p, vc) / denom
    lse = (m + jnp.log(denom))[..., 0]
    o = o.reshape(B, dil, H, Lp, Dh)[:, :, :, :L].transpose(0, 3, 1, 2, 4).reshape(B, S, H, Dh)
    lse = lse.reshape(B, dil, H, Lp)[:, :, :, :L].transpose(0, 3, 1, 2).reshape(B, S, H)
    return o, lse


def _dilated_attention(q, k, v):
    slopes = _alibi_slopes()
    outs, lses = [], []
    for window, dil in DILATED_BRANCHES:
        o, lse = _strided_window_branch(q, k, v, window, dil, slopes)
        outs.append(o)
        lses.append(lse)
    w = jax.nn.softmax(jnp.stack(lses, axis=0), axis=0)
    return jnp.einsum('kbsh,kbshd->bshd', w, jnp.stack(outs, axis=0))


def _spatial_gating(u, z, ln_g, ln_b, w_s, b_s):
    B, S, _ = u.shape
    u = jax.nn.gelu(u)
    z = _layernorm(jax.nn.gelu(z), ln_g, ln_b)
    zc = z.reshape(B, S // CHUNK, CHUNK, SGU_GROUPS, SGU_GROUP_DIM)
    causal = jnp.tril(jnp.ones((CHUNK, CHUNK), dtype=w_s.dtype))
    mixed = jnp.einsum('gts,bcsgd->bctgd', w_s * causal, zc) + b_s.T[None, None, :, :, None]
    return u * mixed.reshape(B, S, SGU_WIDTH)


def _hybrid_mixer(n, w_in, sgu_ln_gain, sgu_ln_bias, w_spatial, b_spatial, g_out_attn, g_out_sgu, w_out):
    B, S, _ = n.shape
    proj = jnp.einsum('bsd,de->bse', n, w_in)
    q, k, v, u, z = jnp.split(
        proj, [ATTN_WIDTH, 2 * ATTN_WIDTH, 3 * ATTN_WIDTH, 3 * ATTN_WIDTH + SGU_WIDTH], axis=-1)
    heads = lambda a: a.reshape(B, S, ATTN_HEADS, HEAD_DIM)
    attn = _dilated_attention(heads(q), heads(k), heads(v)).reshape(B, S, ATTN_WIDTH).astype(n.dtype)
    sgu = _spatial_gating(u, z, sgu_ln_gain, sgu_ln_bias, w_spatial, b_spatial)
    mixed = jnp.concatenate([_rmsnorm(attn, g_out_attn), _rmsnorm(sgu, g_out_sgu)], axis=-1)
    return jnp.einsum('bse,ed->bsd', mixed, w_out)


def _swiglu(x, wg, wu, wd):
    return (jax.nn.silu(x @ wg) * (x @ wu)) @ wd


def _route(xf, w_router, b_router):
    N = xf.shape[0]
    scores = jax.nn.sigmoid((xf @ w_router).astype(jnp.float32))
    choice = scores + b_router.astype(jnp.float32)
    per_group = N_EXPERTS // N_EXPERT_GROUPS
    gscore = jnp.sum(lax.top_k(choice.reshape(N, N_EXPERT_GROUPS, per_group), 2)[0], axis=-1)
    kth = lax.top_k(gscore, TOPK_GROUPS)[0][:, -1:]
    keep = jnp.repeat(gscore >= kth, per_group, axis=-1)
    _, idx = lax.top_k(jnp.where(keep, choice, -jnp.inf), TOP_K)
    sel = jnp.take_along_axis(scores, idx, axis=-1)
    gates = sel / jnp.sum(sel, axis=-1, keepdims=True) * ROUTED_SCALE
    return idx, gates


def _routed_experts(xf, idx, gates, w_gate, w_up, w_down):
    N, D = xf.shape
    A = N * TOP_K
    n_blocks = (A + N_EXPERTS * (EXPERT_BLOCK - 1) + EXPERT_BLOCK - 1) // EXPERT_BLOCK
    P = n_blocks * EXPERT_BLOCK
    flat_e = idx.reshape(A).astype(jnp.int32)
    flat_tok = jnp.arange(A, dtype=jnp.int32) // TOP_K
    flat_g = gates.reshape(A).astype(xf.dtype)
    order = jnp.argsort(flat_e)
    e_sorted = flat_e[order]
    counts = jnp.zeros((N_EXPERTS,), jnp.int32).at[flat_e].add(1)
    starts = jnp.cumsum(counts) - counts
    padded = (counts + EXPERT_BLOCK - 1) // EXPERT_BLOCK * EXPERT_BLOCK
    pends = jnp.cumsum(padded)
    pstarts = pends - padded
    dest = pstarts[e_sorted] + jnp.arange(A, dtype=jnp.int32) - starts[e_sorted]
    row_tok = jnp.zeros((P,), jnp.int32).at[dest].set(flat_tok[order])
    row_gate = jnp.zeros((P,), xf.dtype).at[dest].set(flat_g[order])
    block_start = jnp.arange(n_blocks, dtype=jnp.int32) * EXPERT_BLOCK
    block_e = jnp.minimum(jnp.searchsorted(pends, block_start, side='right'), N_EXPERTS - 1).astype(jnp.int32)

    def body(y, blk):
        tok, g, e = blk
        xt = xf[tok]
        out = _swiglu(xt, w_gate[e], w_up[e], w_down[e]) * g[:, None]
        return y.at[tok].add(out.astype(y.dtype)), None

    y0 = jnp.zeros((N, D), xf.dtype)
    y, _ = lax.scan(body, y0, (row_tok.reshape(n_blocks, EXPERT_BLOCK),
                               row_gate.reshape(n_blocks, EXPERT_BLOCK), block_e))
    return y


def _moe_ffn(n, w_router, b_router, w_exp_gate, w_exp_up, w_exp_down, w_sh_gate, w_sh_up, w_sh_down):
    B, S, D = n.shape
    xf = n.reshape(B * S, D)
    idx, gates = _route(xf, w_router, b_router)
    routed = _routed_experts(xf, idx, gates, w_exp_gate, w_exp_up, w_exp_down)
    shared = _swiglu(xf, w_sh_gate, w_sh_up, w_sh_down)
    return (routed + shared).reshape(B, S, D)


def setup_inputs(seed: int = 0) -> dict:
    key = jax.random.key(seed)
    ks = jax.random.split(key, 23)
    f32 = jnp.float32
    nrm = lambda k, shape, s: jax.random.normal(k, shape, f32) * s
    L = DEPTH
    return {
        'x': nrm(ks[0], (BATCH, SEQ, D_MODEL), 1.0),
        'c': nrm(ks[1], (BATCH, D_MODEL), 1.0),
        'w_ada': nrm(ks[2], (L, D_MODEL, 6 * D_MODEL), 0.5 * D_MODEL ** -0.5),
        'b_ada': nrm(ks[3], (L, 6 * D_MODEL), 0.02),
        'g_norm_mix': 1.0 + nrm(ks[4], (L, D_MODEL), 0.02),
        'w_in': nrm(ks[5], (L, D_MODEL, IN_PROJ_WIDTH), D_MODEL ** -0.5),
        'sgu_ln_gain': 1.0 + nrm(ks[6], (L, SGU_WIDTH), 0.02),
        'sgu_ln_bias': nrm(ks[7], (L, SGU_WIDTH), 0.02),
        'w_spatial': nrm(ks[8], (L, SGU_GROUPS, CHUNK, CHUNK), CHUNK ** -0.5),
        'b_spatial': 1.0 + nrm(ks[9], (L, SGU_GROUPS, CHUNK), 0.02),
        'g_out_attn': 1.0 + nrm(ks[10], (L, ATTN_WIDTH), 0.02),
        'g_out_sgu': 1.0 + nrm(ks[11], (L, SGU_WIDTH), 0.02),
        'w_out': nrm(ks[12], (L, MIX_WIDTH, D_MODEL), MIX_WIDTH ** -0.5),
        'g_norm_ffn': 1.0 + nrm(ks[13], (L, D_MODEL), 0.02),
        'w_router': nrm(ks[14], (L, D_MODEL, N_EXPERTS), D_MODEL ** -0.5),
        'b_router': nrm(ks[15], (L, N_EXPERTS), 0.01),
        'w_exp_gate': nrm(ks[16], (L, N_EXPERTS, D_MODEL, EXPERT_DIM), D_MODEL ** -0.5),
        'w_exp_up': nrm(ks[17], (L, N_EXPERTS, D_MODEL, EXPERT_DIM), D_MODEL ** -0.5),
        'w_exp_down': nrm(ks[18], (L, N_EXPERTS, EXPERT_DIM, D_MODEL), EXPERT_DIM ** -0.5),
        'w_sh_gate': nrm(ks[19], (L, D_MODEL, SHARED_DIM), D_MODEL ** -0.5),
        'w_sh_up': nrm(ks[20], (L, D_MODEL, SHARED_DIM), D_MODEL ** -0.5),
        'w_sh_down': nrm(ks[21], (L, SHARED_DIM, D_MODEL), SHARED_DIM ** -0.5),
        'g_final': 1.0 + nrm(ks[22], (D_MODEL,), 0.02),
    }


def reference(x, c, w_ada, b_ada, g_norm_mix, w_in, sgu_ln_gain, sgu_ln_bias, w_spatial, b_spatial,
              g_out_attn, g_out_sgu, w_out, g_norm_ffn, w_router, b_router, w_exp_gate, w_exp_up,
              w_exp_down, w_sh_gate, w_sh_up, w_sh_down, g_final):
    h = x
    cond = jax.nn.silu(c)
    for l in range(DEPTH):
        mod = cond @ w_ada[l] + b_ada[l]
        sh1, sc1, gt1, sh2, sc2, gt2 = jnp.split(mod, 6, axis=-1)
        n = _modulate(_rmsnorm(h, g_norm_mix[l]), sh1, sc1)
        mix = _hybrid_mixer(n, w_in[l], sgu_ln_gain[l], sgu_ln_bias[l], w_spatial[l], b_spatial[l],
                            g_out_attn[l], g_out_sgu[l], w_out[l])
        h = h + gt1[:, None, :] * mix
        n = _modulate(_rmsnorm(h, g_norm_ffn[l]), sh2, sc2)
        ffn = _moe_ffn(n, w_router[l], b_router[l], w_exp_gate[l], w_exp_up[l], w_exp_down[l],
                       w_sh_gate[l], w_sh_up[l], w_sh_down[l])
        h = h + gt2[:, None, :] * ffn
    return _rmsnorm(h, g_final)
```

```cpp
#include <hip/hip_runtime.h>
#include <cstdio>
#include <cstdint>

#ifndef MK_MULTI
#define MK_MULTI 0
#endif

#define GAS __attribute__((address_space(1)))
#define LAS __attribute__((address_space(3)))
#define CAS __attribute__((address_space(4)))
typedef unsigned short bf16_t;
typedef short bf16x8 __attribute__((ext_vector_type(8)));
typedef short s16x4 __attribute__((ext_vector_type(4)));
typedef float f32x4 __attribute__((ext_vector_type(4)));
typedef unsigned u32x4 __attribute__((ext_vector_type(4)));
typedef unsigned u32x2 __attribute__((ext_vector_type(2)));
typedef int i32x4 __attribute__((ext_vector_type(4)));
typedef int i32x8 __attribute__((ext_vector_type(8)));

constexpr int D = 1024, NBATCH = 16, SEQ = 4096, NTOK = NBATCH * SEQ;
constexpr int NPROJ = 2560;
constexpr int NE = 256, TOPK = 8, EDIM = 256;
constexpr int NCH = 2, CHT = NTOK / NCH;
constexpr int CH_ROUTED = CHT * TOPK;
constexpr int CH_ROWS = CH_ROUTED + CHT;
constexpr int MAXTILES = CH_ROUTED / 256 + NE + CHT / 256;
constexpr float W1_PRE = 64.f, W2_PRE = 8.f, ACT_PRE = 4.f;
constexpr int E8M0_ONE = 127;
constexpr int SC_W1 = (E8M0_ONE - 6) * 0x01010101, SC_W2 = (E8M0_ONE - 3) * 0x01010101, SC_ACT = (E8M0_ONE - 2) * 0x01010101, SC_N2 = E8M0_ONE * 0x01010101;
constexpr float YSCALE = 8.f;
constexpr float EPS = 1e-6f;
constexpr float LOG2E = 1.4426950408889634f;

constexpr size_t WS_CTL = 0, CTL_BYTES = 65536;
constexpr size_t CTL_CNT = 16384;
constexpr size_t WS_MOD = 65536;
constexpr size_t WS_WSP = WS_MOD + 393216;
constexpr size_t WS_TILE = WS_WSP + 131072;
constexpr size_t TILE_TAB = (size_t)NCH * MAXTILES * 4;
constexpr size_t WS_OFFS = WS_TILE + 3 * TILE_TAB + 256;
constexpr size_t WS_WTIN = 1048576;
constexpr size_t WS_WTOUT = WS_WTIN + 5242880;
constexpr size_t WS_WTR = WS_WTOUT + 2097152;
constexpr size_t WS_TOPK_E = 9437184;
constexpr size_t WS_TOPK_G = WS_TOPK_E + 2097152;
constexpr size_t WS_TOPK_P = WS_TOPK_G + 2097152;
constexpr size_t WS_ROWTOK = WS_TOPK_P + 2097152;
constexpr size_t WS_W1T = WS_ROWTOK + 2097152;
constexpr size_t WS_W2T = WS_W1T + (size_t)257 * 524288;
constexpr size_t WS_A = WS_W2T + (size_t)257 * 262144;
constexpr size_t WS_B = WS_A + (size_t)NTOK * D * 2;
constexpr size_t WS_ACT = WS_B + (size_t)NTOK * NPROJ * 2;
constexpr size_t WS_LSE = WS_ACT;
constexpr size_t WS_H1 = WS_ACT + (size_t)(CH_ROWS + 256) * EDIM;
constexpr size_t WS_N2F8 = WS_H1 + (size_t)(NTOK / 2) * D * 2;
constexpr size_t WS_END = WS_N2F8 + (size_t)NTOK * D;
static_assert((size_t)(CH_ROWS + 256) * EDIM >= (size_t)3 * NTOK * 8 * 4, "lse fits the act region");
static_assert(WS_OFFS + 4096 <= WS_WTIN && WS_WTR + 524288 <= WS_TOPK_E && (WS_W1T % 256) == 0, "ws map");
static_assert((size_t)CH_ROWS * D <= (size_t)NTOK * NPROJ * 2, "Y chunk (fp8) fits region B");
static_assert(WS_END <= 1118000000ull, "workspace");

constexpr int LDS_BYTES = 155648;
constexpr int MISC_OFF = 153600;
constexpr int NTHR = 512;

__device__ __forceinline__ unsigned cvt_pk_bf16(float lo, float hi) { unsigned r; asm("v_cvt_pk_bf16_f32 %0, %1, %2" : "=v"(r) : "v"(lo), "v"(hi)); return r; }
__device__ __forceinline__ float bf2f(unsigned short b) { return __builtin_bit_cast(float, (unsigned)b << 16); }
__device__ __forceinline__ float bflo(unsigned w) { return __builtin_bit_cast(float, w << 16); }
__device__ __forceinline__ float bfhi(unsigned w) { return __builtin_bit_cast(float, w & 0xffff0000u); }
template <int CTRL, int ROW_MASK = 0xf>
__device__ __forceinline__ float dpp_f(float old, float v) { return __builtin_bit_cast(float, __builtin_amdgcn_update_dpp(__builtin_bit_cast(int, old), __builtin_bit_cast(int, v), CTRL, ROW_MASK, 0xf, false)); }
__device__ __forceinline__ float wave_sum(float v) {
    v += dpp_f<0x111>(0.f, v); v += dpp_f<0x112>(0.f, v); v += dpp_f<0x114>(0.f, v); v += dpp_f<0x118>(0.f, v);
    v += dpp_f<0x142, 0xa>(0.f, v); v += dpp_f<0x143, 0xc>(0.f, v);
    return __builtin_bit_cast(float, __builtin_amdgcn_readlane(__builtin_bit_cast(int, v), 63));
}
__device__ __forceinline__ float fast_exp2(float x) { return __builtin_amdgcn_exp2f(x); }
__device__ __forceinline__ float fast_rcp(float x) { return __builtin_amdgcn_rcpf(x); }
__device__ __forceinline__ float silu_f(float x) { return x * fast_rcp(1.f + fast_exp2(-x * LOG2E)); }
__device__ __forceinline__ float gelu_f(float x) { const float y2 = 2.3022082f * (x + 0.044715f * x * x * x); return x * fast_rcp(1.f + fast_exp2(-y2)); }

#define XB_TMO      128
#define XB_XCNT(j)  (256  + 64 * (j))
#define XB_XSUB(j)  (1280 + 64 * (j))
#define XB_XGEN(j)  (2304 + 64 * (j))
#define XB_TOP      3328
#define XB_TOPGEN   3392
#define XCD_BAR_WORDS 3456
#define XB_SPIN_CAP (1u << 20)
__device__ __forceinline__ unsigned xb_ld(unsigned* p)              { return __hip_atomic_load(p, __ATOMIC_RELAXED, __HIP_MEMORY_SCOPE_AGENT); }
__device__ __forceinline__ unsigned xb_add(unsigned* p, unsigned v) { return __hip_atomic_fetch_add(p, v, __ATOMIC_RELAXED, __HIP_MEMORY_SCOPE_AGENT); }
__device__ __forceinline__ unsigned xb_xcc_id() { return (unsigned)__builtin_amdgcn_s_getreg((3 << 11) | 20) & 0xFu; }
#define XB_SPIN(cond, bar) do { unsigned _sp = 0; while (cond) { __builtin_amdgcn_s_sleep(1); \
    if ((++_sp & 255u) == 0u) { if (xb_ld(&(bar)[XB_TMO])) break; if (_sp > XB_SPIN_CAP) { atomicAdd(&(bar)[XB_TMO], 1u); break; } } } } while (0)
struct XcdBarrier { unsigned* bar; unsigned x; volatile LAS unsigned* st; };
__device__ __forceinline__ XcdBarrier xcd_barrier_post(unsigned* bar, volatile LAS unsigned* st) {
    XcdBarrier b; b.bar = bar; b.x = xb_xcc_id(); b.st = st;
    if (threadIdx.x == 0) (void)xb_add(&bar[XB_XCNT(b.x)], 1u);
    return b;
}
__device__ __forceinline__ void xcd_barrier_complete(unsigned* bar, unsigned x, unsigned& nloc, unsigned& nx) {
    const unsigned G = gridDim.x * gridDim.y * gridDim.z;
    unsigned sum, cnt, mine, sp = 0u;
    for (;;) {
        sum = 0u; cnt = 0u; mine = 0u;
#pragma unroll
        for (unsigned j = 0; j < 16; ++j) { const unsigned c = xb_ld(&bar[XB_XCNT(j)]); sum += c; cnt += (c > 0u) ? 1u : 0u; mine = (j == x) ? c : mine; }
        if (sum == G) break;
        __builtin_amdgcn_s_sleep(1);
        if ((++sp & 255u) == 0u) { if (xb_ld(&bar[XB_TMO])) break; if (sp > XB_SPIN_CAP) { atomicAdd(&bar[XB_TMO], 1u); break; } }
    }
    nloc = mine > 0u ? mine : 1u; nx = cnt > 0u ? cnt : 1u;
}
__device__ __forceinline__ void xcd_barrier(const XcdBarrier& b) {
    asm volatile("s_waitcnt vmcnt(0)" ::: "memory");
    __syncthreads();
    if (threadIdx.x == 0) {
        unsigned* bar = b.bar;
        __builtin_amdgcn_s_waitcnt(0);
        unsigned nloc = b.st[0], nx = b.st[1];
        if (nloc == 0u) { xcd_barrier_complete(bar, b.x, nloc, nx); b.st[0] = nloc; b.st[1] = nx; }
        const unsigned old = xb_add(&bar[XB_XSUB(b.x)], 1u);
        const unsigned gen = old / nloc;
        if (old + 1u == (gen + 1u) * nloc) {
            __builtin_amdgcn_fence(__ATOMIC_RELEASE, "agent");
            asm volatile("s_waitcnt vmcnt(0)" ::: "memory");
            const unsigned og = xb_add(&bar[XB_TOP], 1u);
            const unsigned tg = og / nx;
            if (og + 1u == (tg + 1u) * nx) xb_add(&bar[XB_TOPGEN], 1u);
            else XB_SPIN(xb_ld(&bar[XB_TOPGEN]) == tg, bar);
            __builtin_amdgcn_fence(__ATOMIC_ACQUIRE, "agent");
            xb_add(&bar[XB_XGEN(b.x)], 1u);
            asm volatile("s_waitcnt vmcnt(0)" ::: "memory");
        } else {
            XB_SPIN(xb_ld(&bar[XB_XGEN(b.x)]) == gen, bar);
            __builtin_amdgcn_fence(__ATOMIC_ACQUIRE, "agent");
            asm volatile("s_waitcnt vmcnt(0)" ::: "memory");
        }
    }
    __syncthreads();
}

struct Args { const float* in[23]; float* out; unsigned char* ws; int ph_lo, ph_hi; };
__device__ __forceinline__ bf16_t* h_row(float* out, unsigned char* ws, int m) {
    return m < NTOK / 2 ? (bf16_t*)((unsigned char*)out + (size_t)NTOK * D * 2) + (size_t)m * D : (bf16_t*)(ws + WS_H1) + (size_t)(m - NTOK / 2) * D; }
enum { I_X = 0, I_C, I_WADA, I_BADA, I_GMIX, I_WIN, I_LNG, I_LNB, I_WSP, I_BSP, I_GOA, I_GOS, I_WOUT, I_GFFN, I_WR, I_BR, I_WEG, I_WEU, I_WED, I_WSG, I_WSU, I_WSD, I_GFIN };

namespace pg8 {
constexpr int BM = 256, BK = 64, HALF = 128, HTB = HALF * BK * 2, STAGE_BYTES = 8 * HTB;
__device__ __forceinline__ int lds_byte(int r, int c) { const int st = (r >> 4) * 2 + (c >> 5), rr = r & 15, cc = c & 31, ob = rr * 64 + cc * 2; return st * 1024 + (ob ^ (((ob >> 9) & 1) << 5)); }
__device__ __forceinline__ void stage_rc(int b, int& R, int& C) { const int st = b / 1024, sb = b % 1024, swz = sb ^ (((sb >> 9) & 1) << 5); R = (st >> 1) * 16 + swz / 64; C = (st & 1) * 32 + (swz % 64) / 2; }
__device__ __forceinline__ int perm32(int rho) { const int n = rho >> 4, i = rho & 15; return 8 * (i >> 2) + 4 * n + (i & 3); }

struct Unit { int t, nt, row0, nv, e; };

template <int K, class Epi, class Sched, bool ALIGN_EPI, bool SP2>
__device__ __forceinline__ void gemm_phase(LAS unsigned char* lds, const int tid, const Sched& S, const Epi& E, const int probe = 0) {
    const int wid = __builtin_amdgcn_readfirstlane(tid >> 6), lane = tid & 63, wr = wid >> 2, wc = wid & 3, fr = lane & 15, fq = lane >> 4;
    constexpr int nt = K / BK;
    unsigned voffB[2];
#pragma unroll
    for (int i = 0; i < 2; ++i) { int R, C; stage_rc(tid * 16 + i * 8192, R, C);
        const int Rb = Epi::COL16 ? (64 * (R >> 5) + 16 * ((R & 15) >> 2) + 4 * ((R >> 4) & 1) + (R & 3)) : ((R & ~31) + perm32(R & 31));
        voffB[i] = (unsigned)(Rb * K + C) * 2u; }
    constexpr size_t kstep = (size_t)(BK * 2);
    constexpr size_t hstep = (size_t)HALF * K * 2;
    constexpr size_t bstep = Epi::COL16 ? (size_t)8 * K * 2 : hstep;
    const unsigned ldsw = (unsigned)wid * 1024u;
    const int aoff = lds_byte(wr * 64 + fr, fq * 8), boff = lds_byte(wc * 32 + fr, fq * 8);
#define PG8_SA(b, h) (((b) * 2 + (h)) * HTB)
#define PG8_SB(b, h) ((4 + (b) * 2 + (h)) * HTB)
#define PG8_STAGE(bufoff, gbase, voff) do { _Pragma("unroll") for (int _i = 0; _i < 2; ++_i) \
        __builtin_amdgcn_global_load_lds((const unsigned*)((const char*)(gbase) + (voff)[_i]), (LAS unsigned*)(lds + (bufoff) + ldsw + _i * 8192), 16, 0, 0); } while (0)
#define PG8_LDA(dst, b, h) do { _Pragma("unroll") for (int m = 0; m < 4; ++m) _Pragma("unroll") for (int k = 0; k < 2; ++k) dst[m][k] = *(const LAS bf16x8*)(lds + PG8_SA(b, h) + aoff + m * 2048 + k * 1024); } while (0)
#define PG8_LDB(dst, b, h) do { _Pragma("unroll") for (int n = 0; n < 2; ++n) _Pragma("unroll") for (int k = 0; k < 2; ++k) dst[n][k] = *(const LAS bf16x8*)(lds + PG8_SB(b, h) + boff + n * 2048 + k * 1024); } while (0)
#define PG8_MMA(ai, bj, At, Bt) do { if (probe & 1) break; __builtin_amdgcn_s_setprio(1); _Pragma("unroll") for (int m = 0; m < 4; ++m) _Pragma("unroll") for (int n = 0; n < 2; ++n) { \
        if constexpr (Epi::F8) { \
            const i32x8 wa_ = __builtin_shufflevector(__builtin_bit_cast(i32x4, Bt[n][0]), __builtin_bit_cast(i32x4, Bt[n][1]), 0, 1, 2, 3, 4, 5, 6, 7); \
            const i32x8 xa_ = __builtin_shufflevector(__builtin_bit_cast(i32x4, At[m][0]), __builtin_bit_cast(i32x4, At[m][1]), 0, 1, 2, 3, 4, 5, 6, 7); \
            asm volatile("v_mfma_scale_f32_16x16x128_f8f6f4 %0, %1, %2, %0, %3, %4 op_sel_hi:[0,0,0]" : "+v"(acc[ai][bj][m][n]) : "v"(wa_), "v"(xa_), "v"(scw_), "v"(scx_)); \
        } else { _Pragma("unroll") for (int k = 0; k < 2; ++k) acc[ai][bj][m][n] = __builtin_amdgcn_mfma_f32_16x16x32_bf16(Bt[n][k], At[m][k], acc[ai][bj][m][n], 0, 0, 0); } } \
        __builtin_amdgcn_s_setprio(0); } while (0)
#define PG8_WAIT_V(n) asm volatile("s_waitcnt vmcnt(" #n ")" ::: "memory")
#define PG8_WAIT_L(n) asm volatile("s_waitcnt lgkmcnt(" #n ")" ::: "memory")
#define PG8_BAR __builtin_amdgcn_s_barrier()
#define PG8_SCHED __builtin_amdgcn_sched_barrier(0)
    Unit cur, nxt; int ui = 0;
    if (!S.next(0, cur)) return;
    f32x4 acc[2][2][4][2];
#pragma unroll
    for (int a = 0; a < 2; ++a)
#pragma unroll
        for (int b = 0; b < 2; ++b)
#pragma unroll
            for (int m = 0; m < 4; ++m)
#pragma unroll
                for (int n = 0; n < 2; ++n) acc[a][b][m][n] = (f32x4){0.f, 0.f, 0.f, 0.f};
    bf16x8 At[4][2], B0[2][2], B1[2][2];
    int scw_ = Epi::SC_W, scx_ = Epi::SC_X; asm volatile("" : "+v"(scw_), "+v"(scx_));
    constexpr bool GATHER = Sched::GATHER;
    constexpr size_t ah = GATHER ? 0 : hstep;
    unsigned va[2][2], vn[2][2];
    S.a_voff(cur, va);
#define VA1 (GATHER ? va[1] : va[0])
    const char* cA = S.a_base(cur); const char* cB = S.b_base(cur);
    if constexpr (SP2) {
        PG8_STAGE(PG8_SB(0, 0), cB, voffB); PG8_STAGE(PG8_SB(0, 1), cB + bstep, voffB); PG8_STAGE(PG8_SA(0, 0), cA, va[0]); PG8_STAGE(PG8_SA(0, 1), cA + ah, VA1);
        if (wr == 1) PG8_BAR;
        PG8_WAIT_V(2); PG8_BAR;
        PG8_STAGE(PG8_SB(1, 0), cB + kstep, voffB); PG8_STAGE(PG8_SA(1, 0), cA + kstep, va[0]); PG8_STAGE(PG8_SB(1, 1), cB + bstep + kstep, voffB);
        PG8_WAIT_V(6); PG8_BAR;
    } else {
        PG8_STAGE(PG8_SB(0, 0), cB, voffB); PG8_STAGE(PG8_SA(0, 0), cA, va[0]); PG8_STAGE(PG8_SB(0, 1), cB + bstep, voffB); PG8_STAGE(PG8_SA(0, 1), cA + ah, VA1);
        if (wr == 1) PG8_BAR;
        PG8_WAIT_V(4); PG8_BAR;
        PG8_STAGE(PG8_SB(1, 0), cB + kstep, voffB); PG8_STAGE(PG8_SA(1, 0), cA + kstep, va[0]); PG8_STAGE(PG8_SB(1, 1), cB + bstep + kstep, voffB);
        PG8_WAIT_V(6); PG8_BAR;
    }
    for (;;) {
        const bool has_next = S.next(ui + 1, nxt);
        const char* nA = has_next ? S.a_base(nxt) : cA; const char* nB = has_next ? S.b_base(nxt) : cB;
        const bool full = cur.nv > 128;
        if constexpr (GATHER) { if (has_next) S.a_voff(nxt, vn); else { vn[0][0] = va[0][0]; vn[0][1] = va[0][1]; vn[1][0] = va[1][0]; vn[1][1] = va[1][1]; } }
#pragma unroll 1
        for (int t = 0; t < nt; t += 2) {
            const bool last = (t == nt - 2);
            const char* a1 = cA + (size_t)(t + 1) * kstep;
            const char* a2 = last ? nA : cA + (size_t)(t + 2) * kstep; const char* b2 = last ? nB : cB + (size_t)(t + 2) * kstep;
            const char* a3 = a2 + kstep; const char* b3 = b2 + kstep;
            unsigned v2[2][2];
            if constexpr (GATHER) { v2[0][0] = last ? vn[0][0] : va[0][0]; v2[0][1] = last ? vn[0][1] : va[0][1]; v2[1][0] = last ? vn[1][0] : va[1][0]; v2[1][1] = last ? vn[1][1] : va[1][1]; }
            else { v2[0][0] = va[0][0]; v2[0][1] = va[0][1]; v2[1][0] = va[0][0]; v2[1][1] = va[0][1]; }
            if constexpr (SP2) {
            PG8_LDB(B0, 0, 0); PG8_LDB(B1, 0, 1); PG8_SCHED; PG8_LDA(At, 0, 0); PG8_STAGE(PG8_SA(1, 1), a1 + ah, VA1);
            PG8_WAIT_V(8); PG8_WAIT_L(0); PG8_BAR; PG8_MMA(0, 0, At, B0); PG8_MMA(0, 1, At, B1); PG8_BAR; PG8_SCHED;
            PG8_LDA(At, 0, 1); PG8_STAGE(PG8_SB(0, 0), b2, voffB); PG8_STAGE(PG8_SB(0, 1), b2 + bstep, voffB); PG8_STAGE(PG8_SA(0, 0), a2, v2[0]);
            PG8_WAIT_V(8); PG8_WAIT_L(0); PG8_BAR; if (full) { PG8_MMA(1, 0, At, B0); PG8_MMA(1, 1, At, B1); } PG8_BAR; PG8_SCHED;
            PG8_LDB(B0, 1, 0); PG8_LDB(B1, 1, 1); PG8_SCHED; PG8_LDA(At, 1, 0); PG8_STAGE(PG8_SA(0, 1), a2 + ah, v2[1]);
            PG8_WAIT_V(8); PG8_WAIT_L(0); PG8_BAR; PG8_MMA(0, 0, At, B0); PG8_MMA(0, 1, At, B1); PG8_BAR; PG8_SCHED;
            PG8_LDA(At, 1, 1); PG8_STAGE(PG8_SB(1, 0), b3, voffB); PG8_STAGE(PG8_SB(1, 1), b3 + bstep, voffB); PG8_STAGE(PG8_SA(1, 0), a3, v2[0]);
            PG8_WAIT_V(8); PG8_WAIT_L(0); PG8_BAR; if (full) { PG8_MMA(1, 0, At, B0); PG8_MMA(1, 1, At, B1); } PG8_BAR; PG8_SCHED;
            } else {
            PG8_LDB(B0, 0, 0); PG8_SCHED; PG8_LDA(At, 0, 0); PG8_STAGE(PG8_SA(1, 1), a1 + ah, VA1);
            PG8_WAIT_L(8); PG8_BAR; PG8_WAIT_L(0); PG8_MMA(0, 0, At, B0); PG8_BAR; PG8_SCHED;
            PG8_LDB(B1, 0, 1); PG8_STAGE(PG8_SB(0, 0), b2, voffB);
            PG8_BAR; PG8_WAIT_L(0); PG8_MMA(0, 1, At, B1); PG8_BAR;
            PG8_LDA(At, 0, 1); PG8_STAGE(PG8_SA(0, 0), a2, v2[0]);
            PG8_BAR; PG8_WAIT_L(0); PG8_MMA(1, 0, At, B0); PG8_BAR; PG8_SCHED;
            PG8_STAGE(PG8_SB(0, 1), b2 + bstep, voffB);
            PG8_WAIT_V(6); PG8_BAR; PG8_MMA(1, 1, At, B1); PG8_BAR;
            PG8_LDB(B0, 1, 0); PG8_SCHED; PG8_LDA(At, 1, 0); PG8_STAGE(PG8_SA(0, 1), a2 + ah, v2[1]);
            PG8_WAIT_L(8); PG8_BAR; PG8_WAIT_L(0); PG8_MMA(0, 0, At, B0); PG8_BAR; PG8_SCHED;
            PG8_LDB(B1, 1, 1); PG8_STAGE(PG8_SB(1, 0), b3, voffB);
            PG8_BAR; PG8_WAIT_L(0); PG8_MMA(0, 1, At, B1); PG8_BAR;
            PG8_LDA(At, 1, 1); PG8_STAGE(PG8_SA(1, 0), a3, v2[0]);
            PG8_BAR; PG8_WAIT_L(0); PG8_MMA(1, 0, At, B0); PG8_BAR; PG8_SCHED;
            PG8_STAGE(PG8_SB(1, 1), b3 + bstep, voffB);
            PG8_WAIT_V(6); PG8_BAR; PG8_MMA(1, 1, At, B1); PG8_BAR;
            }
        }
        if constexpr (ALIGN_EPI) { if (wr == 0) PG8_BAR; }
        if constexpr (Epi::F8) asm volatile("s_nop 15\n\ts_nop 15" ::: "memory");
        if (!(probe & 2)) E(acc, cur, wr, wc, fr, fq);
        if (!has_next) break;
#pragma unroll
        for (int a = 0; a < 2; ++a)
#pragma unroll
            for (int b = 0; b < 2; ++b)
#pragma unroll
                for (int m = 0; m < 4; ++m)
#pragma unroll
                    for (int n = 0; n < 2; ++n) acc[a][b][m][n] = (f32x4){0.f, 0.f, 0.f, 0.f};
        cur = nxt; cA = nA; cB = nB; ++ui;
        if constexpr (GATHER) { va[0][0] = vn[0][0]; va[0][1] = vn[0][1]; va[1][0] = vn[1][0]; va[1][1] = vn[1][1]; }
        if constexpr (ALIGN_EPI) { if (wr == 1) PG8_BAR; }
    }
    PG8_WAIT_V(0);
    if constexpr (!ALIGN_EPI) { if (wr == 0) PG8_BAR; }
    PG8_BAR;
#undef VA1
#undef PG8_SA
#undef PG8_SB
#undef PG8_STAGE
#undef PG8_LDA
#undef PG8_LDB
#undef PG8_MMA
#undef PG8_WAIT_V
#undef PG8_WAIT_L
#undef PG8_BAR
#undef PG8_SCHED
}

template <int K> struct DenseSched {
    static constexpr bool GATHER = false;
    const char* A; const char* Bt; int nM, nN, nwg, G, c, tid;
    __device__ __forceinline__ void init(const void* A_, const void* Bt_, int M, int N, int G_, int c_, int tid_) { tid = tid_; A = (const char*)A_; Bt = (const char*)Bt_; nM = M / BM; nN = N / BM; nwg = nM * nN; G = G_; c = c_; }
    __device__ __forceinline__ bool next(int i, Unit& u) const {
        const long L = (long)i * G + c; if (L >= nwg) return false;
        int wgid = (int)L; { const int q = nwg / 8, r = nwg % 8, xcd = wgid % 8, off = wgid / 8; wgid = (xcd < r ? xcd * (q + 1) : r * (q + 1) + (xcd - r) * q) + off; }
        const int nig = 8 * nN, gid = wgid / nig, fm = gid * 8, gsz = (nM - fm) < 8 ? (nM - fm) : 8;
        u.t = fm + ((wgid % nig) % gsz); u.nt = (wgid % nig) / gsz; u.row0 = 0; u.nv = 256; u.e = 0; return true;
    }
    __device__ __forceinline__ const char* a_base(const Unit& u) const { return A + (size_t)u.t * (BM * K * 2); }
    __device__ __forceinline__ const char* b_base(const Unit& u) const { return Bt + (size_t)u.nt * (BM * K * 2); }
    __device__ __forceinline__ void a_voff(const Unit&, unsigned (&v)[2][2]) const {
#pragma unroll
        for (int i = 0; i < 2; ++i) { int R, C; stage_rc(tid * 16 + i * 8192, R, C); v[0][i] = (unsigned)(R * K + C) * 2u; v[1][i] = v[0][i] + (unsigned)(HALF * K * 2); }
    }
};
}
using pg8::Unit;

struct TileTabs { const int* te; const int* trow0; const int* tnv; int ntiles; };
constexpr int UT_OFF = pg8::STAGE_BYTES;
constexpr int UT_INFO = UT_OFF + 16, UT_TOK = UT_INFO + 64 * 16, UT_MAXU = 20;
static_assert(UT_TOK + UT_MAXU * 1024 <= MISC_OFF, "unit tables fit under the LDS control words");
template <int NTN, bool G1>
struct ExpertSched {
    static constexpr bool GATHER = G1;
    const char* A; const char* W; LAS unsigned char* lds; int n, tid;
    __device__ __forceinline__ void init(LAS unsigned char* lds_, const void* A_, const void* W_, const int* rowtok, const TileTabs& T, int chunk, int tid_) {
        lds = lds_; tid = tid_; A = (const char*)A_; W = (const char*)W_;
        const int U = T.ntiles * NTN, x8 = blockIdx.x & 7, r8 = blockIdx.x >> 3, G8 = gridDim.x >> 3;
        const int q = (((U + 7) >> 3) + NTN - 1) / NTN * NTN;
        const int lo = x8 * q + r8, hi = (x8 + 1) * q < U ? (x8 + 1) * q : U;
        int cnt = hi > lo ? (hi - lo + G8 - 1) / G8 : 0; cnt = cnt > (G1 ? UT_MAXU : 64) ? (G1 ? UT_MAXU : 64) : cnt;
        n = cnt;
        LAS int* info = (LAS int*)(lds + UT_INFO);
        if (tid < cnt) { const int L = lo + G8 * tid, t = L / NTN; info[tid * 4 + 0] = T.te[t]; info[tid * 4 + 1] = T.trow0[t]; info[tid * 4 + 2] = T.tnv[t]; info[tid * 4 + 3] = L % NTN; }
        __syncthreads();
        if constexpr (G1) {
            LAS int* tok = (LAS int*)(lds + UT_TOK);
            for (int idx = tid; idx < cnt * 256; idx += NTHR) { const int i = idx >> 8, rl = idx & 255; const int e = info[i * 4 + 0], row0 = info[i * 4 + 1], nv = info[i * 4 + 2];
                tok[idx] = (e == NE) ? chunk * CHT + (row0 - CH_ROUTED) + rl : (rl < nv ? rowtok[row0 + rl] : chunk * CHT); }
            __syncthreads();
        }
    }
    __device__ __forceinline__ bool next(int i, Unit& u) const {
        if (i >= n) return false;
        const LAS int* info = (const LAS int*)(lds + UT_INFO);
        u.t = i; u.e = __builtin_amdgcn_readfirstlane(info[i * 4 + 0]); u.row0 = __builtin_amdgcn_readfirstlane(info[i * 4 + 1]);
        u.nv = __builtin_amdgcn_readfirstlane(info[i * 4 + 2]); u.nt = __builtin_amdgcn_readfirstlane(info[i * 4 + 3]); return true; }
    __device__ __forceinline__ const char* a_base(const Unit& u) const { if constexpr (G1) return A; else return A + (size_t)u.row0 * 256; }
    __device__ __forceinline__ const char* b_base(const Unit& u) const {
        if constexpr (G1) return W + ((size_t)u.e * 512 + u.nt * 256) * 1024; else return W + ((size_t)u.e * 1024 + u.nt * 256) * 256; }
    __device__ __forceinline__ void a_voff(const Unit& u, unsigned (&v)[2][2]) const {
        if constexpr (G1) {
            const LAS int* tok = (const LAS int*)(lds + UT_TOK) + u.t * 256;
#pragma unroll
            for (int i = 0; i < 2; ++i) { int R, C; pg8::stage_rc(tid * 16 + i * 8192, R, C);
#pragma unroll
                for (int h = 0; h < 2; ++h) v[h][i] = (unsigned)tok[R + 128 * h] * 1024u + (unsigned)C * 2u; }
        } else {
#pragma unroll
            for (int i = 0; i < 2; ++i) { int R, C; pg8::stage_rc(tid * 16 + i * 8192, R, C); v[0][i] = (unsigned)(R * 128 + C) * 2u; v[1][i] = v[0][i] + (unsigned)(128 * 128 * 2); }
        }
    }
};
typedef ExpertSched<2, true> Gemm1Sched;
typedef ExpertSched<4, false> Gemm2Sched;

template <bool F8_> struct EpiBf16T {
    static constexpr bool F8 = F8_; static constexpr int SC_W = SC_W1, SC_X = SC_N2;
    static constexpr bool COL16 = false;
    bf16_t* O; int ldc;
    __device__ __forceinline__ void operator()(const f32x4 (&acc)[2][2][4][2], const Unit& u, int wr, int wc, int fr, int fq) const {
        const int row0 = u.t * 256 + wr * 64 + fr, col0 = u.nt * 256 + wc * 32 + 8 * fq;
#pragma unroll
        for (int ai = 0; ai < 2; ++ai)
#pragma unroll
            for (int m = 0; m < 4; ++m) { bf16_t* rowp = O + (size_t)(row0 + ai * 128 + m * 16) * ldc + col0;
#pragma unroll
                for (int bj = 0; bj < 2; ++bj) { const f32x4 v0 = acc[ai][bj][m][0], v1 = acc[ai][bj][m][1];
                    u32x4 w; w.x = cvt_pk_bf16(v0[0], v0[1]); w.y = cvt_pk_bf16(v0[2], v0[3]); w.z = cvt_pk_bf16(v1[0], v1[1]); w.w = cvt_pk_bf16(v1[2], v1[3]);
                    *(u32x4*)(rowp + bj * 128) = w; } }
    }
};
struct EpiResH {
    static constexpr bool F8 = true; static constexpr int SC_W = SC_W1, SC_X = SC_N2;
    static constexpr bool COL16 = false;
    const float* x; const float* gate; float* out; unsigned char* ws;
    __device__ __forceinline__ void operator()(const f32x4 (&acc)[2][2][4][2], const Unit& u, int wr, int wc, int fr, int fq) const {
        const int row0 = u.t * 256 + wr * 64 + fr, col0 = u.nt * 256 + wc * 32 + 8 * fq;
        const int b = (u.t * 256) / SEQ;
        f32x4 g[2][2];
#pragma unroll
        for (int bj = 0; bj < 2; ++bj)
#pragma unroll
            for (int n = 0; n < 2; ++n) g[bj][n] = *(const f32x4*)(gate + (size_t)b * 6144 + col0 + bj * 128 + 4 * n);
        bf16_t* hb = h_row(out, ws, u.t * 256) + (size_t)(wr * 64 + fr) * D + col0;
#pragma unroll
        for (int ai = 0; ai < 2; ++ai)
#pragma unroll
            for (int m = 0; m < 4; ++m) { const size_t off = (size_t)(row0 + ai * 128 + m * 16) * D + col0;
#pragma unroll
                for (int bj = 0; bj < 2; ++bj) {
                    const f32x4 h0 = *(const f32x4*)(x + off + bj * 128) + g[bj][0] * acc[ai][bj][m][0], h1 = *(const f32x4*)(x + off + bj * 128 + 4) + g[bj][1] * acc[ai][bj][m][1];
                    u32x4 w; w.x = cvt_pk_bf16(h0[0], h0[1]); w.y = cvt_pk_bf16(h0[2], h0[3]); w.z = cvt_pk_bf16(h1[0], h1[1]); w.w = cvt_pk_bf16(h1[2], h1[3]);
                    *(u32x4*)(hb + (size_t)(ai * 128 + m * 16) * D + bj * 128) = w; } }
    }
};
struct EpiF32 {
    static constexpr bool F8 = false; static constexpr int SC_W = 0, SC_X = 0;
    static constexpr bool COL16 = false;
    float* O; int ldc;
    __device__ __forceinline__ void operator()(const f32x4 (&acc)[2][2][4][2], const Unit& u, int wr, int wc, int fr, int fq) const {
        const int row0 = u.t * 256 + wr * 64 + fr, col0 = u.nt * 256 + wc * 32 + 8 * fq;
#pragma unroll
        for (int ai = 0; ai < 2; ++ai)
#pragma unroll
            for (int m = 0; m < 4; ++m) { float* rowp = O + (size_t)(row0 + ai * 128 + m * 16) * ldc + col0;
#pragma unroll
                for (int bj = 0; bj < 2; ++bj)
#pragma unroll
                    for (int n = 0; n < 2; ++n) *(f32x4*)(rowp + bj * 128 + 4 * n) = acc[ai][bj][m][n]; }
    }
};
struct EpiAct {
    static constexpr bool F8 = true; static constexpr int SC_W = SC_W1, SC_X = SC_N2;
    static constexpr bool COL16 = false;
    unsigned char* act;
    __device__ __forceinline__ void operator()(const f32x4 (&acc)[2][2][4][2], const Unit& u, int wr, int wc, int fr, int fq) const {
        const int col0 = u.nt * 128 + wc * 32 + 8 * fq;
#pragma unroll
        for (int ai = 0; ai < 2; ++ai)
#pragma unroll
            for (int m = 0; m < 4; ++m) { const int rl = ai * 128 + wr * 64 + m * 16 + fr;
                f32x4 ov[2];
#pragma unroll
                for (int n = 0; n < 2; ++n) { const f32x4 g = acc[ai][0][m][n], gu = g * acc[ai][1][m][n];
                    f32x4 d; d.x = fast_exp2(g.x); d.y = fast_exp2(g.y); d.z = fast_exp2(g.z); d.w = fast_exp2(g.w);
                    d = d + 1.f;
                    f32x4 r; r.x = fast_rcp(d.x); r.y = fast_rcp(d.y); r.z = fast_rcp(d.z); r.w = fast_rcp(d.w);
                    ov[n] = gu * r; }
                ov[0] = ov[0] * ACT_PRE; ov[1] = ov[1] * ACT_PRE;
                int w0 = __builtin_amdgcn_cvt_pk_fp8_f32(ov[0].x, ov[0].y, 0, false); w0 = __builtin_amdgcn_cvt_pk_fp8_f32(ov[0].z, ov[0].w, w0, true);
                int w1 = __builtin_amdgcn_cvt_pk_fp8_f32(ov[1].x, ov[1].y, 0, false); w1 = __builtin_amdgcn_cvt_pk_fp8_f32(ov[1].z, ov[1].w, w1, true);
                u32x2 w; w.x = (unsigned)w0; w.y = (unsigned)w1;
                if (rl < u.nv) *(u32x2*)(act + (size_t)(u.row0 + rl) * EDIM + col0) = w; }
    }
};
struct EpiDown {
    static constexpr bool F8 = true; static constexpr int SC_W = SC_W2, SC_X = SC_ACT;
    static constexpr bool COL16 = true;
    unsigned char* Y; LAS unsigned char* lds; int nost;
    __device__ __forceinline__ u32x4 pack(const f32x4 (&acc)[2][2][4][2], int ai, int m) const {
        u32x4 w;
#pragma unroll
        for (int bj = 0; bj < 2; ++bj) {
            f32x4 v0 = acc[ai][bj][m][0], v1 = acc[ai][bj][m][1];
#pragma unroll
            for (int j = 0; j < 4; ++j) { v0[j] = fminf(fmaxf(v0[j], -448.f), 448.f); v1[j] = fminf(fmaxf(v1[j], -448.f), 448.f); }
            int w0 = __builtin_amdgcn_cvt_pk_fp8_f32(v0[0], v0[1], 0, false); w0 = __builtin_amdgcn_cvt_pk_fp8_f32(v0[2], v0[3], w0, true);
            int w1 = __builtin_amdgcn_cvt_pk_fp8_f32(v1[0], v1[1], 0, false); w1 = __builtin_amdgcn_cvt_pk_fp8_f32(v1[2], v1[3], w1, true);
            if (bj == 0) { w.x = (unsigned)w0; w.y = (unsigned)w1; } else { w.z = (unsigned)w0; w.w = (unsigned)w1; } }
        return w;
    }
    __device__ __forceinline__ void operator()(const f32x4 (&acc)[2][2][4][2], const Unit& u, int wr, int wc, int fr, int fq) const {
        const int lane = fq * 16 + fr, wv = wr * 4 + wc;
        constexpr int B0 = 3 * pg8::HTB, B1 = UT_TOK;
        const int wofs = (32 * wr + fr) * 256 + (((4 * wc + fq) ^ fr) << 4);
        const int rr0 = 8 * wv + (lane >> 4);
        const int rofs = rr0 * 256 + (((lane & 15) ^ (rr0 & 15)) << 4), rofs4 = (rr0 + 4) * 256 + (((lane & 15) ^ ((rr0 + 4) & 15)) << 4);
        const int t0 = 64 * (rr0 >> 5) + 16 * ((rr0 >> 4) & 1) + (rr0 & 15);
        unsigned char* yp = Y + (size_t)u.row0 * D + u.nt * 256 + 16 * (lane & 15);
        { const u32x4 wa = pack(acc, 0, 0), wb = pack(acc, 0, 1); *(LAS u32x4*)(lds + B0 + wofs) = wa; *(LAS u32x4*)(lds + B0 + wofs + 16 * 256) = wb; }
#pragma unroll
        for (int sl = 0; sl < 4; ++sl) { const int ai = sl >> 1, mh = sl & 1;
            asm volatile("s_waitcnt lgkmcnt(0)" ::: "memory"); __builtin_amdgcn_s_barrier();
            const int rb = (sl & 1) ? B1 : B0, wb_ = (sl & 1) ? B0 : B1;
            const u32x4 v0 = *(const LAS u32x4*)(lds + rb + rofs), v1 = *(const LAS u32x4*)(lds + rb + rofs4);
            if (sl < 3) { const int a2 = (sl + 1) >> 1, m2 = ((sl + 1) & 1) * 2;
                const u32x4 wa = pack(acc, a2, m2), wb = pack(acc, a2, m2 + 1); *(LAS u32x4*)(lds + wb_ + wofs) = wa; *(LAS u32x4*)(lds + wb_ + wofs + 16 * 256) = wb; }
            const int rl = ai * 128 + mh * 32 + t0;
            if (!nost) { if (rl < u.nv) __builtin_nontemporal_store(v0, (u32x4*)(yp + (size_t)rl * D)); if (rl + 4 < u.nv) __builtin_nontemporal_store(v1, (u32x4*)(yp + (size_t)(rl + 4) * D)); } }
    }
};

struct Frame {
    LAS unsigned char* lds; int tid, lane, wave, G, vcu;
    const CAS Args* a;
};
__device__ __forceinline__ Frame make_frame(LAS unsigned char* lds) {
    Frame F; F.lds = lds;
    int t = threadIdx.x; asm volatile("" : "+v"(t));
    F.tid = t; F.lane = t & 63; F.wave = __builtin_amdgcn_readfirstlane(t >> 6);
    const CAS Args* a = (const CAS Args*)__builtin_amdgcn_kernarg_segment_ptr(); asm volatile("" : "+s"(a)); F.a = a;
    F.G = gridDim.x; { const int bx = blockIdx.x; F.vcu = (F.G % 8 == 0) ? (bx % 8) * (F.G / 8) + bx / 8 : bx; }
    return F;
}
#define WSP(F, off, T) ((T*)((F).a->ws + (off)))

__device__ __forceinline__ void phase_mod(Frame& F) {
    LAS float* cond = (LAS float*)F.lds;
    LAS float* red = (LAS float*)(F.lds + 65536);
    const float* c = F.a->in[I_C]; const float* wada = F.a->in[I_WADA]; const float* bada = F.a->in[I_BADA];
    float* mod = WSP(F, WS_MOD, float);
    for (int i = F.tid; i < 16 * 1024; i += NTHR) cond[i] = silu_f(c[i]);
    __syncthreads();
    const int jj = F.tid & 31, ks = F.tid >> 5;
    for (int cb = blockIdx.x; cb < 256; cb += F.G) {
        const int j0 = cb * 24;
        float acc[16];
#pragma unroll
        for (int b = 0; b < 16; ++b) acc[b] = 0.f;
        if (jj < 24) {
            for (int k = ks * 64; k < ks * 64 + 64; ++k) {
                const float w = wada[(size_t)k * 6144 + j0 + jj];
#pragma unroll
                for (int b = 0; b < 16; ++b) acc[b] += cond[b * 1024 + k] * w;
            }
        }
#pragma unroll
        for (int b = 0; b < 16; ++b) red[(ks * 16 + b) * 32 + jj] = acc[b];
        __syncthreads();
        if (F.tid < 16 * 24) { const int b = F.tid / 24, j = F.tid % 24; float s = 0.f;
            for (int k2 = 0; k2 < 16; ++k2) s += red[(k2 * 16 + b) * 32 + j];
            mod[b * 6144 + j0 + j] = s + bada[j0 + j]; }
        __syncthreads();
    }
    const float* wsp = F.a->in[I_WSP]; bf16_t* o = WSP(F, WS_WSP, bf16_t);
    for (int i = blockIdx.x * NTHR + F.tid; i < 4 * 128 * 128; i += F.G * NTHR) { const int s = i & 127, t = (i >> 7) & 127; o[i] = (bf16_t)(cvt_pk_bf16(s <= t ? wsp[i] : 0.f, 0.f) & 0xffffu); }
}

struct TItem { const float* W; bf16_t* WT; int K, N, gmode, item; float scale; bool f8; };
__device__ __forceinline__ void titem_issue(const TItem& t, int lane, LAS unsigned char* buf) {
    const int nblk = t.N / 32, kb = t.item / nblk, nb = t.item % nblk, k0 = 64 * kb, n0 = 32 * nb;
#pragma unroll
    for (int j = 0; j < 8; ++j) { const float* g = t.W + (size_t)(k0 + 8 * j + (lane >> 3)) * t.N + n0 + 4 * ((lane & 7) ^ j);
        __builtin_amdgcn_global_load_lds((const unsigned*)g, (LAS unsigned*)(buf + j * 1024), 16, 0, 2); }
}
__device__ __forceinline__ void titem_finish(const TItem& t, int lane, const LAS unsigned char* buf) {
    const int nblk = t.N / 32, kb = t.item / nblk, nb = t.item % nblk, k0 = 64 * kb, n0 = 32 * nb;
    const int d0 = t.gmode == 0 ? n0 : ((n0 >> 7) * 256 + (n0 & 127) + (t.gmode == 2 ? 128 : 0));
    const int c = lane & 7;
    const LAS float* sb = (const LAS float*)buf;
    float v[4][8];
    const float wsc = t.scale;
#pragma unroll
    for (int j = 0; j < 4; ++j) { const int n = (lane >> 3) + 8 * j; const LAS float* s = sb + (8 * c) * 32 + 4 * ((n >> 2) ^ c) + (n & 3);
#pragma unroll
        for (int q = 0; q < 8; ++q) v[j][q] = s[32 * q] * wsc; }
    if (t.f8) {
#pragma unroll
        for (int j = 0; j < 4; ++j) { const int n = (lane >> 3) + 8 * j;
            int w0 = __builtin_amdgcn_cvt_pk_fp8_f32(v[j][0], v[j][1], 0, false); w0 = __builtin_amdgcn_cvt_pk_fp8_f32(v[j][2], v[j][3], w0, true);
            int w1 = __builtin_amdgcn_cvt_pk_fp8_f32(v[j][4], v[j][5], 0, false); w1 = __builtin_amdgcn_cvt_pk_fp8_f32(v[j][6], v[j][7], w1, true);
            u32x2 o; o.x = (unsigned)w0; o.y = (unsigned)w1;
            __builtin_nontemporal_store(o, (u32x2*)((unsigned char*)t.WT + (size_t)(d0 + n) * t.K + k0 + 8 * c)); }
    } else {
#pragma unroll
        for (int j = 0; j < 4; ++j) { const int n = (lane >> 3) + 8 * j;
            u32x4 o; o.x = cvt_pk_bf16(v[j][0], v[j][1]); o.y = cvt_pk_bf16(v[j][2], v[j][3]); o.z = cvt_pk_bf16(v[j][4], v[j][5]); o.w = cvt_pk_bf16(v[j][6], v[j][7]);
            __builtin_nontemporal_store(o, (u32x4*)(t.WT + (size_t)(d0 + n) * t.K + k0 + 8 * c)); }
    }
}
typedef float f32x2v __attribute__((ext_vector_type(2)));
template <bool HB>
__device__ __forceinline__ void norm_mod_row2(const void* x0, const void* x1, const float* g, const float* sh0, const float* sc0, const float* sh1, const float* sc1, bf16_t* o0, bf16_t* o1, int lane) {
    f32x4 v0[4], v1[4]; float s0 = 0.f, s1 = 0.f;
#pragma unroll
    for (int j = 0; j < 4; ++j) {
        if (HB) { const u32x2 a = *(const u32x2*)((const bf16_t*)x0 + 4 * lane + 256 * j), b = *(const u32x2*)((const bf16_t*)x1 + 4 * lane + 256 * j);
            v0[j] = (f32x4){bflo(a.x), bfhi(a.x), bflo(a.y), bfhi(a.y)}; v1[j] = (f32x4){bflo(b.x), bfhi(b.x), bflo(b.y), bfhi(b.y)}; }
        else { v0[j] = *(const f32x4*)((const float*)x0 + 4 * lane + 256 * j); v1[j] = *(const f32x4*)((const float*)x1 + 4 * lane + 256 * j); } }
#pragma unroll
    for (int j = 0; j < 4; ++j) { s0 += (v0[j].x * v0[j].x + v0[j].y * v0[j].y) + (v0[j].z * v0[j].z + v0[j].w * v0[j].w);
                                  s1 += (v1[j].x * v1[j].x + v1[j].y * v1[j].y) + (v1[j].z * v1[j].z + v1[j].w * v1[j].w); }
    s0 = wave_sum(s0); s1 = wave_sum(s1);
    const float r0 = 1.f / sqrtf(s0 * (1.f / D) + EPS), r1 = 1.f / sqrtf(s1 * (1.f / D) + EPS);
#pragma unroll
    for (int j = 0; j < 4; ++j) { const int c0 = 4 * lane + 256 * j;
        const f32x4 gg = *(const f32x4*)(g + c0);
        const f32x4 y0 = v0[j] * r0 * gg * (*(const f32x4*)(sc0 + c0) + 1.f) + *(const f32x4*)(sh0 + c0);
        const f32x4 y1 = v1[j] * r1 * gg * (*(const f32x4*)(sc1 + c0) + 1.f) + *(const f32x4*)(sh1 + c0);
        u32x2 w0, w1; w0.x = cvt_pk_bf16(y0.x, y0.y); w0.y = cvt_pk_bf16(y0.z, y0.w); w1.x = cvt_pk_bf16(y1.x, y1.y); w1.y = cvt_pk_bf16(y1.z, y1.w);
        *(u32x2*)(o0 + c0) = w0; *(u32x2*)(o1 + c0) = w1; }
}
template <int NR, bool HB>
__device__ __forceinline__ void norm_mod_rows(const void* x, size_t xstride, const float* g, const float* sh, const float* sc, bf16_t* o, size_t ostride, int lane, unsigned char* o8 = nullptr) {
    f32x4 v[NR][4]; float ss[NR];
    f32x4 gq[4], sq4[4], hq[4];
#pragma unroll
    for (int j = 0; j < 4; ++j) { const int c0 = 4 * lane + 256 * j; gq[j] = *(const f32x4*)(g + c0); sq4[j] = *(const f32x4*)(sc + c0); hq[j] = *(const f32x4*)(sh + c0); }
    if constexpr (HB) {
        u32x2 raw[NR][4];
#pragma unroll
        for (int r = 0; r < NR; ++r)
#pragma unroll
            for (int j = 0; j < 4; ++j) raw[r][j] = *(const u32x2*)((const bf16_t*)x + r * xstride + 4 * lane + 256 * j);
#pragma unroll
        for (int r = 0; r < NR; ++r)
#pragma unroll
            for (int j = 0; j < 4; ++j) v[r][j] = (f32x4){bflo(raw[r][j].x), bfhi(raw[r][j].x), bflo(raw[r][j].y), bfhi(raw[r][j].y)};
    } else {
#pragma unroll
        for (int r = 0; r < NR; ++r)
#pragma unroll
            for (int j = 0; j < 4; ++j) v[r][j] = *(const f32x4*)((const float*)x + r * xstride + 4 * lane + 256 * j);
    }
#pragma unroll
    for (int r = 0; r < NR; ++r) { float s0 = 0.f;
#pragma unroll
        for (int j = 0; j < 4; ++j) s0 += (v[r][j].x * v[r][j].x + v[r][j].y * v[r][j].y) + (v[r][j].z * v[r][j].z + v[r][j].w * v[r][j].w);
        ss[r] = 1.f / sqrtf(wave_sum(s0) * (1.f / D) + EPS); }
#pragma unroll
    for (int j = 0; j < 4; ++j) { const int c0 = 4 * lane + 256 * j;
        const f32x4 gg = gq[j] * (sq4[j] + 1.f), hh = hq[j];
#pragma unroll
        for (int r = 0; r < NR; ++r) { const f32x4 y = v[r][j] * ss[r] * gg + hh;
            if (o) { u32x2 w; w.x = cvt_pk_bf16(y.x, y.y); w.y = cvt_pk_bf16(y.z, y.w); *(u32x2*)(o + r * ostride + c0) = w; }
            if (o8) { int q = __builtin_amdgcn_cvt_pk_fp8_f32(y.x, y.y, 0, false); q = __builtin_amdgcn_cvt_pk_fp8_f32(y.z, y.w, q, true); *(int*)(o8 + r * ostride + c0) = q; } } }
}
__device__ __forceinline__ void phase_prep(Frame& F) {
    const int gw = F.vcu * 8 + F.wave, NGW = F.G * 8;
    const float* mod = WSP(F, WS_MOD, float); bf16_t* nbuf = WSP(F, WS_A, bf16_t);
    for (int m = gw * 4; m < NTOK; m += 4 * NGW) { const int b = m / SEQ;
        norm_mod_rows<4, false>(F.a->in[I_X] + (size_t)m * D, D, F.a->in[I_GMIX], mod + b * 6144, mod + b * 6144 + 1024, nullptr, D, F.lane, (unsigned char*)nbuf + (size_t)m * D); }
    LAS unsigned char* scr = F.lds + F.wave * 16384;
    constexpr int IT_IN = 16 * 80, IT_OUT = 16 * 32, IT_R = 16 * 8;
    constexpr int NITEMS = IT_IN + IT_OUT + IT_R;
    for (int it = gw; it < NITEMS; it += NGW) {
        int r = it; TItem t;
        if (r < IT_IN) t = TItem{F.a->in[I_WIN], WSP(F, WS_WTIN, bf16_t), 1024, 2560, 0, r, W1_PRE, true};
        else if (r < IT_IN + IT_OUT) t = TItem{F.a->in[I_WOUT], WSP(F, WS_WTOUT, bf16_t), 1024, 1024, 0, r - IT_IN, W1_PRE, true};
        else t = TItem{F.a->in[I_WR], WSP(F, WS_WTR, bf16_t), 1024, 256, 0, r - IT_IN - IT_OUT, 1.f, false};
        titem_issue(t, F.lane, scr); asm volatile("s_waitcnt vmcnt(0)" ::: "memory"); titem_finish(t, F.lane, scr); asm volatile("s_waitcnt lgkmcnt(0)" ::: "memory");
    }
}
constexpr int CONV_ITEMS = 257 * 3 * 128;
__device__ __forceinline__ void convert_experts(Frame& F, int lo, int hi) {
    const int gw = F.vcu * 8 + F.wave, NGW = F.G * 8;
    LAS unsigned char* scr = F.lds + F.wave * 16384;
    unsigned char* W1t = WSP(F, WS_W1T, unsigned char); unsigned char* W2t = WSP(F, WS_W2T, unsigned char);
    const float* weg = F.a->in[I_WEG]; const float* weu = F.a->in[I_WEU]; const float* wed = F.a->in[I_WED];
    const float* wsg = F.a->in[I_WSG]; const float* wsu = F.a->in[I_WSU]; const float* wsd = F.a->in[I_WSD];
#define CONV_DESC(r, t) do { const int e_ = (r) / 384, w_ = ((r) >> 7) % 3; (t).item = (r) & 127; (t).f8 = true; (t).scale = w_ == 2 ? YSCALE * W2_PRE : (w_ == 0 ? -LOG2E * W1_PRE : -W1_PRE / LOG2E); (t).gmode = w_ == 2 ? 0 : w_ + 1; (t).K = w_ == 2 ? 256 : 1024; (t).N = w_ == 2 ? 1024 : 256; \
        (t).W = w_ == 0 ? (e_ < NE ? weg + (size_t)e_ * 262144 : wsg) : w_ == 1 ? (e_ < NE ? weu + (size_t)e_ * 262144 : wsu) : (e_ < NE ? wed + (size_t)e_ * 262144 : wsd); \
        (t).WT = (bf16_t*)(w_ == 2 ? W2t + (size_t)e_ * 262144 : W1t + (size_t)e_ * 524288); } while (0)
    constexpr int NPAIRS = CONV_ITEMS / 2;
    (void)lo; (void)hi;
#define CONV_RIDX(s_) ({ const int P_ = gw + ((s_) >> 1) * NGW, mi_ = P_ >> 6, pp_ = P_ & 63, nb_ = (mi_ % 3) == 2 ? 32 : 8; mi_ * 128 + (2 * (pp_ / nb_) + ((s_) & 1)) * nb_ + (pp_ % nb_); })
    if (gw < NPAIRS) {
        const int ns = 2 * ((NPAIRS - gw + NGW - 1) / NGW);
        int sq = 0, r = CONV_RIDX(0);
        TItem tc, tn; CONV_DESC(r, tc); tn = tc;
        int p = 0; bool first = true;
        titem_issue(tc, F.lane, scr);
        for (;;) {
            const bool more = sq + 1 < ns; const int rn = more ? CONV_RIDX(sq + 1) : r;
            if (more) { CONV_DESC(rn, tn); titem_issue(tn, F.lane, scr + (p ^ 1) * 8192); }
            if (!more) asm volatile("s_waitcnt vmcnt(0)" ::: "memory");
            else if (first) asm volatile("s_waitcnt vmcnt(8)" ::: "memory");
            else asm volatile("s_waitcnt vmcnt(12)" ::: "memory");
            titem_finish(tc, F.lane, scr + p * 8192);
            asm volatile("s_waitcnt lgkmcnt(0)" ::: "memory");
            if (!more) break;
            tc = tn; r = rn; ++sq; p ^= 1; first = false;
        }
    }
#undef CONV_RIDX
#undef CONV_DESC
    __syncthreads();
}

__device__ __forceinline__ s16x4 tr_read(LAS unsigned char* p) { return __builtin_bit_cast(s16x4, __builtin_amdgcn_ds_read_tr16_b64_v4i16((LAS s16x4*)p)); }
constexpr int ATT_ROWB = 144;
constexpr int ATT_VOFF = 256 * ATT_ROWB;
struct AttnUnit { int b, h, d, dsel, r, n; };
__device__ __forceinline__ AttnUnit attn_decode(int j) {
    AttnUnit u; const int bh = j / 96, rest = j % 96; u.b = bh >> 3; u.h = bh & 7;
    u.dsel = (rest >= 32 ? 1 : 0) + (rest >= 64 ? 1 : 0);
    const int x = rest - 32 * u.dsel, sh = 5 - 2 * u.dsel;
    u.d = 1 << (2 * u.dsel); u.r = x >> sh; u.n = x & ((1 << sh) - 1);
    return u;
}
__device__ __forceinline__ void attn_issue(const bf16_t* qkv, const AttnUnit& u, int tid, u32x4 (&kr)[4], u32x4 (&vr)[4]) {
#pragma unroll
    for (int jj = 0; jj < 4; ++jj) { const int ch = tid + 512 * jj, row = ch >> 3, c16 = ch & 7;
        int i = 128 * (u.n - 1) + row; i = i < 0 ? 0 : i;
        const size_t tok = (size_t)u.b * SEQ + (size_t)i * u.d + u.r;
        const bf16_t* p = qkv + tok * NPROJ + 512 + u.h * 64 + c16 * 8;
        kr[jj] = *(const u32x4*)p; vr[jj] = *(const u32x4*)(p + 512); }
}
__device__ __forceinline__ void phase_attn(Frame& F) {
    const bf16_t* qkv = WSP(F, WS_B, bf16_t);
    bf16_t* part = (bf16_t*)F.a->out;
    float* lse = WSP(F, WS_LSE, float);
    const int tid = F.tid, w = F.wave, lane = F.lane, fr = lane & 15, fq = lane >> 4;
    const int x8 = blockIdx.x & 7, r8 = blockIdx.x >> 3, G8 = F.G >> 3;
    constexpr int PER_X = 16 * 96;
    constexpr int ABUF = 2 * ATT_VOFF;
    float ef[4];
#pragma unroll
    for (int rg = 0; rg < 4; ++rg) ef[rg] = (float)(fr - 4 * fq - rg);
    u32x4 kr[4], vr[4];
    AttnUnit un;
    bf16x8 qn0, qn1;
    int jl = r8;
    if (jl >= PER_X) return;
    AttnUnit cu = attn_decode(x8 * PER_X + jl);
    attn_issue(qkv, cu, tid, kr, vr);
    { const size_t tq = (size_t)cu.b * SEQ + (size_t)(128 * cu.n + 16 * w + fr) * cu.d + cu.r; const bf16_t* qp = qkv + tq * NPROJ + cu.h * 64 + 8 * fq; qn0 = *(const bf16x8*)qp; qn1 = *(const bf16x8*)(qp + 32); }
#pragma unroll
    for (int jj = 0; jj < 4; ++jj) { const int ch = tid + 512 * jj, row = ch >> 3, c16 = ch & 7;
        *(LAS u32x4*)(F.lds + row * ATT_ROWB + c16 * 16) = kr[jj]; *(LAS u32x4*)(F.lds + ATT_VOFF + row * ATT_ROWB + c16 * 16) = vr[jj]; }
    const int jlast = r8 + G8 * ((PER_X - 1 - r8) / G8);
    un = attn_decode(x8 * PER_X + (jl + G8 < jlast ? jl + G8 : jlast)); attn_issue(qkv, un, tid, kr, vr);
    int buf = 0;
    for (; jl < PER_X; jl += G8) {
        __syncthreads();
        LAS unsigned char* kb = F.lds + buf * ABUF;
        const bf16x8 q0 = qn0, q1 = qn1;
        {
            LAS unsigned char* ob = F.lds + (buf ^ 1) * ABUF;
#pragma unroll
            for (int jj = 0; jj < 4; ++jj) { const int ch = tid + 512 * jj, row = ch >> 3, c16 = ch & 7;
                *(LAS u32x4*)(ob + row * ATT_ROWB + c16 * 16) = kr[jj]; *(LAS u32x4*)(ob + ATT_VOFF + row * ATT_ROWB + c16 * 16) = vr[jj]; }
        }
        const AttnUnit nu = un;
        un = attn_decode(x8 * PER_X + (jl + 2 * G8 < jlast ? jl + 2 * G8 : jlast)); attn_issue(qkv, un, tid, kr, vr);
        { const size_t tq = (size_t)nu.b * SEQ + (size_t)(128 * nu.n + 16 * w + fr) * nu.d + nu.r; const bf16_t* qp = qkv + tq * NPROJ + nu.h * 64 + 8 * fq; qn0 = *(const bf16x8*)qp; qn1 = *(const bf16x8*)(qp + 32); }
        const size_t tokq = (size_t)cu.b * SEQ + (size_t)(128 * cu.n + 16 * w + fr) * cu.d + cu.r;
        const float c1 = 0.125f * LOG2E;
        const float nc2 = -__builtin_amdgcn_exp2f(-(float)(cu.h + 1)) * (float)cu.d * LOG2E;
        const bool first = cu.n == 0;
        f32x4 St[9];
        float mx = -INFINITY;
        bf16x8 kf[9][2];
#pragma unroll
        for (int T = 0; T < 9; ++T) { LAS unsigned char* ka = kb + (16 * (w + T) + fr) * ATT_ROWB + fq * 16; kf[T][0] = *(LAS bf16x8*)ka; kf[T][1] = *(LAS bf16x8*)(ka + 64); }
        __builtin_amdgcn_sched_barrier(0);
#pragma unroll
        for (int T = 0; T < 9; ++T) {
            f32x4 sa = (f32x4){0.f, 0.f, 0.f, 0.f};
            sa = __builtin_amdgcn_mfma_f32_16x16x32_bf16(kf[T][0], q0, sa, 0, 0, 0);
            sa = __builtin_amdgcn_mfma_f32_16x16x32_bf16(kf[T][1], q1, sa, 0, 0, 0);
            const float kT = (!first || w + T >= 8) ? nc2 * (float)(128 - 16 * T) : -INFINITY;
#pragma unroll
            for (int rg = 0; rg < 4; ++rg) {
                float s2 = __builtin_fmaf(ef[rg], nc2, __builtin_fmaf(sa[rg], c1, kT));
                if (T == 0) s2 = ef[rg] <= 0.f ? s2 : -INFINITY;
                if (T == 8) s2 = ef[rg] >= 0.f ? s2 : -INFINITY;
                sa[rg] = s2;
            }
            St[T] = sa;
            mx = fmaxf(mx, fmaxf(fmaxf(sa[0], sa[1]), fmaxf(sa[2], sa[3])));
        }
        mx = fmaxf(mx, __shfl_xor(mx, 16)); mx = fmaxf(mx, __shfl_xor(mx, 32));
        float l = 0.f;
#pragma unroll
        for (int T = 0; T < 9; ++T)
#pragma unroll
            for (int rg = 0; rg < 4; ++rg) { const float p = fast_exp2(St[T][rg] - mx); St[T][rg] = p; l += p; }
        l += __shfl_xor(l, 16); l += __shfl_xor(l, 32);
        f32x4 O[4];
#pragma unroll
        for (int dt = 0; dt < 4; ++dt) O[dt] = (f32x4){0.f, 0.f, 0.f, 0.f};
#pragma unroll
        for (int T = 0; T < 9; ++T) {
            u32x2 pw; pw.x = cvt_pk_bf16(St[T][0], St[T][1]); pw.y = cvt_pk_bf16(St[T][2], St[T][3]);
            const s16x4 pb = __builtin_bit_cast(s16x4, pw);
            LAS unsigned char* va = kb + ATT_VOFF + (16 * (w + T) + 4 * fq + (fr >> 2)) * ATT_ROWB + (8 * (fr & 3)) * 2;
#pragma unroll
            for (int dt = 0; dt < 4; ++dt) O[dt] = __builtin_amdgcn_mfma_f32_16x16x16bf16_1k(tr_read(va + 64 * (dt >> 1) + 8 * (dt & 1)), pb, O[dt], 0, 0, 0);
        }
        const float inv = 1.f / l;
        bf16_t* op = part + ((size_t)cu.dsel * NTOK + tokq) * 512 + cu.h * 64 + 8 * fq;
#pragma unroll
        for (int u2 = 0; u2 < 2; ++u2) { u32x4 o4; o4.x = cvt_pk_bf16(O[2 * u2][0] * inv, O[2 * u2][1] * inv); o4.y = cvt_pk_bf16(O[2 * u2][2] * inv, O[2 * u2][3] * inv);
            o4.z = cvt_pk_bf16(O[2 * u2 + 1][0] * inv, O[2 * u2 + 1][1] * inv); o4.w = cvt_pk_bf16(O[2 * u2 + 1][2] * inv, O[2 * u2 + 1][3] * inv); *(u32x4*)(op + 32 * u2) = o4; }
        if (fq == 0) lse[((size_t)cu.dsel * NTOK + tokq) * 8 + cu.h] = mx + __builtin_amdgcn_logf(l);
        cu = nu; buf ^= 1;
    }
    __syncthreads();
}

constexpr int SGU_ROWB = 1040;
__device__ __forceinline__ void phase_sgu(Frame& F) {
    const bf16_t* qkv = WSP(F, WS_B, bf16_t);
    bf16_t* sgu = (bf16_t*)F.a->out + (size_t)3 * NTOK * 512;
    const bf16_t* Wsp = WSP(F, WS_WSP, bf16_t);
    const float* lng = F.a->in[I_LNG]; const float* lnb = F.a->in[I_LNB]; const float* bsp = F.a->in[I_BSP];
    const int w = F.wave, lane = F.lane, fr = lane & 15, fq = lane >> 4;
    for (int un = blockIdx.x; un < NTOK / 128; un += F.G) {
        const size_t tok0 = (size_t)un * 128;
        __syncthreads();
        float g8[8], b8[8];
#pragma unroll
        for (int j = 0; j < 8; ++j) { g8[j] = lng[8 * lane + j]; b8[j] = lnb[8 * lane + j]; }
#pragma unroll 1
        for (int i0 = 0; i0 < 16; i0 += 8) {
        u32x4 zrv[8];
#pragma unroll
        for (int i = 0; i < 8; ++i) zrv[i] = *(const u32x4*)(qkv + (tok0 + 16 * w + i0 + i) * NPROJ + 2048 + 8 * lane);
#pragma unroll
        for (int i = 0; i < 8; ++i) { const int s = 16 * w + i0 + i;
            const u32x4 zr = zrv[i];
            float z[8]; z[0] = bflo(zr.x); z[1] = bfhi(zr.x); z[2] = bflo(zr.y); z[3] = bfhi(zr.y); z[4] = bflo(zr.z); z[5] = bfhi(zr.z); z[6] = bflo(zr.w); z[7] = bfhi(zr.w);
            float sm = 0.f;
#pragma unroll
            for (int j = 0; j < 8; ++j) { z[j] = gelu_f(z[j]); sm += z[j]; }
            const float mean = wave_sum(sm) * (1.f / 512.f); float sq = 0.f;
#pragma unroll
            for (int j = 0; j < 8; ++j) { z[j] -= mean; sq += z[j] * z[j]; }
            const float rstd = 1.f / sqrtf(wave_sum(sq) * (1.f / 512.f) + EPS);
#pragma unroll
            for (int j = 0; j < 8; ++j) z[j] = z[j] * rstd * g8[j] + b8[j];
            u32x4 o; o.x = cvt_pk_bf16(z[0], z[1]); o.y = cvt_pk_bf16(z[2], z[3]); o.z = cvt_pk_bf16(z[4], z[5]); o.w = cvt_pk_bf16(z[6], z[7]);
            *(LAS u32x4*)(F.lds + s * SGU_ROWB + lane * 16) = o; }
        }
        __syncthreads();
        const int cw = 64 * w, g = w >> 1;
        f32x4 acc[4][8];
#pragma unroll
        for (int ct = 0; ct < 4; ++ct)
#pragma unroll
            for (int tt = 0; tt < 8; ++tt) acc[ct][tt] = (f32x4){0.f, 0.f, 0.f, 0.f};
#pragma unroll
        for (int ks = 0; ks < 4; ++ks) {
            bf16x8 af[4];
#pragma unroll
            for (int ct = 0; ct < 4; ++ct) {
                LAS unsigned char* pa = F.lds + (32 * ks + 8 * fq + (fr >> 2)) * SGU_ROWB + (cw + 32 * (ct >> 1) + 8 * (fr & 3) + 4 * (ct & 1)) * 2;
                const s16x4 lo = tr_read(pa), hi = tr_read(pa + 4 * SGU_ROWB);
                af[ct].s0 = lo.x; af[ct].s1 = lo.y; af[ct].s2 = lo.z; af[ct].s3 = lo.w; af[ct].s4 = hi.x; af[ct].s5 = hi.y; af[ct].s6 = hi.z; af[ct].s7 = hi.w;
            }
            bf16x8 bfr[8];
#pragma unroll
            for (int tt = 0; tt < 8; ++tt) if (16 * tt + 15 >= 32 * ks) bfr[tt] = *(const bf16x8*)(Wsp + ((size_t)(g * 128 + 16 * tt + fr) * 128 + 32 * ks + 8 * fq));
#pragma unroll
            for (int tt = 0; tt < 8; ++tt) {
                if (16 * tt + 15 < 32 * ks) continue;
#pragma unroll
                for (int ct = 0; ct < 4; ++ct) acc[ct][tt] = __builtin_amdgcn_mfma_f32_16x16x32_bf16(af[ct], bfr[tt], acc[ct][tt], 0, 0, 0);
            }
        }
        float bsv[8];
#pragma unroll
        for (int tt = 0; tt < 8; ++tt) bsv[tt] = bsp[g * 128 + 16 * tt + fr];
#pragma unroll
        for (int th = 0; th < 2; ++th) {
            u32x4 urv[4][2];
#pragma unroll
            for (int i = 0; i < 4; ++i)
#pragma unroll
                for (int cp = 0; cp < 2; ++cp) urv[i][cp] = *(const u32x4*)(qkv + (tok0 + 16 * (4 * th + i) + fr) * NPROJ + 1536 + cw + 32 * cp + 8 * fq);
#pragma unroll
            for (int i = 0; i < 4; ++i) { const int tt = 4 * th + i, t = 16 * tt + fr; const float bs = bsv[tt];
#pragma unroll
                for (int cp = 0; cp < 2; ++cp) { const int c0 = cw + 32 * cp + 8 * fq;
                    const u32x4 ur = urv[i][cp];
                    u32x4 o;
                    o.x = cvt_pk_bf16(gelu_f(bflo(ur.x)) * (acc[2 * cp][tt][0] + bs), gelu_f(bfhi(ur.x)) * (acc[2 * cp][tt][1] + bs));
                    o.y = cvt_pk_bf16(gelu_f(bflo(ur.y)) * (acc[2 * cp][tt][2] + bs), gelu_f(bfhi(ur.y)) * (acc[2 * cp][tt][3] + bs));
                    o.z = cvt_pk_bf16(gelu_f(bflo(ur.z)) * (acc[2 * cp + 1][tt][0] + bs), gelu_f(bfhi(ur.z)) * (acc[2 * cp + 1][tt][1] + bs));
                    o.w = cvt_pk_bf16(gelu_f(bflo(ur.w)) * (acc[2 * cp + 1][tt][2] + bs), gelu_f(bfhi(ur.w)) * (acc[2 * cp + 1][tt][3] + bs));
                    *(u32x4*)(sgu + (tok0 + t) * 512 + c0) = o; } }
        }
    }
    __syncthreads();
}

__device__ __forceinline__ void phase_merge(Frame& F) {
    const bf16_t* part = (const bf16_t*)F.a->out; const bf16_t* sgu = part + (size_t)3 * NTOK * 512;
    const float* lse = WSP(F, WS_LSE, float); bf16_t* mixed = WSP(F, WS_A, bf16_t);
    const float* goa = F.a->in[I_GOA]; const float* gos = F.a->in[I_GOS];
    const int lane = F.lane, gw = F.vcu * 8 + F.wave, NGW = F.G * 8, h = lane >> 3;
    const f32x4 ga0 = *(const f32x4*)(goa + 8 * lane), ga1 = *(const f32x4*)(goa + 8 * lane + 4), gs0 = *(const f32x4*)(gos + 8 * lane), gs1 = *(const f32x4*)(gos + 8 * lane + 4);
    constexpr int NT = 2;
#pragma unroll 1
    for (int mb = gw; mb < NTOK; mb += NT * NGW) {
        float lv[NT][3]; u32x4 pv[NT][3], sr[NT];
#pragma unroll
        for (int t = 0; t < NT; ++t) { const int m = mb + t * NGW;
#pragma unroll
            for (int k = 0; k < 3; ++k) { lv[t][k] = lse[((size_t)k * NTOK + m) * 8 + h]; pv[t][k] = *(const u32x4*)(part + ((size_t)k * NTOK + m) * 512 + 8 * lane); }
            sr[t] = *(const u32x4*)(sgu + (size_t)m * 512 + 8 * lane); }
        float a[NT][8], sv[NT][8], sqa[NT], sqs[NT];
#pragma unroll
        for (int t = 0; t < NT; ++t) {
            const float mx = fmaxf(lv[t][0], fmaxf(lv[t][1], lv[t][2]));
            float w0 = fast_exp2(lv[t][0] - mx), w1 = fast_exp2(lv[t][1] - mx), w2 = fast_exp2(lv[t][2] - mx);
            const float iw = 1.f / (w0 + w1 + w2); w0 *= iw; w1 *= iw; w2 *= iw;
            sqa[t] = 0.f; sqs[t] = 0.f;
#pragma unroll
            for (int j = 0; j < 4; ++j) { a[t][2 * j] = w0 * bflo(pv[t][0][j]) + w1 * bflo(pv[t][1][j]) + w2 * bflo(pv[t][2][j]); a[t][2 * j + 1] = w0 * bfhi(pv[t][0][j]) + w1 * bfhi(pv[t][1][j]) + w2 * bfhi(pv[t][2][j]);
                sv[t][2 * j] = bflo(sr[t][j]); sv[t][2 * j + 1] = bfhi(sr[t][j]); }
#pragma unroll
            for (int j = 0; j < 8; ++j) { sqa[t] += a[t][j] * a[t][j]; sqs[t] += sv[t][j] * sv[t][j]; }
        }
#pragma unroll
        for (int t = 0; t < NT; ++t) { sqa[t] = wave_sum(sqa[t]); sqs[t] = wave_sum(sqs[t]); }
#pragma unroll
        for (int t = 0; t < NT; ++t) { const int m = mb + t * NGW;
            const float rsa = 1.f / sqrtf(sqa[t] * (1.f / 512.f) + EPS), rss = 1.f / sqrtf(sqs[t] * (1.f / 512.f) + EPS);
            float oa[8], os[8];
            oa[0] = a[t][0] * rsa * ga0.x; oa[1] = a[t][1] * rsa * ga0.y; oa[2] = a[t][2] * rsa * ga0.z; oa[3] = a[t][3] * rsa * ga0.w;
            oa[4] = a[t][4] * rsa * ga1.x; oa[5] = a[t][5] * rsa * ga1.y; oa[6] = a[t][6] * rsa * ga1.z; oa[7] = a[t][7] * rsa * ga1.w;
            os[0] = sv[t][0] * rss * gs0.x; os[1] = sv[t][1] * rss * gs0.y; os[2] = sv[t][2] * rss * gs0.z; os[3] = sv[t][3] * rss * gs0.w;
            os[4] = sv[t][4] * rss * gs1.x; os[5] = sv[t][5] * rss * gs1.y; os[6] = sv[t][6] * rss * gs1.z; os[7] = sv[t][7] * rss * gs1.w;
#pragma unroll
            for (int j = 0; j < 8; ++j) { oa[j] = fminf(fmaxf(oa[j], -448.f), 448.f); os[j] = fminf(fmaxf(os[j], -448.f), 448.f); }
            u32x2 wa, wsg;
            { int w0 = __builtin_amdgcn_cvt_pk_fp8_f32(oa[0], oa[1], 0, false); w0 = __builtin_amdgcn_cvt_pk_fp8_f32(oa[2], oa[3], w0, true);
              int w1 = __builtin_amdgcn_cvt_pk_fp8_f32(oa[4], oa[5], 0, false); w1 = __builtin_amdgcn_cvt_pk_fp8_f32(oa[6], oa[7], w1, true); wa.x = (unsigned)w0; wa.y = (unsigned)w1; }
            { int w0 = __builtin_amdgcn_cvt_pk_fp8_f32(os[0], os[1], 0, false); w0 = __builtin_amdgcn_cvt_pk_fp8_f32(os[2], os[3], w0, true);
              int w1 = __builtin_amdgcn_cvt_pk_fp8_f32(os[4], os[5], 0, false); w1 = __builtin_amdgcn_cvt_pk_fp8_f32(os[6], os[7], w1, true); wsg.x = (unsigned)w0; wsg.y = (unsigned)w1; }
            unsigned char* mrow = (unsigned char*)mixed + (size_t)m * D;
            *(u32x2*)(mrow + 8 * lane) = wa;
            *(u32x2*)(mrow + 512 + 8 * lane) = wsg; }
    }
}

__device__ __forceinline__ float wave_max_bcast(float v) {
    const float ninf = -INFINITY;
    v = fmaxf(v, dpp_f<0x111>(ninf, v)); v = fmaxf(v, dpp_f<0x112>(ninf, v)); v = fmaxf(v, dpp_f<0x114>(ninf, v)); v = fmaxf(v, dpp_f<0x118>(ninf, v));
    v = fmaxf(v, dpp_f<0x142, 0xa>(ninf, v)); v = fmaxf(v, dpp_f<0x143, 0xc>(ninf, v));
    return __builtin_bit_cast(float, __builtin_amdgcn_readlane(__builtin_bit_cast(int, v), 63));
}
__device__ __forceinline__ void router_topk(Frame& F, int tile) {
    const float* logits = WSP(F, WS_B, float); const float* br = F.a->in[I_BR];
    int* tk_e = WSP(F, WS_TOPK_E, int); float* tk_g = WSP(F, WS_TOPK_G, float); int* tk_p = WSP(F, WS_TOPK_P, int);
    int* gcnt = (int*)(F.a->ws + WS_CTL + CTL_CNT);
    LAS int* hist = (LAS int*)F.lds; LAS int* base = hist + 256;
    const int lane = F.lane, w = F.wave;
    if (F.tid < 256) hist[F.tid] = 0;
    __syncthreads();
    const f32x4 bias = *(const f32x4*)(br + 4 * lane);
    f32x4 lgn = *(const f32x4*)(logits + (size_t)(tile * 256 + w * 32) * 256 + 4 * lane);
    for (int i = 0; i < 32; ++i) {
        const int tok = tile * 256 + w * 32 + i;
        const f32x4 lg = lgn;
        if (i + 1 < 32) lgn = *(const f32x4*)(logits + (size_t)(tok + 1) * 256 + 4 * lane);
        float sc[4], ch[4];
#pragma unroll
        for (int j = 0; j < 4; ++j) { sc[j] = 1.f / (1.f + __expf(-lg[j])); ch[j] = sc[j] + bias[j]; }
        float t1 = fmaxf(ch[0], ch[1]), t2 = fminf(ch[0], ch[1]);
        { const float a = fmaxf(ch[2], ch[3]), b = fminf(ch[2], ch[3]); const float n1 = fmaxf(t1, a), n2 = fmaxf(fminf(t1, a), fmaxf(t2, b)); t1 = n1; t2 = n2; }
        { const float a = dpp_f<0xB1>(t1, t1), b = dpp_f<0xB1>(t2, t2); const float n1 = fmaxf(t1, a), n2 = fmaxf(fminf(t1, a), fmaxf(t2, b)); t1 = n1; t2 = n2; }
        { const float a = dpp_f<0x4E>(t1, t1), b = dpp_f<0x4E>(t2, t2); const float n1 = fmaxf(t1, a), n2 = fmaxf(fminf(t1, a), fmaxf(t2, b)); t1 = n1; t2 = n2; }
        { const float a = dpp_f<0x141>(t1, t1), b = dpp_f<0x141>(t2, t2); const float n1 = fmaxf(t1, a), n2 = fmaxf(fminf(t1, a), fmaxf(t2, b)); t1 = n1; t2 = n2; }
        const float gs = t1 + t2; int ngt = 0;
#pragma unroll
        for (int j = 0; j < 8; ++j) { const float o = __builtin_bit_cast(float, __builtin_amdgcn_readlane(__builtin_bit_cast(int, gs), 8 * j)); ngt += (o > gs) ? 1 : 0; }
        const bool keep = ngt < 4;
#pragma unroll
        for (int j = 0; j < 4; ++j) ch[j] = keep ? ch[j] : -INFINITY;
        int my_e = 0; float my_s = 0.f;
#pragma unroll 1
        for (int k = 0; k < 8; ++k) {
            float bv = ch[0]; int bj = 0; float bs = sc[0];
#pragma unroll
            for (int j = 1; j < 4; ++j) if (ch[j] > bv) { bv = ch[j]; bj = j; bs = sc[j]; }
            const float M = wave_max_bcast(bv);
            const unsigned long long hit = __ballot(bv == M);
            const int owner = __builtin_ctzll(hit);
            const int be = __builtin_amdgcn_readlane(4 * lane + bj, owner);
            const float bsc = __builtin_bit_cast(float, __builtin_amdgcn_readlane(__builtin_bit_cast(int, bs), owner));
            if (lane == k) { my_e = be; my_s = bsc; }
            if (lane == owner) {
#pragma unroll
                for (int j = 0; j < 4; ++j) if (bj == j) ch[j] = -INFINITY;
            }
        }
        float ssum = my_s;
        ssum += dpp_f<0xB1>(0.f, ssum); ssum += dpp_f<0x4E>(0.f, ssum); ssum += dpp_f<0x141>(0.f, ssum);
        if (lane < 8) {
            const int p = __hip_atomic_fetch_add(&hist[my_e], 1, __ATOMIC_RELAXED, __HIP_MEMORY_SCOPE_WORKGROUP);
            tk_e[(size_t)tok * 8 + lane] = my_e; tk_g[(size_t)tok * 8 + lane] = my_s / ssum * 2.5f; tk_p[(size_t)tok * 8 + lane] = p;
        }
    }
    __syncthreads();
    const int chunk = (tile * 256) / CHT;
    if (F.tid < 256) { const int c = hist[F.tid]; base[F.tid] = c > 0 ? atomicAdd(&gcnt[chunk * NE + F.tid], c) : 0; }
    __syncthreads();
    {
      const size_t e0 = (size_t)(tile * 256 + w * 32) * 8 + 4 * lane;
      const i32x4 e4 = *(const i32x4*)(tk_e + e0); i32x4 p4 = *(const i32x4*)(tk_p + e0);
      p4.x += base[e4.x]; p4.y += base[e4.y]; p4.z += base[e4.z]; p4.w += base[e4.w];
      *(i32x4*)(tk_p + e0) = p4; }
    __syncthreads();
}

__device__ __forceinline__ void phase_dispatch(Frame& F) {
    const int* gcnt = (const int*)(F.a->ws + WS_CTL + CTL_CNT);
    LAS int* off = (LAS int*)F.lds;
    LAS int* tst = off + NCH * NE;
    LAS int* cnt = tst + NCH * NE;
    LAS int* ntl = cnt + NCH * NE;
    for (int i = F.tid; i < NCH * NE; i += NTHR) cnt[i] = gcnt[i];
    __syncthreads();
    if (F.wave < NCH) {
        const int c = F.wave; int cv[4], tv[4], so = 0, st = 0;
#pragma unroll
        for (int j = 0; j < 4; ++j) { cv[j] = cnt[c * NE + 4 * F.lane + j]; tv[j] = (cv[j] + 255) >> 8; so += cv[j]; st += tv[j]; }
        int io = so, it = st;
#define ISCAN(v) do { v += __builtin_amdgcn_update_dpp(0, v, 0x111, 0xf, 0xf, false); v += __builtin_amdgcn_update_dpp(0, v, 0x112, 0xf, 0xf, false); v += __builtin_amdgcn_update_dpp(0, v, 0x114, 0xf, 0xf, false); \
        v += __builtin_amdgcn_update_dpp(0, v, 0x118, 0xf, 0xf, false); v += __builtin_amdgcn_update_dpp(0, v, 0x142, 0xa, 0xf, false); v += __builtin_amdgcn_update_dpp(0, v, 0x143, 0xc, 0xf, false); } while (0)
        ISCAN(io); ISCAN(it);
#undef ISCAN
        int o = io - so, t = it - st;
#pragma unroll
        for (int j = 0; j < 4; ++j) { off[c * NE + 4 * F.lane + j] = o; tst[c * NE + 4 * F.lane + j] = t; o += cv[j]; t += tv[j]; }
        if (F.lane == 63) ntl[c] = it;
    }
    __syncthreads();
    int* te = WSP(F, WS_TILE, int); int* trow0 = te + NCH * MAXTILES; int* tnv = trow0 + NCH * MAXTILES; int* ntiles = tnv + NCH * MAXTILES;
    if (blockIdx.x < NCH) { const int c = blockIdx.x;
        for (int e = F.tid; e < NE; e += NTHR) { const int n = cnt[c * NE + e], t0 = tst[c * NE + e], o = off[c * NE + e];
            for (int m = 0; m * 256 < n; ++m) { te[c * MAXTILES + t0 + m] = e; trow0[c * MAXTILES + t0 + m] = o + 256 * m; tnv[c * MAXTILES + t0 + m] = (n - 256 * m) < 256 ? (n - 256 * m) : 256; } }
        const int nr = ntl[c];
        for (int m = F.tid; m < CHT / 256; m += NTHR) { te[c * MAXTILES + nr + m] = NE; trow0[c * MAXTILES + nr + m] = CH_ROUTED + 256 * m; tnv[c * MAXTILES + nr + m] = 256; }
        if (F.tid == 0) ntiles[c] = nr + CHT / 256;
    }
    const int* tk_e = WSP(F, WS_TOPK_E, int); int* tk_p = WSP(F, WS_TOPK_P, int);
    int* rowtok = WSP(F, WS_ROWTOK, int);
    for (int a = blockIdx.x * NTHR + F.tid; a < NTOK * 8; a += F.G * NTHR) { const int tok = a >> 3, c = tok / CHT;
        const int e = tk_e[a], slot = off[c * NE + e] + tk_p[a];
        rowtok[(size_t)c * CH_ROUTED + slot] = tok; tk_p[a] = slot; }
    __syncthreads();
}

__device__ __forceinline__ void phase_combine(Frame& F, int chunk) {
    const unsigned char* Y = WSP(F, WS_B, unsigned char); const int* slot = WSP(F, WS_TOPK_P, int); const float* tkg = WSP(F, WS_TOPK_G, float);
    const float* mod = WSP(F, WS_MOD, float); const float* gf = F.a->in[I_GFIN];
    const int lane = F.lane, gw = F.vcu * 8 + F.wave, NGW = F.G * 8, c0 = 16 * lane;
    typedef float f32x2 __attribute__((ext_vector_type(2)));
    typedef int i32x4 __attribute__((ext_vector_type(4)));
    int mi = gw;
    if (mi >= CHT) return;
    i32x4 rn0, rn1; f32x4 gn0, gn1;
    { const size_t m = (size_t)chunk * CHT + mi; rn0 = *(const i32x4*)(slot + m * 8); rn1 = *(const i32x4*)(slot + m * 8 + 4); gn0 = *(const f32x4*)(tkg + m * 8); gn1 = *(const f32x4*)(tkg + m * 8 + 4); }
#pragma unroll 1
    for (; mi < CHT; mi += NGW) { const int m = chunk * CHT + mi, b = m / SEQ;
        const i32x4 r0 = rn0, r1 = rn1; const f32x4 g0 = gn0 * (1.f / YSCALE), g1 = gn1 * (1.f / YSCALE);
        u32x4 yv[9];
        yv[0] = *(const u32x4*)(Y + (size_t)r0.x * D + c0); yv[1] = *(const u32x4*)(Y + (size_t)r0.y * D + c0); yv[2] = *(const u32x4*)(Y + (size_t)r0.z * D + c0); yv[3] = *(const u32x4*)(Y + (size_t)r0.w * D + c0);
        yv[4] = *(const u32x4*)(Y + (size_t)r1.x * D + c0); yv[5] = *(const u32x4*)(Y + (size_t)r1.y * D + c0); yv[6] = *(const u32x4*)(Y + (size_t)r1.z * D + c0); yv[7] = *(const u32x4*)(Y + (size_t)r1.w * D + c0);
        yv[8] = *(const u32x4*)(Y + (size_t)(CH_ROUTED + mi) * D + c0);
        float* hrow = F.a->out + (size_t)m * D;
        f32x4 hv[4];
        { const bf16_t* hb = h_row(F.a->out, F.a->ws, m) + c0; const u32x4 ha = *(const u32x4*)hb, hc = *(const u32x4*)(hb + 8);
          hv[0] = (f32x4){bflo(ha.x), bfhi(ha.x), bflo(ha.y), bfhi(ha.y)}; hv[1] = (f32x4){bflo(ha.z), bfhi(ha.z), bflo(ha.w), bfhi(ha.w)};
          hv[2] = (f32x4){bflo(hc.x), bfhi(hc.x), bflo(hc.y), bfhi(hc.y)}; hv[3] = (f32x4){bflo(hc.z), bfhi(hc.z), bflo(hc.w), bfhi(hc.w)}; }
        if (mi + NGW < CHT) { const size_t mn = (size_t)m + NGW; rn0 = *(const i32x4*)(slot + mn * 8); rn1 = *(const i32x4*)(slot + mn * 8 + 4); gn0 = *(const f32x4*)(tkg + mn * 8); gn1 = *(const f32x4*)(tkg + mn * 8 + 4); }
        const float gk[9] = {g0.x, g0.y, g0.z, g0.w, g1.x, g1.y, g1.z, g1.w, 1.f / YSCALE};
        f32x4 acc[4];
#pragma unroll
        for (int i = 0; i < 4; ++i) acc[i] = (f32x4){0.f, 0.f, 0.f, 0.f};
#pragma unroll
        for (int k = 0; k < 9; ++k)
#pragma unroll
            for (int i = 0; i < 4; ++i) { const f32x2 lo = __builtin_amdgcn_cvt_pk_f32_fp8((int)yv[k][i], false), hi = __builtin_amdgcn_cvt_pk_f32_fp8((int)yv[k][i], true);
                acc[i].x += gk[k] * lo.x; acc[i].y += gk[k] * lo.y; acc[i].z += gk[k] * hi.x; acc[i].w += gk[k] * hi.y; }
        float sq = 0.f;
#pragma unroll
        for (int i = 0; i < 4; ++i) { const f32x4 g2 = *(const f32x4*)(mod + b * 6144 + 5120 + c0 + 4 * i);
            hv[i] = hv[i] + g2 * acc[i];
            sq += (hv[i].x * hv[i].x + hv[i].y * hv[i].y) + (hv[i].z * hv[i].z + hv[i].w * hv[i].w); }
        const float rs = 1.f / sqrtf(wave_sum(sq) * (1.f / D) + EPS);
#pragma unroll
        for (int i = 0; i < 4; ++i) *(f32x4*)(hrow + c0 + 4 * i) = hv[i] * rs * *(const f32x4*)(gf + c0 + 4 * i);
    }
}

constexpr int N_PHASES = 9 + 3 * NCH;
#ifndef REP_MASK
#define REP_MASK 0u
#endif
#define NREP(k) (1 + (int)((REP_MASK >> (k)) & 1u))
#ifndef PROBE_KIND
#define PROBE_KIND 0
#endif
__global__ void __launch_bounds__(NTHR, 2) hybrid_fwd(Args args) {
    extern __shared__ __attribute__((aligned(16))) unsigned char lds_raw[];
    LAS unsigned char* const lds = (LAS unsigned char*)lds_raw;
    volatile LAS unsigned* MISC = (volatile LAS unsigned*)(lds + MISC_OFF);
    if (threadIdx.x < 64) MISC[threadIdx.x] = 0u;
    __syncthreads();
    XcdBarrier bar; bar.bar = (unsigned*)(args.ws + WS_CTL); bar.x = 0; bar.st = nullptr;
    const int lo = args.ph_lo, hi = args.ph_hi;
    if (hi - lo > 1) bar = xcd_barrier_post((unsigned*)(args.ws + WS_CTL), MISC + 8);
#define IN(k) (lo <= (k) && (k) < hi)
#define SEAM(k) do { if (IN(k) && IN((k) + 1)) xcd_barrier(bar); } while (0)

    if (IN(0)) { for (int rep = 0; rep < NREP(0); ++rep) { Frame F = make_frame(lds); phase_mod(F); } } SEAM(0);
    if (IN(1)) { for (int rep = 0; rep < NREP(1); ++rep) { Frame F = make_frame(lds); phase_prep(F); } } SEAM(1);
    if (IN(2)) for (int rep = 0; rep < NREP(2); ++rep) {
        const bool conv_first = (blockIdx.x >> 3) & 1;
        if (conv_first && rep == 0) { Frame F = make_frame(lds); convert_experts(F, 0, CONV_ITEMS); }
        { Frame F = make_frame(lds);
        pg8::DenseSched<512> S; S.init(F.a->ws + WS_A, F.a->ws + WS_WTIN, NTOK, NPROJ, F.G, (int)blockIdx.x, F.tid);
        EpiBf16T<true> E{WSP(F, WS_B, bf16_t), NPROJ};
        pg8::gemm_phase<512, EpiBf16T<true>, pg8::DenseSched<512>, true, true>(F.lds, F.tid, S, E); }
        if (!conv_first && rep == 0) { Frame F = make_frame(lds); convert_experts(F, 0, CONV_ITEMS); }
    } SEAM(2);
    if (IN(3)) { for (int rep = 0; rep < NREP(3); ++rep) { Frame F = make_frame(lds); phase_attn(F); } for (int rep = 0; rep < NREP(21); ++rep) { Frame F = make_frame(lds); phase_sgu(F); } } SEAM(3);
    if (IN(4)) { for (int rep = 0; rep < NREP(4); ++rep) { Frame F = make_frame(lds); phase_merge(F); } } SEAM(4);
    if (IN(5)) for (int rep = 0; rep < NREP(5); ++rep) {
        Frame F = make_frame(lds);
        pg8::DenseSched<512> S; S.init(F.a->ws + WS_A, F.a->ws + WS_WTOUT, NTOK, D, F.G, (int)blockIdx.x, F.tid);
        EpiResH E{F.a->in[I_X], WSP(F, WS_MOD, float) + 2048, F.a->out, F.a->ws};
        pg8::gemm_phase<512, EpiResH, pg8::DenseSched<512>, true, true>(F.lds, F.tid, S, E);
    } SEAM(5);
    if (IN(7)) {
        Frame F = make_frame(lds);
        pg8::DenseSched<1024> S; S.init(F.a->ws + WS_A, F.a->ws + WS_WTR, NTOK, NE, F.G, (int)blockIdx.x, F.tid);
        { const float* mod = WSP(F, WS_MOD, float); bf16_t* n2 = WSP(F, WS_A, bf16_t); Unit u0;
          for (int i = 0; S.next(i, u0); ++i) for (int r = 4 * F.wave; r < 256; r += 32) { const int m = u0.t * 256 + r, b = m / SEQ;
              norm_mod_rows<4, true>(h_row(F.a->out, F.a->ws, m), D, F.a->in[I_GFFN], mod + b * 6144 + 3072, mod + b * 6144 + 4096, n2 + (size_t)m * D, D, F.lane, WSP(F, WS_N2F8, unsigned char) + (size_t)m * D); }
          asm volatile("s_waitcnt vmcnt(0)" ::: "memory"); __syncthreads(); }
        EpiF32 E{WSP(F, WS_B, float), NE};
        pg8::gemm_phase<1024, EpiF32, pg8::DenseSched<1024>, true, true>(F.lds, F.tid, S, E);
        asm volatile("s_waitcnt vmcnt(0)" ::: "memory"); __syncthreads();
        Unit u; for (int i = 0; S.next(i, u); ++i) router_topk(F, u.t);
    } SEAM(7);
    if (IN(8)) { Frame F = make_frame(lds); phase_dispatch(F); } SEAM(8);
    const bool comb_late = (blockIdx.x >> 4) & 1;
#pragma unroll
    for (int c = 0; c < NCH; ++c) {
        if (IN(9 + 3 * c)) for (int rep = 0; rep < NREP(9); ++rep) {
            Frame F = make_frame(lds);
            const int* te = WSP(F, WS_TILE, int);
            TileTabs T; T.te = te + c * MAXTILES; T.trow0 = te + NCH * MAXTILES + c * MAXTILES; T.tnv = te + 2 * NCH * MAXTILES + c * MAXTILES;
            T.ntiles = __builtin_amdgcn_readfirstlane((te + 3 * NCH * MAXTILES)[c]);
            Gemm1Sched S; S.init(F.lds, F.a->ws + WS_N2F8, F.a->ws + WS_W1T, WSP(F, WS_ROWTOK, int) + (size_t)c * CH_ROUTED, T, c, F.tid);
            EpiAct E{WSP(F, WS_ACT, unsigned char)};
            pg8::gemm_phase<512, EpiAct, Gemm1Sched, true, true>(F.lds, F.tid, S, E, (NREP(9) > 1 && rep == 0) ? PROBE_KIND : 0);
        }
        if (c > 0 && comb_late && IN(11 + 3 * (c - 1))) { Frame F = make_frame(lds); phase_combine(F, c - 1); }
        SEAM(9 + 3 * c);
        if (IN(10 + 3 * c)) for (int rep = 0; rep < NREP(10); ++rep) {
            Frame F = make_frame(lds);
            const int* te = WSP(F, WS_TILE, int);
            TileTabs T; T.te = te + c * MAXTILES; T.trow0 = te + NCH * MAXTILES + c * MAXTILES; T.tnv = te + 2 * NCH * MAXTILES + c * MAXTILES;
            T.ntiles = __builtin_amdgcn_readfirstlane((te + 3 * NCH * MAXTILES)[c]);
            Gemm2Sched S; S.init(F.lds, F.a->ws + WS_ACT, F.a->ws + WS_W2T, nullptr, T, c, F.tid);
            EpiDown E{WSP(F, WS_B, unsigned char), F.lds, (NREP(10) > 1 && rep == 0 && (PROBE_KIND & 4)) ? 1 : 0};
            pg8::gemm_phase<128, EpiDown, Gemm2Sched, true, true>(F.lds, F.tid, S, E, (NREP(10) > 1 && rep == 0) ? PROBE_KIND : 0);
        } SEAM(10 + 3 * c);
        if (IN(11 + 3 * c) && !(c + 1 < NCH && comb_late)) { Frame F = make_frame(lds); phase_combine(F, c); }
    }
#undef IN
#undef SEAM
}

extern "C" void kernel_launch(void* const* d_in, const int* in_sizes, int n_in, void* d_out, int out_size, void* d_ws, size_t ws_size, hipStream_t stream) {
    static int grid = 0;
    if (grid == 0) {
        if (n_in != 23 || out_size != NTOK * D || ws_size < WS_END) { fprintf(stderr, "kernel_launch: unexpected shapes (n_in %d out %d ws %zu need %zu)\n", n_in, out_size, ws_size, (size_t)WS_END); grid = -1; return; }
        int dev = 0, cus = 0, per_cu = 0;
        if (hipGetDevice(&dev) != hipSuccess || hipDeviceGetAttribute(&cus, hipDeviceAttributeMultiprocessorCount, dev) != hipSuccess) { grid = -1; return; }
        if (hipFuncSetAttribute((const void*)hybrid_fwd, hipFuncAttributeMaxDynamicSharedMemorySize, LDS_BYTES) != hipSuccess) { fprintf(stderr, "kernel_launch: hipFuncSetAttribute failed\n"); grid = -1; return; }
        if (hipOccupancyMaxActiveBlocksPerMultiprocessor(&per_cu, (const void*)hybrid_fwd, NTHR, LDS_BYTES) != hipSuccess || per_cu < 1) fprintf(stderr, "kernel_launch: occupancy query says %d\n", per_cu);
        (void)hipGetLastError();
        grid = cus & ~7;
        if (grid <= 0) { grid = -1; return; }
    }
    if (grid < 0) return;
    if (hipMemsetAsync((char*)d_ws + WS_CTL, 0, CTL_BYTES, stream) != hipSuccess) return;
    Args a{};
    for (int i = 0; i < 23; ++i) a.in[i] = (const float*)d_in[i];
    a.out = (float*)d_out; a.ws = (unsigned char*)d_ws;
#if MK_MULTI
    for (int p = 0; p < N_PHASES; ++p) { a.ph_lo = p; a.ph_hi = p + 1; hipLaunchKernelGGL(hybrid_fwd, dim3(grid), dim3(NTHR), LDS_BYTES, stream, a); }
#else
    a.ph_lo = 0; a.ph_hi = N_PHASES;
    hipLaunchKernelGGL(hybrid_fwd, dim3(grid), dim3(NTHR), LDS_BYTES, stream, a);
#endif
    const hipError_t le = hipPeekAtLastError();
    if (le != hipSuccess) fprintf(stderr, "kernel_launch: launch failed: %s\n", hipGetErrorName(le));
}
```

```cpp
#include <hip/hip_runtime.h>
#include <cstdio>
#include <cstdint>

#ifndef MK_MULTI
#define MK_MULTI 0
#endif

#define GAS __attribute__((address_space(1)))
#define LAS __attribute__((address_space(3)))
#define CAS __attribute__((address_space(4)))
typedef unsigned short bf16_t;
typedef short bf16x8 __attribute__((ext_vector_type(8)));
typedef short s16x4 __attribute__((ext_vector_type(4)));
typedef float f32x4 __attribute__((ext_vector_type(4)));
typedef unsigned u32x4 __attribute__((ext_vector_type(4)));
typedef unsigned u32x2 __attribute__((ext_vector_type(2)));
typedef int i32x4 __attribute__((ext_vector_type(4)));
typedef int i32x8 __attribute__((ext_vector_type(8)));

constexpr int D = 1024, NBATCH = 16, SEQ = 4096, NTOK = NBATCH * SEQ;
constexpr int NPROJ = 2560;
constexpr int NE = 256, TOPK = 8, EDIM = 256;
constexpr int NCH = 2, CHT = NTOK / NCH;
constexpr int CH_ROUTED = CHT * TOPK;
constexpr int CH_ROWS = CH_ROUTED + CHT;
constexpr int MAXTILES = CH_ROUTED / 256 + NE + CHT / 256;
constexpr float W1_PRE = 64.f, W2_PRE = 8.f, ACT_PRE = 4.f;
constexpr int E8M0_ONE = 127;
constexpr int SC_W1 = (E8M0_ONE - 6) * 0x01010101, SC_W2 = (E8M0_ONE - 3) * 0x01010101, SC_ACT = (E8M0_ONE - 2) * 0x01010101, SC_N2 = E8M0_ONE * 0x01010101;
constexpr float YSCALE = 8.f;
constexpr float EPS = 1e-6f;
constexpr float LOG2E = 1.4426950408889634f;

constexpr size_t WS_CTL = 0, CTL_BYTES = 65536;
constexpr size_t CTL_CNT = 16384;
constexpr size_t WS_MOD = 65536;
constexpr size_t WS_WSP = WS_MOD + 393216;
constexpr size_t WS_TILE = WS_WSP + 131072;
constexpr size_t TILE_TAB = (size_t)NCH * MAXTILES * 4;
constexpr size_t WS_OFFS = WS_TILE + 3 * TILE_TAB + 256;
constexpr size_t WS_WTIN = 1048576;
constexpr size_t WS_WTOUT = WS_WTIN + 5242880;
constexpr size_t WS_WTR = WS_WTOUT + 2097152;
constexpr size_t WS_TOPK_E = 9437184;
constexpr size_t WS_TOPK_G = WS_TOPK_E + 2097152;
constexpr size_t WS_TOPK_P = WS_TOPK_G + 2097152;
constexpr size_t WS_ROWTOK = WS_TOPK_P + 2097152;
constexpr size_t WS_W1T = WS_ROWTOK + 2097152;
constexpr size_t WS_W2T = WS_W1T + (size_t)257 * 524288;
constexpr size_t WS_A = WS_W2T + (size_t)257 * 262144;
constexpr size_t WS_B = WS_A + (size_t)NTOK * D * 2;
constexpr size_t WS_ACT = WS_B + (size_t)NTOK * NPROJ * 2;
constexpr size_t WS_LSE = WS_ACT;
constexpr size_t WS_H1 = WS_ACT + (size_t)(CH_ROWS + 256) * EDIM;
constexpr size_t WS_N2F8 = WS_H1 + (size_t)(NTOK / 2) * D * 2;
constexpr size_t WS_END = WS_N2F8 + (size_t)NTOK * D;
static_assert((size_t)(CH_ROWS + 256) * EDIM >= (size_t)3 * NTOK * 8 * 4, "lse fits the act region");
static_assert(WS_OFFS + 4096 <= WS_WTIN && WS_WTR + 524288 <= WS_TOPK_E && (WS_W1T % 256) == 0, "ws map");
static_assert((size_t)CH_ROWS * D <= (size_t)NTOK * NPROJ * 2, "Y chunk (fp8) fits region B");
static_assert(WS_END <= 1118000000ull, "workspace");

constexpr int LDS_BYTES = 155648;
constexpr int MISC_OFF = 153600;
constexpr int NTHR = 512;

__device__ __forceinline__ unsigned cvt_pk_bf16(float lo, float hi) { unsigned r; asm("v_cvt_pk_bf16_f32 %0, %1, %2" : "=v"(r) : "v"(lo), "v"(hi)); return r; }
__device__ __forceinline__ float bf2f(unsigned short b) { return __builtin_bit_cast(float, (unsigned)b << 16); }
__device__ __forceinline__ float bflo(unsigned w) { return __builtin_bit_cast(float, w << 16); }
__device__ __forceinline__ float bfhi(unsigned w) { return __builtin_bit_cast(float, w & 0xffff0000u); }
template <int CTRL, int ROW_MASK = 0xf>
__device__ __forceinline__ float dpp_f(float old, float v) { return __builtin_bit_cast(float, __builtin_amdgcn_update_dpp(__builtin_bit_cast(int, old), __builtin_bit_cast(int, v), CTRL, ROW_MASK, 0xf, false)); }
__device__ __forceinline__ float wave_sum(float v) {
    v += dpp_f<0x111>(0.f, v); v += dpp_f<0x112>(0.f, v); v += dpp_f<0x114>(0.f, v); v += dpp_f<0x118>(0.f, v);
    v += dpp_f<0x142, 0xa>(0.f, v); v += dpp_f<0x143, 0xc>(0.f, v);
    return __builtin_bit_cast(float, __builtin_amdgcn_readlane(__builtin_bit_cast(int, v), 63));
}
__device__ __forceinline__ float fast_exp2(float x) { return __builtin_amdgcn_exp2f(x); }
__device__ __forceinline__ float fast_rcp(float x) { return __builtin_amdgcn_rcpf(x); }
__device__ __forceinline__ float silu_f(float x) { return x * fast_rcp(1.f + fast_exp2(-x * LOG2E)); }
__device__ __forceinline__ float gelu_f(float x) { const float y2 = 2.3022082f * (x + 0.044715f * x * x * x); return x * fast_rcp(1.f + fast_exp2(-y2)); }

#define XB_TMO      128
#define XB_XCNT(j)  (256  + 64 * (j))
#define XB_XSUB(j)  (1280 + 64 * (j))
#define XB_XGEN(j)  (2304 + 64 * (j))
#define XB_TOP      3328
#define XB_TOPGEN   3392
#define XCD_BAR_WORDS 3456
#define XB_SPIN_CAP (1u << 20)
__device__ __forceinline__ unsigned xb_ld(unsigned* p)              { return __hip_atomic_load(p, __ATOMIC_RELAXED, __HIP_MEMORY_SCOPE_AGENT); }
__device__ __forceinline__ unsigned xb_add(unsigned* p, unsigned v) { return __hip_atomic_fetch_add(p, v, __ATOMIC_RELAXED, __HIP_MEMORY_SCOPE_AGENT); }
__device__ __forceinline__ unsigned xb_xcc_id() { return (unsigned)__builtin_amdgcn_s_getreg((3 << 11) | 20) & 0xFu; }
#define XB_SPIN(cond, bar) do { unsigned _sp = 0; while (cond) { __builtin_amdgcn_s_sleep(1); \
    if ((++_sp & 255u) == 0u) { if (xb_ld(&(bar)[XB_TMO])) break; if (_sp > XB_SPIN_CAP) { atomicAdd(&(bar)[XB_TMO], 1u); break; } } } } while (0)
struct XcdBarrier { unsigned* bar; unsigned x; volatile LAS unsigned* st; };
__device__ __forceinline__ XcdBarrier xcd_barrier_post(unsigned* bar, volatile LAS unsigned* st) {
    XcdBarrier b; b.bar = bar; b.x = xb_xcc_id(); b.st = st;
    if (threadIdx.x == 0) (void)xb_add(&bar[XB_XCNT(b.x)], 1u);
    return b;
}
__device__ __forceinline__ void xcd_barrier_complete(unsigned* bar, unsigned x, unsigned& nloc, unsigned& nx) {
    const unsigned G = gridDim.x * gridDim.y * gridDim.z;
    unsigned sum, cnt, mine, sp = 0u;
    for (;;) {
        sum = 0u; cnt = 0u; mine = 0u;
#pragma unroll
        for (unsigned j = 0; j < 16; ++j) { const unsigned c = xb_ld(&bar[XB_XCNT(j)]); sum += c; cnt += (c > 0u) ? 1u : 0u; mine = (j == x) ? c : mine; }
        if (sum == G) break;
        __builtin_amdgcn_s_sleep(1);
        if ((++sp & 255u) == 0u) { if (xb_ld(&bar[XB_TMO])) break; if (sp > XB_SPIN_CAP) { atomicAdd(&bar[XB_TMO], 1u); break; } }
    }
    nloc = mine > 0u ? mine : 1u; nx = cnt > 0u ? cnt : 1u;
}
__device__ __forceinline__ void xcd_barrier(const XcdBarrier& b) {
    asm volatile("s_waitcnt vmcnt(0)" ::: "memory");
    __syncthreads();
    if (threadIdx.x == 0) {
        unsigned* bar = b.bar;
        __builtin_amdgcn_s_waitcnt(0);
        unsigned nloc = b.st[0], nx = b.st[1];
        if (nloc == 0u) { xcd_barrier_complete(bar, b.x, nloc, nx); b.st[0] = nloc; b.st[1] = nx; }
        const unsigned old = xb_add(&bar[XB_XSUB(b.x)], 1u);
        const unsigned gen = old / nloc;
        if (old + 1u == (gen + 1u) * nloc) {
            __builtin_amdgcn_fence(__ATOMIC_RELEASE, "agent");
            asm volatile("s_waitcnt vmcnt(0)" ::: "memory");
            const unsigned og = xb_add(&bar[XB_TOP], 1u);
            const unsigned tg = og / nx;
            if (og + 1u == (tg + 1u) * nx) xb_add(&bar[XB_TOPGEN], 1u);
            else XB_SPIN(xb_ld(&bar[XB_TOPGEN]) == tg, bar);
            __builtin_amdgcn_fence(__ATOMIC_ACQUIRE, "agent");
            xb_add(&bar[XB_XGEN(b.x)], 1u);
            asm volatile("s_waitcnt vmcnt(0)" ::: "memory");
        } else {
            XB_SPIN(xb_ld(&bar[XB_XGEN(b.x)]) == gen, bar);
            __builtin_amdgcn_fence(__ATOMIC_ACQUIRE, "agent");
            asm volatile("s_waitcnt vmcnt(0)" ::: "memory");
        }
    }
    __syncthreads();
}

struct Args { const float* in[23]; float* out; unsigned char* ws; int ph_lo, ph_hi; };
__device__ __forceinline__ bf16_t* h_row(float* out, unsigned char* ws, int m) {
    return m < NTOK / 2 ? (bf16_t*)((unsigned char*)out + (size_t)NTOK * D * 2) + (size_t)m * D : (bf16_t*)(ws + WS_H1) + (size_t)(m - NTOK / 2) * D; }
enum { I_X = 0, I_C, I_WADA, I_BADA, I_GMIX, I_WIN, I_LNG, I_LNB, I_WSP, I_BSP, I_GOA, I_GOS, I_WOUT, I_GFFN, I_WR, I_BR, I_WEG, I_WEU, I_WED, I_WSG, I_WSU, I_WSD, I_GFIN };

namespace pg8 {
constexpr int BM = 256, BK = 64, HALF = 128, HTB = HALF * BK * 2, STAGE_BYTES = 8 * HTB;
__device__ __forceinline__ int lds_byte(int r, int c) { const int st = (r >> 4) * 2 + (c >> 5), rr = r & 15, cc = c & 31, ob = rr * 64 + cc * 2; return st * 1024 + (ob ^ (((ob >> 9) & 1) << 5)); }
__device__ __forceinline__ void stage_rc(int b, int& R, int& C) { const int st = b / 1024, sb = b % 1024, swz = sb ^ (((sb >> 9) & 1) << 5); R = (st >> 1) * 16 + swz / 64; C = (st & 1) * 32 + (swz % 64) / 2; }
__device__ __forceinline__ int perm32(int rho) { const int n = rho >> 4, i = rho & 15; return 8 * (i >> 2) + 4 * n + (i & 3); }

struct Unit { int t, nt, row0, nv, e; };

template <int K, class Epi, class Sched, bool ALIGN_EPI, bool SP2>
__device__ __forceinline__ void gemm_phase(LAS unsigned char* lds, const int tid, const Sched& S, const Epi& E, const int probe = 0) {
    const int wid = __builtin_amdgcn_readfirstlane(tid >> 6), lane = tid & 63, wr = wid >> 2, wc = wid & 3, fr = lane & 15, fq = lane >> 4;
    constexpr int nt = K / BK;
    unsigned voffB[2];
#pragma unroll
    for (int i = 0; i < 2; ++i) { int R, C; stage_rc(tid * 16 + i * 8192, R, C);
        const int Rb = Epi::COL16 ? (64 * (R >> 5) + 16 * ((R & 15) >> 2) + 4 * ((R >> 4) & 1) + (R & 3)) : ((R & ~31) + perm32(R & 31));
        voffB[i] = (unsigned)(Rb * K + C) * 2u; }
    constexpr size_t kstep = (size_t)(BK * 2);
    constexpr size_t hstep = (size_t)HALF * K * 2;
    constexpr size_t bstep = Epi::COL16 ? (size_t)8 * K * 2 : hstep;
    const unsigned ldsw = (unsigned)wid * 1024u;
    const int aoff = lds_byte(wr * 64 + fr, fq * 8), boff = lds_byte(wc * 32 + fr, fq * 8);
#define PG8_SA(b, h) (((b) * 2 + (h)) * HTB)
#define PG8_SB(b, h) ((4 + (b) * 2 + (h)) * HTB)
#define PG8_STAGE(bufoff, gbase, voff) do { _Pragma("unroll") for (int _i = 0; _i < 2; ++_i) \
        __builtin_amdgcn_global_load_lds((const unsigned*)((const char*)(gbase) + (voff)[_i]), (LAS unsigned*)(lds + (bufoff) + ldsw + _i * 8192), 16, 0, 0); } while (0)
#define PG8_LDA(dst, b, h) do { _Pragma("unroll") for (int m = 0; m < 4; ++m) _Pragma("unroll") for (int k = 0; k < 2; ++k) dst[m][k] = *(const LAS bf16x8*)(lds + PG8_SA(b, h) + aoff + m * 2048 + k * 1024); } while (0)
#define PG8_LDB(dst, b, h) do { _Pragma("unroll") for (int n = 0; n < 2; ++n) _Pragma("unroll") for (int k = 0; k < 2; ++k) dst[n][k] = *(const LAS bf16x8*)(lds + PG8_SB(b, h) + boff + n * 2048 + k * 1024); } while (0)
#define PG8_MMA(ai, bj, At, Bt) do { if (probe & 1) break; __builtin_amdgcn_s_setprio(1); _Pragma("unroll") for (int m = 0; m < 4; ++m) _Pragma("unroll") for (int n = 0; n < 2; ++n) { \
        if constexpr (Epi::F8) { \
            const i32x8 wa_ = __builtin_shufflevector(__builtin_bit_cast(i32x4, Bt[n][0]), __builtin_bit_cast(i32x4, Bt[n][1]), 0, 1, 2, 3, 4, 5, 6, 7); \
            const i32x8 xa_ = __builtin_shufflevector(__builtin_bit_cast(i32x4, At[m][0]), __builtin_bit_cast(i32x4, At[m][1]), 0, 1, 2, 3, 4, 5, 6, 7); \
            asm volatile("v_mfma_scale_f32_16x16x128_f8f6f4 %0, %1, %2, %0, %3, %4 op_sel_hi:[0,0,0]" : "+v"(acc[ai][bj][m][n]) : "v"(wa_), "v"(xa_), "v"(scw_), "v"(scx_)); \
        } else { _Pragma("unroll") for (int k = 0; k < 2; ++k) acc[ai][bj][m][n] = __builtin_amdgcn_mfma_f32_16x16x32_bf16(Bt[n][k], At[m][k], acc[ai][bj][m][n], 0, 0, 0); } } \
        __builtin_amdgcn_s_setprio(0); } while (0)
#define PG8_WAIT_V(n) asm volatile("s_waitcnt vmcnt(" #n ")" ::: "memory")
#define PG8_WAIT_L(n) asm volatile("s_waitcnt lgkmcnt(" #n ")" ::: "memory")
#define PG8_BAR __builtin_amdgcn_s_barrier()
#define PG8_SCHED __builtin_amdgcn_sched_barrier(0)
    Unit cur, nxt; int ui = 0;
    if (!S.next(0, cur)) return;
    f32x4 acc[2][2][4][2];
#pragma unroll
    for (int a = 0; a < 2; ++a)
#pragma unroll
        for (int b = 0; b < 2; ++b)
#pragma unroll
            for (int m = 0; m < 4; ++m)
#pragma unroll
                for (int n = 0; n < 2; ++n) acc[a][b][m][n] = (f32x4){0.f, 0.f, 0.f, 0.f};
    bf16x8 At[4][2], B0[2][2], B1[2][2];
    int scw_ = Epi::SC_W, scx_ = Epi::SC_X; asm volatile("" : "+v"(scw_), "+v"(scx_));
    constexpr bool GATHER = Sched::GATHER;
    constexpr size_t ah = GATHER ? 0 : hstep;
    unsigned va[2][2], vn[2][2];
    S.a_voff(cur, va);
#define VA1 (GATHER ? va[1] : va[0])
    const char* cA = S.a_base(cur); const char* cB = S.b_base(cur);
    if constexpr (SP2) {
        PG8_STAGE(PG8_SB(0, 0), cB, voffB); PG8_STAGE(PG8_SB(0, 1), cB + bstep, voffB); PG8_STAGE(PG8_SA(0, 0), cA, va[0]); PG8_STAGE(PG8_SA(0, 1), cA + ah, VA1);
        if (wr == 1) PG8_BAR;
        PG8_WAIT_V(2); PG8_BAR;
        PG8_STAGE(PG8_SB(1, 0), cB + kstep, voffB); PG8_STAGE(PG8_SA(1, 0), cA + kstep, va[0]); PG8_STAGE(PG8_SB(1, 1), cB + bstep + kstep, voffB);
        PG8_WAIT_V(6); PG8_BAR;
    } else {
        PG8_STAGE(PG8_SB(0, 0), cB, voffB); PG8_STAGE(PG8_SA(0, 0), cA, va[0]); PG8_STAGE(PG8_SB(0, 1), cB + bstep, voffB); PG8_STAGE(PG8_SA(0, 1), cA + ah, VA1);
        if (wr == 1) PG8_BAR;
        PG8_WAIT_V(4); PG8_BAR;
        PG8_STAGE(PG8_SB(1, 0), cB + kstep, voffB); PG8_STAGE(PG8_SA(1, 0), cA + kstep, va[0]); PG8_STAGE(PG8_SB(1, 1), cB + bstep + kstep, voffB);
        PG8_WAIT_V(6); PG8_BAR;
    }
    for (;;) {
        const bool has_next = S.next(ui + 1, nxt);
        const char* nA = has_next ? S.a_base(nxt) : cA; const char* nB = has_next ? S.b_base(nxt) : cB;
        const bool full = cur.nv > 128;
        if constexpr (GATHER) { if (has_next) S.a_voff(nxt, vn); else { vn[0][0] = va[0][0]; vn[0][1] = va[0][1]; vn[1][0] = va[1][0]; vn[1][1] = va[1][1]; } }
#pragma unroll 1
        for (int t = 0; t < nt; t += 2) {
            const bool last = (t == nt - 2);
            const char* a1 = cA + (size_t)(t + 1) * kstep;
            const char* a2 = last ? nA : cA + (size_t)(t + 2) * kstep; const char* b2 = last ? nB : cB + (size_t)(t + 2) * kstep;
            const char* a3 = a2 + kstep; const char* b3 = b2 + kstep;
            unsigned v2[2][2];
            if constexpr (GATHER) { v2[0][0] = last ? vn[0][0] : va[0][0]; v2[0][1] = last ? vn[0][1] : va[0][1]; v2[1][0] = last ? vn[1][0] : va[1][0]; v2[1][1] = last ? vn[1][1] : va[1][1]; }
            else { v2[0][0] = va[0][0]; v2[0][1] = va[0][1]; v2[1][0] = va[0][0]; v2[1][1] = va[0][1]; }
            if constexpr (SP2) {
            PG8_LDB(B0, 0, 0); PG8_LDB(B1, 0, 1); PG8_SCHED; PG8_LDA(At, 0, 0); PG8_STAGE(PG8_SA(1, 1), a1 + ah, VA1);
            PG8_WAIT_V(8); PG8_WAIT_L(0); PG8_BAR; PG8_MMA(0, 0, At, B0); PG8_MMA(0, 1, At, B1); PG8_BAR; PG8_SCHED;
            PG8_LDA(At, 0, 1); PG8_STAGE(PG8_SB(0, 0), b2, voffB); PG8_STAGE(PG8_SB(0, 1), b2 + bstep, voffB); PG8_STAGE(PG8_SA(0, 0), a2, v2[0]);
            PG8_WAIT_V(8); PG8_WAIT_L(0); PG8_BAR; if (full) { PG8_MMA(1, 0, At, B0); PG8_MMA(1, 1, At, B1); } PG8_BAR; PG8_SCHED;
            PG8_LDB(B0, 1, 0); PG8_LDB(B1, 1, 1); PG8_SCHED; PG8_LDA(At, 1, 0); PG8_STAGE(PG8_SA(0, 1), a2 + ah, v2[1]);
            PG8_WAIT_V(8); PG8_WAIT_L(0); PG8_BAR; PG8_MMA(0, 0, At, B0); PG8_MMA(0, 1, At, B1); PG8_BAR; PG8_SCHED;
            PG8_LDA(At, 1, 1); PG8_STAGE(PG8_SB(1, 0), b3, voffB); PG8_STAGE(PG8_SB(1, 1), b3 + bstep, voffB); PG8_STAGE(PG8_SA(1, 0), a3, v2[0]);
            PG8_WAIT_V(8); PG8_WAIT_L(0); PG8_BAR; if (full) { PG8_MMA(1, 0, At, B0); PG8_MMA(1, 1, At, B1); } PG8_BAR; PG8_SCHED;
            } else {
            PG8_LDB(B0, 0, 0); PG8_SCHED; PG8_LDA(At, 0, 0); PG8_STAGE(PG8_SA(1, 1), a1 + ah, VA1);
            PG8_WAIT_L(8); PG8_BAR; PG8_WAIT_L(0); PG8_MMA(0, 0, At, B0); PG8_BAR; PG8_SCHED;
            PG8_LDB(B1, 0, 1); PG8_STAGE(PG8_SB(0, 0), b2, voffB);
            PG8_BAR; PG8_WAIT_L(0); PG8_MMA(0, 1, At, B1); PG8_BAR;
            PG8_LDA(At, 0, 1); PG8_STAGE(PG8_SA(0, 0), a2, v2[0]);
            PG8_BAR; PG8_WAIT_L(0); PG8_MMA(1, 0, At, B0); PG8_BAR; PG8_SCHED;
            PG8_STAGE(PG8_SB(0, 1), b2 + bstep, voffB);
            PG8_WAIT_V(6); PG8_BAR; PG8_MMA(1, 1, At, B1); PG8_BAR;
            PG8_LDB(B0, 1, 0); PG8_SCHED; PG8_LDA(At, 1, 0); PG8_STAGE(PG8_SA(0, 1), a2 + ah, v2[1]);
            PG8_WAIT_L(8); PG8_BAR; PG8_WAIT_L(0); PG8_MMA(0, 0, At, B0); PG8_BAR; PG8_SCHED;
            PG8_LDB(B1, 1, 1); PG8_STAGE(PG8_SB(1, 0), b3, voffB);
            PG8_BAR; PG8_WAIT_L(0); PG8_MMA(0, 1, At, B1); PG8_BAR;
            PG8_LDA(At, 1, 1); PG8_STAGE(PG8_SA(1, 0), a3, v2[0]);
            PG8_BAR; PG8_WAIT_L(0); PG8_MMA(1, 0, At, B0); PG8_BAR; PG8_SCHED;
            PG8_STAGE(PG8_SB(1, 1), b3 + bstep, voffB);
            PG8_WAIT_V(6); PG8_BAR; PG8_MMA(1, 1, At, B1); PG8_BAR;
            }
        }
        if constexpr (ALIGN_EPI) { if (wr == 0) PG8_BAR; }
        if constexpr (Epi::F8) asm volatile("s_nop 15\n\ts_nop 15" ::: "memory");
        if (!(probe & 2)) E(acc, cur, wr, wc, fr, fq);
        if (!has_next) break;
#pragma unroll
        for (int a = 0; a < 2; ++a)
#pragma unroll
            for (int b = 0; b < 2; ++b)
#pragma unroll
                for (int m = 0; m < 4; ++m)
#pragma unroll
                    for (int n = 0; n < 2; ++n) acc[a][b][m][n] = (f32x4){0.f, 0.f, 0.f, 0.f};
        cur = nxt; cA = nA; cB = nB; ++ui;
        if constexpr (GATHER) { va[0][0] = vn[0][0]; va[0][1] = vn[0][1]; va[1][0] = vn[1][0]; va[1][1] = vn[1][1]; }
        if constexpr (ALIGN_EPI) { if (wr == 1) PG8_BAR; }
    }
    PG8_WAIT_V(0);
    if constexpr (!ALIGN_EPI) { if (wr == 0) PG8_BAR; }
    PG8_BAR;
#undef VA1
#undef PG8_SA
#undef PG8_SB
#undef PG8_STAGE
#undef PG8_LDA
#undef PG8_LDB
#undef PG8_MMA
#undef PG8_WAIT_V
#undef PG8_WAIT_L
#undef PG8_BAR
#undef PG8_SCHED
}

template <int K> struct DenseSched {
    static constexpr bool GATHER = false;
    const char* A; const char* Bt; int nM, nN, nwg, G, c, tid;
    __device__ __forceinline__ void init(const void* A_, const void* Bt_, int M, int N, int G_, int c_, int tid_) { tid = tid_; A = (const char*)A_; Bt = (const char*)Bt_; nM = M / BM; nN = N / BM; nwg = nM * nN; G = G_; c = c_; }
    __device__ __forceinline__ bool next(int i, Unit& u) const {
        const long L = (long)i * G + c; if (L >= nwg) return false;
        int wgid = (int)L; { const int q = nwg / 8, r = nwg % 8, xcd = wgid % 8, off = wgid / 8; wgid = (xcd < r ? xcd * (q + 1) : r * (q + 1) + (xcd - r) * q) + off; }
        const int nig = 8 * nN, gid = wgid / nig, fm = gid * 8, gsz = (nM - fm) < 8 ? (nM - fm) : 8;
        u.t = fm + ((wgid % nig) % gsz); u.nt = (wgid % nig) / gsz; u.row0 = 0; u.nv = 256; u.e = 0; return true;
    }
    __device__ __forceinline__ const char* a_base(const Unit& u) const { return A + (size_t)u.t * (BM * K * 2); }
    __device__ __forceinline__ const char* b_base(const Unit& u) const { return Bt + (size_t)u.nt * (BM * K * 2); }
    __device__ __forceinline__ void a_voff(const Unit&, unsigned (&v)[2][2]) const {
#pragma unroll
        for (int i = 0; i < 2; ++i) { int R, C; stage_rc(tid * 16 + i * 8192, R, C); v[0][i] = (unsigned)(R * K + C) * 2u; v[1][i] = v[0][i] + (unsigned)(HALF * K * 2); }
    }
};
}
using pg8::Unit;

struct TileTabs { const int* te; const int* trow0; const int* tnv; int ntiles; };
constexpr int UT_OFF = pg8::STAGE_BYTES;
constexpr int UT_INFO = UT_OFF + 16, UT_TOK = UT_INFO + 64 * 16, UT_MAXU = 20;
static_assert(UT_TOK + UT_MAXU * 1024 <= MISC_OFF, "unit tables fit under the LDS control words");
template <int NTN, bool G1>
struct ExpertSched {
    static constexpr bool GATHER = G1;
    const char* A; const char* W; LAS unsigned char* lds; int n, tid;
    __device__ __forceinline__ void init(LAS unsigned char* lds_, const void* A_, const void* W_, const int* rowtok, const TileTabs& T, int chunk, int tid_) {
        lds = lds_; tid = tid_; A = (const char*)A_; W = (const char*)W_;
        const int U = T.ntiles * NTN, x8 = blockIdx.x & 7, r8 = blockIdx.x >> 3, G8 = gridDim.x >> 3;
        const int q = (((U + 7) >> 3) + NTN - 1) / NTN * NTN;
        const int lo = x8 * q + r8, hi = (x8 + 1) * q < U ? (x8 + 1) * q : U;
        int cnt = hi > lo ? (hi - lo + G8 - 1) / G8 : 0; cnt = cnt > (G1 ? UT_MAXU : 64) ? (G1 ? UT_MAXU : 64) : cnt;
        n = cnt;
        LAS int* info = (LAS int*)(lds + UT_INFO);
        if (tid < cnt) { const int L = lo + G8 * tid, t = L / NTN; info[tid * 4 + 0] = T.te[t]; info[tid * 4 + 1] = T.trow0[t]; info[tid * 4 + 2] = T.tnv[t]; info[tid * 4 + 3] = L % NTN; }
        __syncthreads();
        if constexpr (G1) {
            LAS int* tok = (LAS int*)(lds + UT_TOK);
            constexpr int TPT = UT_MAXU * 256 / NTHR;
            int tv[TPT];
#pragma unroll
            for (int k = 0; k < TPT; ++k) { const int idx = tid + k * NTHR; tv[k] = chunk * CHT;
                if (idx < cnt * 256) { const int i = idx >> 8, rl = idx & 255; const int e = info[i * 4 + 0], row0 = info[i * 4 + 1], nv = info[i * 4 + 2];
                    if (e == NE) tv[k] = chunk * CHT + (row0 - CH_ROUTED) + rl; else if (rl < nv) tv[k] = rowtok[row0 + rl]; } }
#pragma unroll
            for (int k = 0; k < TPT; ++k) { const int idx = tid + k * NTHR; if (idx < cnt * 256) tok[idx] = tv[k]; }
            __syncthreads();
        }
    }
    __device__ __forceinline__ bool next(int i, Unit& u) const {
        if (i >= n) return false;
        const LAS int* info = (const LAS int*)(lds + UT_INFO);
        u.t = i; u.e = __builtin_amdgcn_readfirstlane(info[i * 4 + 0]); u.row0 = __builtin_amdgcn_readfirstlane(info[i * 4 + 1]);
        u.nv = __builtin_amdgcn_readfirstlane(info[i * 4 + 2]); u.nt = __builtin_amdgcn_readfirstlane(info[i * 4 + 3]); return true; }
    __device__ __forceinline__ const char* a_base(const Unit& u) const { if constexpr (G1) return A; else return A + (size_t)u.row0 * 256; }
    __device__ __forceinline__ const char* b_base(const Unit& u) const {
        if constexpr (G1) return W + ((size_t)u.e * 512 + u.nt * 256) * 1024; else return W + ((size_t)u.e * 1024 + u.nt * 256) * 256; }
    __device__ __forceinline__ void a_voff(const Unit& u, unsigned (&v)[2][2]) const {
        if constexpr (G1) {
            const LAS int* tok = (const LAS int*)(lds + UT_TOK) + u.t * 256;
#pragma unroll
            for (int i = 0; i < 2; ++i) { int R, C; pg8::stage_rc(tid * 16 + i * 8192, R, C);
#pragma unroll
                for (int h = 0; h < 2; ++h) v[h][i] = (unsigned)tok[R + 128 * h] * 1024u + (unsigned)C * 2u; }
        } else {
#pragma unroll
            for (int i = 0; i < 2; ++i) { int R, C; pg8::stage_rc(tid * 16 + i * 8192, R, C); v[0][i] = (unsigned)(R * 128 + C) * 2u; v[1][i] = v[0][i] + (unsigned)(128 * 128 * 2); }
        }
    }
};
typedef ExpertSched<2, true> Gemm1Sched;
typedef ExpertSched<4, false> Gemm2Sched;

template <bool F8_> struct EpiBf16T {
    static constexpr bool F8 = F8_; static constexpr int SC_W = SC_W1, SC_X = SC_N2;
    static constexpr bool COL16 = false;
    bf16_t* O; int ldc;
    __device__ __forceinline__ void operator()(const f32x4 (&acc)[2][2][4][2], const Unit& u, int wr, int wc, int fr, int fq) const {
        const int row0 = u.t * 256 + wr * 64 + fr, col0 = u.nt * 256 + wc * 32 + 8 * fq;
#pragma unroll
        for (int ai = 0; ai < 2; ++ai)
#pragma unroll
            for (int m = 0; m < 4; ++m) { bf16_t* rowp = O + (size_t)(row0 + ai * 128 + m * 16) * ldc + col0;
#pragma unroll
                for (int bj = 0; bj < 2; ++bj) { const f32x4 v0 = acc[ai][bj][m][0], v1 = acc[ai][bj][m][1];
                    u32x4 w; w.x = cvt_pk_bf16(v0[0], v0[1]); w.y = cvt_pk_bf16(v0[2], v0[3]); w.z = cvt_pk_bf16(v1[0], v1[1]); w.w = cvt_pk_bf16(v1[2], v1[3]);
                    *(u32x4*)(rowp + bj * 128) = w; } }
    }
};
struct EpiResH {
    static constexpr bool F8 = true; static constexpr int SC_W = SC_W1, SC_X = SC_N2;
    static constexpr bool COL16 = false;
    const float* x; const float* gate; float* out; unsigned char* ws;
    __device__ __forceinline__ void operator()(const f32x4 (&acc)[2][2][4][2], const Unit& u, int wr, int wc, int fr, int fq) const {
        const int row0 = u.t * 256 + wr * 64 + fr, col0 = u.nt * 256 + wc * 32 + 8 * fq;
        const int b = (u.t * 256) / SEQ;
        f32x4 g[2][2];
#pragma unroll
        for (int bj = 0; bj < 2; ++bj)
#pragma unroll
            for (int n = 0; n < 2; ++n) g[bj][n] = *(const f32x4*)(gate + (size_t)b * 6144 + col0 + bj * 128 + 4 * n);
        bf16_t* hb = h_row(out, ws, u.t * 256) + (size_t)(wr * 64 + fr) * D + col0;
#pragma unroll
        for (int ai = 0; ai < 2; ++ai)
#pragma unroll
            for (int mh = 0; mh < 2; ++mh) {
                f32x4 xv[2][2][2];
#pragma unroll
                for (int m2 = 0; m2 < 2; ++m2) { const size_t off = (size_t)(row0 + ai * 128 + (2 * mh + m2) * 16) * D + col0;
#pragma unroll
                    for (int bj = 0; bj < 2; ++bj) { xv[m2][bj][0] = *(const f32x4*)(x + off + bj * 128); xv[m2][bj][1] = *(const f32x4*)(x + off + bj * 128 + 4); } }
#pragma unroll
                for (int m2 = 0; m2 < 2; ++m2) { const int m = 2 * mh + m2;
#pragma unroll
                    for (int bj = 0; bj < 2; ++bj) {
                        const f32x4 h0 = xv[m2][bj][0] + g[bj][0] * acc[ai][bj][m][0], h1 = xv[m2][bj][1] + g[bj][1] * acc[ai][bj][m][1];
                        u32x4 w; w.x = cvt_pk_bf16(h0[0], h0[1]); w.y = cvt_pk_bf16(h0[2], h0[3]); w.z = cvt_pk_bf16(h1[0], h1[1]); w.w = cvt_pk_bf16(h1[2], h1[3]);
                        *(u32x4*)(hb + (size_t)(ai * 128 + m * 16) * D + bj * 128) = w; } } }
    }
};
struct EpiF32 {
    static constexpr bool F8 = false; static constexpr int SC_W = 0, SC_X = 0;
    static constexpr bool COL16 = false;
    float* O; int ldc;
    __device__ __forceinline__ void operator()(const f32x4 (&acc)[2][2][4][2], const Unit& u, int wr, int wc, int fr, int fq) const {
        const int row0 = u.t * 256 + wr * 64 + fr, col0 = u.nt * 256 + wc * 32 + 8 * fq;
#pragma unroll
        for (int ai = 0; ai < 2; ++ai)
#pragma unroll
            for (int m = 0; m < 4; ++m) { float* rowp = O + (size_t)(row0 + ai * 128 + m * 16) * ldc + col0;
#pragma unroll
                for (int bj = 0; bj < 2; ++bj)
#pragma unroll
                    for (int n = 0; n < 2; ++n) *(f32x4*)(rowp + bj * 128 + 4 * n) = acc[ai][bj][m][n]; }
    }
};
struct EpiAct {
    static constexpr bool F8 = true; static constexpr int SC_W = SC_W1, SC_X = SC_N2;
    static constexpr bool COL16 = false;
    unsigned char* act;
    __device__ __forceinline__ void operator()(const f32x4 (&acc)[2][2][4][2], const Unit& u, int wr, int wc, int fr, int fq) const {
        const int col0 = u.nt * 128 + wc * 32 + 8 * fq;
#pragma unroll
        for (int ai = 0; ai < 2; ++ai)
#pragma unroll
            for (int m = 0; m < 4; ++m) { const int rl = ai * 128 + wr * 64 + m * 16 + fr;
                f32x4 ov[2];
#pragma unroll
                for (int n = 0; n < 2; ++n) { const f32x4 g = acc[ai][0][m][n], gu = g * acc[ai][1][m][n];
                    f32x4 d; d.x = fast_exp2(g.x); d.y = fast_exp2(g.y); d.z = fast_exp2(g.z); d.w = fast_exp2(g.w);
                    d = d + 1.f;
                    f32x4 r; r.x = fast_rcp(d.x); r.y = fast_rcp(d.y); r.z = fast_rcp(d.z); r.w = fast_rcp(d.w);
                    ov[n] = gu * r; }
                ov[0] = ov[0] * ACT_PRE; ov[1] = ov[1] * ACT_PRE;
                int w0 = __builtin_amdgcn_cvt_pk_fp8_f32(ov[0].x, ov[0].y, 0, false); w0 = __builtin_amdgcn_cvt_pk_fp8_f32(ov[0].z, ov[0].w, w0, true);
                int w1 = __builtin_amdgcn_cvt_pk_fp8_f32(ov[1].x, ov[1].y, 0, false); w1 = __builtin_amdgcn_cvt_pk_fp8_f32(ov[1].z, ov[1].w, w1, true);
                u32x2 w; w.x = (unsigned)w0; w.y = (unsigned)w1;
                if (rl < u.nv) *(u32x2*)(act + (size_t)(u.row0 + rl) * EDIM + col0) = w; }
    }
};
struct EpiDown {
    static constexpr bool F8 = true; static constexpr int SC_W = SC_W2, SC_X = SC_ACT;
    static constexpr bool COL16 = true;
    unsigned char* Y; LAS unsigned char* lds; int nost;
    __device__ __forceinline__ u32x4 pack(const f32x4 (&acc)[2][2][4][2], int ai, int m) const {
        u32x4 w;
#pragma unroll
        for (int bj = 0; bj < 2; ++bj) {
            f32x4 v0 = acc[ai][bj][m][0], v1 = acc[ai][bj][m][1];
#pragma unroll
            for (int j = 0; j < 4; ++j) { v0[j] = fminf(fmaxf(v0[j], -448.f), 448.f); v1[j] = fminf(fmaxf(v1[j], -448.f), 448.f); }
            int w0 = __builtin_amdgcn_cvt_pk_fp8_f32(v0[0], v0[1], 0, false); w0 = __builtin_amdgcn_cvt_pk_fp8_f32(v0[2], v0[3], w0, true);
            int w1 = __builtin_amdgcn_cvt_pk_fp8_f32(v1[0], v1[1], 0, false); w1 = __builtin_amdgcn_cvt_pk_fp8_f32(v1[2], v1[3], w1, true);
            if (bj == 0) { w.x = (unsigned)w0; w.y = (unsigned)w1; } else { w.z = (unsigned)w0; w.w = (unsigned)w1; } }
        return w;
    }
    __device__ __forceinline__ void operator()(const f32x4 (&acc)[2][2][4][2], const Unit& u, int wr, int wc, int fr, int fq) const {
        const int lane = fq * 16 + fr, wv = wr * 4 + wc;
        constexpr int B0 = 3 * pg8::HTB, B1 = UT_TOK;
        const int wofs = (32 * wr + fr) * 256 + (((4 * wc + fq) ^ fr) << 4);
        const int rr0 = 8 * wv + (lane >> 4);
        const int rofs = rr0 * 256 + (((lane & 15) ^ (rr0 & 15)) << 4), rofs4 = (rr0 + 4) * 256 + (((lane & 15) ^ ((rr0 + 4) & 15)) << 4);
        const int t0 = 64 * (rr0 >> 5) + 16 * ((rr0 >> 4) & 1) + (rr0 & 15);
        unsigned char* yp = Y + (size_t)u.row0 * D + u.nt * 256 + 16 * (lane & 15);
        { const u32x4 wa = pack(acc, 0, 0), wb = pack(acc, 0, 1); *(LAS u32x4*)(lds + B0 + wofs) = wa; *(LAS u32x4*)(lds + B0 + wofs + 16 * 256) = wb; }
#pragma unroll
        for (int sl = 0; sl < 4; ++sl) { const int ai = sl >> 1, mh = sl & 1;
            asm volatile("s_waitcnt lgkmcnt(0)" ::: "memory"); __builtin_amdgcn_s_barrier();
            const int rb = (sl & 1) ? B1 : B0, wb_ = (sl & 1) ? B0 : B1;
            const u32x4 v0 = *(const LAS u32x4*)(lds + rb + rofs), v1 = *(const LAS u32x4*)(lds + rb + rofs4);
            if (sl < 3) { const int a2 = (sl + 1) >> 1, m2 = ((sl + 1) & 1) * 2;
                const u32x4 wa = pack(acc, a2, m2), wb = pack(acc, a2, m2 + 1); *(LAS u32x4*)(lds + wb_ + wofs) = wa; *(LAS u32x4*)(lds + wb_ + wofs + 16 * 256) = wb; }
            const int rl = ai * 128 + mh * 32 + t0;
            if (!nost) { if (rl < u.nv) __builtin_nontemporal_store(v0, (u32x4*)(yp + (size_t)rl * D)); if (rl + 4 < u.nv) __builtin_nontemporal_store(v1, (u32x4*)(yp + (size_t)(rl + 4) * D)); } }
    }
};

struct Frame {
    LAS unsigned char* lds; int tid, lane, wave, G, vcu;
    const CAS Args* a;
};
__device__ __forceinline__ Frame make_frame(LAS unsigned char* lds) {
    Frame F; F.lds = lds;
    int t = threadIdx.x; asm volatile("" : "+v"(t));
    F.tid = t; F.lane = t & 63; F.wave = __builtin_amdgcn_readfirstlane(t >> 6);
    const CAS Args* a = (const CAS Args*)__builtin_amdgcn_kernarg_segment_ptr(); asm volatile("" : "+s"(a)); F.a = a;
    F.G = gridDim.x; { const int bx = blockIdx.x; F.vcu = (F.G % 8 == 0) ? (bx % 8) * (F.G / 8) + bx / 8 : bx; }
    return F;
}
#define WSP(F, off, T) ((T*)((F).a->ws + (off)))

__device__ __forceinline__ void phase_mod(Frame& F) {
    LAS float* cond = (LAS float*)F.lds;
    LAS float* red = (LAS float*)(F.lds + 65536);
    const float* c = F.a->in[I_C]; const float* wada = F.a->in[I_WADA]; const float* bada = F.a->in[I_BADA];
    float* mod = WSP(F, WS_MOD, float);
    for (int i = F.tid; i < 16 * 1024; i += NTHR) cond[i] = silu_f(c[i]);
    __syncthreads();
    const int jj = F.tid & 31, ks = F.tid >> 5;
    for (int cb = blockIdx.x; cb < 256; cb += F.G) {
        const int j0 = cb * 24;
        float acc[16];
#pragma unroll
        for (int b = 0; b < 16; ++b) acc[b] = 0.f;
        if (jj < 24) {
            for (int k = ks * 64; k < ks * 64 + 64; ++k) {
                const float w = wada[(size_t)k * 6144 + j0 + jj];
#pragma unroll
                for (int b = 0; b < 16; ++b) acc[b] += cond[b * 1024 + k] * w;
            }
        }
#pragma unroll
        for (int b = 0; b < 16; ++b) red[(ks * 16 + b) * 32 + jj] = acc[b];
        __syncthreads();
        if (F.tid < 16 * 24) { const int b = F.tid / 24, j = F.tid % 24; float s = 0.f;
            for (int k2 = 0; k2 < 16; ++k2) s += red[(k2 * 16 + b) * 32 + j];
            mod[b * 6144 + j0 + j] = s + bada[j0 + j]; }
        __syncthreads();
    }
    const float* wsp = F.a->in[I_WSP]; bf16_t* o = WSP(F, WS_WSP, bf16_t);
    for (int i = blockIdx.x * NTHR + F.tid; i < 4 * 128 * 128; i += F.G * NTHR) { const int s = i & 127, t = (i >> 7) & 127; o[i] = (bf16_t)(cvt_pk_bf16(s <= t ? wsp[i] : 0.f, 0.f) & 0xffffu); }
}

struct TItem { const float* W; bf16_t* WT; int K, N, gmode, item; float scale; bool f8; };
__device__ __forceinline__ void titem_issue(const TItem& t, int lane, LAS unsigned char* buf) {
    const int nblk = t.N / 32, kb = t.item / nblk, nb = t.item % nblk, k0 = 64 * kb, n0 = 32 * nb;
#pragma unroll
    for (int j = 0; j < 8; ++j) { const float* g = t.W + (size_t)(k0 + 8 * j + (lane >> 3)) * t.N + n0 + 4 * ((lane & 7) ^ j);
        __builtin_amdgcn_global_load_lds((const unsigned*)g, (LAS unsigned*)(buf + j * 1024), 16, 0, 2); }
}
__device__ __forceinline__ void titem_finish(const TItem& t, int lane, const LAS unsigned char* buf) {
    const int nblk = t.N / 32, kb = t.item / nblk, nb = t.item % nblk, k0 = 64 * kb, n0 = 32 * nb;
    const int d0 = t.gmode == 0 ? n0 : ((n0 >> 7) * 256 + (n0 & 127) + (t.gmode == 2 ? 128 : 0));
    const int c = lane & 7;
    const LAS float* sb = (const LAS float*)buf;
    float v[4][8];
    const float wsc = t.scale;
#pragma unroll
    for (int j = 0; j < 4; ++j) { const int n = (lane >> 3) + 8 * j; const LAS float* s = sb + (8 * c) * 32 + 4 * ((n >> 2) ^ c) + (n & 3);
#pragma unroll
        for (int q = 0; q < 8; ++q) v[j][q] = s[32 * q] * wsc; }
    if (t.f8) {
#pragma unroll
        for (int j = 0; j < 4; ++j) { const int n = (lane >> 3) + 8 * j;
            int w0 = __builtin_amdgcn_cvt_pk_fp8_f32(v[j][0], v[j][1], 0, false); w0 = __builtin_amdgcn_cvt_pk_fp8_f32(v[j][2], v[j][3], w0, true);
            int w1 = __builtin_amdgcn_cvt_pk_fp8_f32(v[j][4], v[j][5], 0, false); w1 = __builtin_amdgcn_cvt_pk_fp8_f32(v[j][6], v[j][7], w1, true);
            u32x2 o; o.x = (unsigned)w0; o.y = (unsigned)w1;
            __builtin_nontemporal_store(o, (u32x2*)((unsigned char*)t.WT + (size_t)(d0 + n) * t.K + k0 + 8 * c)); }
    } else {
#pragma unroll
        for (int j = 0; j < 4; ++j) { const int n = (lane >> 3) + 8 * j;
            u32x4 o; o.x = cvt_pk_bf16(v[j][0], v[j][1]); o.y = cvt_pk_bf16(v[j][2], v[j][3]); o.z = cvt_pk_bf16(v[j][4], v[j][5]); o.w = cvt_pk_bf16(v[j][6], v[j][7]);
            __builtin_nontemporal_store(o, (u32x4*)(t.WT + (size_t)(d0 + n) * t.K + k0 + 8 * c)); }
    }
}
typedef float f32x2v __attribute__((ext_vector_type(2)));
template <bool HB>
__device__ __forceinline__ void norm_mod_row2(const void* x0, const void* x1, const float* g, const float* sh0, const float* sc0, const float* sh1, const float* sc1, bf16_t* o0, bf16_t* o1, int lane) {
    f32x4 v0[4], v1[4]; float s0 = 0.f, s1 = 0.f;
#pragma unroll
    for (int j = 0; j < 4; ++j) {
        if (HB) { const u32x2 a = *(const u32x2*)((const bf16_t*)x0 + 4 * lane + 256 * j), b = *(const u32x2*)((const bf16_t*)x1 + 4 * lane + 256 * j);
            v0[j] = (f32x4){bflo(a.x), bfhi(a.x), bflo(a.y), bfhi(a.y)}; v1[j] = (f32x4){bflo(b.x), bfhi(b.x), bflo(b.y), bfhi(b.y)}; }
        else { v0[j] = *(const f32x4*)((const float*)x0 + 4 * lane + 256 * j); v1[j] = *(const f32x4*)((const float*)x1 + 4 * lane + 256 * j); } }
#pragma unroll
    for (int j = 0; j < 4; ++j) { s0 += (v0[j].x * v0[j].x + v0[j].y * v0[j].y) + (v0[j].z * v0[j].z + v0[j].w * v0[j].w);
                                  s1 += (v1[j].x * v1[j].x + v1[j].y * v1[j].y) + (v1[j].z * v1[j].z + v1[j].w * v1[j].w); }
    s0 = wave_sum(s0); s1 = wave_sum(s1);
    const float r0 = 1.f / sqrtf(s0 * (1.f / D) + EPS), r1 = 1.f / sqrtf(s1 * (1.f / D) + EPS);
#pragma unroll
    for (int j = 0; j < 4; ++j) { const int c0 = 4 * lane + 256 * j;
        const f32x4 gg = *(const f32x4*)(g + c0);
        const f32x4 y0 = v0[j] * r0 * gg * (*(const f32x4*)(sc0 + c0) + 1.f) + *(const f32x4*)(sh0 + c0);
        const f32x4 y1 = v1[j] * r1 * gg * (*(const f32x4*)(sc1 + c0) + 1.f) + *(const f32x4*)(sh1 + c0);
        u32x2 w0, w1; w0.x = cvt_pk_bf16(y0.x, y0.y); w0.y = cvt_pk_bf16(y0.z, y0.w); w1.x = cvt_pk_bf16(y1.x, y1.y); w1.y = cvt_pk_bf16(y1.z, y1.w);
        *(u32x2*)(o0 + c0) = w0; *(u32x2*)(o1 + c0) = w1; }
}
template <int NR, bool HB>
__device__ __forceinline__ void norm_mod_rows(const void* x, size_t xstride, const float* g, const float* sh, const float* sc, bf16_t* o, size_t ostride, int lane, unsigned char* o8 = nullptr) {
    f32x4 v[NR][4]; float ss[NR];
    f32x4 gq[4], sq4[4], hq[4];
#pragma unroll
    for (int j = 0; j < 4; ++j) { const int c0 = 4 * lane + 256 * j; gq[j] = *(const f32x4*)(g + c0); sq4[j] = *(const f32x4*)(sc + c0); hq[j] = *(const f32x4*)(sh + c0); }
    if constexpr (HB) {
        u32x2 raw[NR][4];
#pragma unroll
        for (int r = 0; r < NR; ++r)
#pragma unroll
            for (int j = 0; j < 4; ++j) raw[r][j] = *(const u32x2*)((const bf16_t*)x + r * xstride + 4 * lane + 256 * j);
#pragma unroll
        for (int r = 0; r < NR; ++r)
#pragma unroll
            for (int j = 0; j < 4; ++j) v[r][j] = (f32x4){bflo(raw[r][j].x), bfhi(raw[r][j].x), bflo(raw[r][j].y), bfhi(raw[r][j].y)};
    } else {
#pragma unroll
        for (int r = 0; r < NR; ++r)
#pragma unroll
            for (int j = 0; j < 4; ++j) v[r][j] = *(const f32x4*)((const float*)x + r * xstride + 4 * lane + 256 * j);
    }
#pragma unroll
    for (int r = 0; r < NR; ++r) { float s0 = 0.f;
#pragma unroll
        for (int j = 0; j < 4; ++j) s0 += (v[r][j].x * v[r][j].x + v[r][j].y * v[r][j].y) + (v[r][j].z * v[r][j].z + v[r][j].w * v[r][j].w);
        ss[r] = 1.f / sqrtf(wave_sum(s0) * (1.f / D) + EPS); }
#pragma unroll
    for (int j = 0; j < 4; ++j) { const int c0 = 4 * lane + 256 * j;
        const f32x4 gg = gq[j] * (sq4[j] + 1.f), hh = hq[j];
#pragma unroll
        for (int r = 0; r < NR; ++r) { const f32x4 y = v[r][j] * ss[r] * gg + hh;
            if (o) { u32x2 w; w.x = cvt_pk_bf16(y.x, y.y); w.y = cvt_pk_bf16(y.z, y.w); *(u32x2*)(o + r * ostride + c0) = w; }
            if (o8) { int q = __builtin_amdgcn_cvt_pk_fp8_f32(y.x, y.y, 0, false); q = __builtin_amdgcn_cvt_pk_fp8_f32(y.z, y.w, q, true); *(int*)(o8 + r * ostride + c0) = q; } } }
}
__device__ __forceinline__ void phase_prep(Frame& F) {
    const int gw = F.vcu * 8 + F.wave, NGW = F.G * 8;
    const float* mod = WSP(F, WS_MOD, float); bf16_t* nbuf = WSP(F, WS_A, bf16_t);
    for (int m = gw * 4; m < NTOK; m += 4 * NGW) { const int b = m / SEQ;
        norm_mod_rows<4, false>(F.a->in[I_X] + (size_t)m * D, D, F.a->in[I_GMIX], mod + b * 6144, mod + b * 6144 + 1024, nullptr, D, F.lane, (unsigned char*)nbuf + (size_t)m * D); }
    LAS unsigned char* scr = F.lds + F.wave * 16384;
    constexpr int IT_IN = 16 * 80, IT_OUT = 16 * 32, IT_R = 16 * 8;
    constexpr int NITEMS = IT_IN + IT_OUT + IT_R;
    for (int it = gw; it < NITEMS; it += NGW) {
        int r = it; TItem t;
        if (r < IT_IN) t = TItem{F.a->in[I_WIN], WSP(F, WS_WTIN, bf16_t), 1024, 2560, 0, r, W1_PRE, true};
        else if (r < IT_IN + IT_OUT) t = TItem{F.a->in[I_WOUT], WSP(F, WS_WTOUT, bf16_t), 1024, 1024, 0, r - IT_IN, W1_PRE, true};
        else t = TItem{F.a->in[I_WR], WSP(F, WS_WTR, bf16_t), 1024, 256, 0, r - IT_IN - IT_OUT, 1.f, false};
        titem_issue(t, F.lane, scr); asm volatile("s_waitcnt vmcnt(0)" ::: "memory"); titem_finish(t, F.lane, scr); asm volatile("s_waitcnt lgkmcnt(0)" ::: "memory");
    }
}
constexpr int CONV_ITEMS = 257 * 3 * 128;
__device__ __forceinline__ void convert_experts(Frame& F, int lo, int hi) {
    const int gw = F.vcu * 8 + F.wave, NGW = F.G * 8;
    LAS unsigned char* scr = F.lds + F.wave * 16384;
    unsigned char* W1t = WSP(F, WS_W1T, unsigned char); unsigned char* W2t = WSP(F, WS_W2T, unsigned char);
    const float* weg = F.a->in[I_WEG]; const float* weu = F.a->in[I_WEU]; const float* wed = F.a->in[I_WED];
    const float* wsg = F.a->in[I_WSG]; const float* wsu = F.a->in[I_WSU]; const float* wsd = F.a->in[I_WSD];
#define CONV_DESC(r, t) do { const int e_ = (r) / 384, w_ = ((r) >> 7) % 3; (t).item = (r) & 127; (t).f8 = true; (t).scale = w_ == 2 ? YSCALE * W2_PRE : (w_ == 0 ? -LOG2E * W1_PRE : -W1_PRE / LOG2E); (t).gmode = w_ == 2 ? 0 : w_ + 1; (t).K = w_ == 2 ? 256 : 1024; (t).N = w_ == 2 ? 1024 : 256; \
        (t).W = w_ == 0 ? (e_ < NE ? weg + (size_t)e_ * 262144 : wsg) : w_ == 1 ? (e_ < NE ? weu + (size_t)e_ * 262144 : wsu) : (e_ < NE ? wed + (size_t)e_ * 262144 : wsd); \
        (t).WT = (bf16_t*)(w_ == 2 ? W2t + (size_t)e_ * 262144 : W1t + (size_t)e_ * 524288); } while (0)
    constexpr int NPAIRS = CONV_ITEMS / 2;
    (void)lo; (void)hi;
#define CONV_RIDX(s_) ({ const int P_ = gw + ((s_) >> 1) * NGW, mi_ = P_ >> 6, pp_ = P_ & 63, nb_ = (mi_ % 3) == 2 ? 32 : 8; mi_ * 128 + (2 * (pp_ / nb_) + ((s_) & 1)) * nb_ + (pp_ % nb_); })
    if (gw < NPAIRS) {
        const int ns = 2 * ((NPAIRS - gw + NGW - 1) / NGW);
        int sq = 0, r = CONV_RIDX(0);
        TItem tc, tn; CONV_DESC(r, tc); tn = tc;
        int p = 0; bool first = true;
        titem_issue(tc, F.lane, scr);
        for (;;) {
            const bool more = sq + 1 < ns; const int rn = more ? CONV_RIDX(sq + 1) : r;
            if (more) { CONV_DESC(rn, tn); titem_issue(tn, F.lane, scr + (p ^ 1) * 8192); }
            if (!more) asm volatile("s_waitcnt vmcnt(0)" ::: "memory");
            else if (first) asm volatile("s_waitcnt vmcnt(8)" ::: "memory");
            else asm volatile("s_waitcnt vmcnt(12)" ::: "memory");
            titem_finish(tc, F.lane, scr + p * 8192);
            asm volatile("s_waitcnt lgkmcnt(0)" ::: "memory");
            if (!more) break;
            tc = tn; r = rn; ++sq; p ^= 1; first = false;
        }
    }
#undef CONV_RIDX
#undef CONV_DESC
    __syncthreads();
}

__device__ __forceinline__ s16x4 tr_read(LAS unsigned char* p) { return __builtin_bit_cast(s16x4, __builtin_amdgcn_ds_read_tr16_b64_v4i16((LAS s16x4*)p)); }
constexpr int ATT_ROWB = 144;
constexpr int ATT_VOFF = 256 * ATT_ROWB;
struct AttnUnit { int b, h, d, dsel, r, n; };
__device__ __forceinline__ AttnUnit attn_decode(int j) {
    AttnUnit u; const int bh = j / 96, rest = j % 96; u.b = bh >> 3; u.h = bh & 7;
    u.dsel = (rest >= 32 ? 1 : 0) + (rest >= 64 ? 1 : 0);
    const int x = rest - 32 * u.dsel, sh = 5 - 2 * u.dsel;
    u.d = 1 << (2 * u.dsel); u.r = x >> sh; u.n = x & ((1 << sh) - 1);
    return u;
}
__device__ __forceinline__ void attn_issue(const bf16_t* qkv, const AttnUnit& u, int tid, u32x4 (&kr)[4], u32x4 (&vr)[4]) {
#pragma unroll
    for (int jj = 0; jj < 4; ++jj) { const int ch = tid + 512 * jj, row = ch >> 3, c16 = ch & 7;
        int i = 128 * (u.n - 1) + row; i = i < 0 ? 0 : i;
        const size_t tok = (size_t)u.b * SEQ + (size_t)i * u.d + u.r;
        const bf16_t* p = qkv + tok * NPROJ + 512 + u.h * 64 + c16 * 8;
        kr[jj] = *(const u32x4*)p; vr[jj] = *(const u32x4*)(p + 512); }
}
__device__ __forceinline__ void phase_attn(Frame& F) {
    const bf16_t* qkv = WSP(F, WS_B, bf16_t);
    bf16_t* part = (bf16_t*)F.a->out;
    float* lse = WSP(F, WS_LSE, float);
    const int tid = F.tid, w = F.wave, lane = F.lane, fr = lane & 15, fq = lane >> 4;
    const int x8 = blockIdx.x & 7, r8 = blockIdx.x >> 3, G8 = F.G >> 3;
    constexpr int PER_X = 16 * 96;
    constexpr int ABUF = 2 * ATT_VOFF;
    float ef[4];
#pragma unroll
    for (int rg = 0; rg < 4; ++rg) ef[rg] = (float)(fr - 4 * fq - rg);
    u32x4 kr[4], vr[4];
    AttnUnit un;
    bf16x8 qn0, qn1;
    int jl = r8;
    if (jl >= PER_X) return;
    AttnUnit cu = attn_decode(x8 * PER_X + jl);
    attn_issue(qkv, cu, tid, kr, vr);
    { const size_t tq = (size_t)cu.b * SEQ + (size_t)(128 * cu.n + 16 * w + fr) * cu.d + cu.r; const bf16_t* qp = qkv + tq * NPROJ + cu.h * 64 + 8 * fq; qn0 = *(const bf16x8*)qp; qn1 = *(const bf16x8*)(qp + 32); }
#pragma unroll
    for (int jj = 0; jj < 4; ++jj) { const int ch = tid + 512 * jj, row = ch >> 3, c16 = ch & 7;
        *(LAS u32x4*)(F.lds + row * ATT_ROWB + c16 * 16) = kr[jj]; *(LAS u32x4*)(F.lds + ATT_VOFF + row * ATT_ROWB + c16 * 16) = vr[jj]; }
    const int jlast = r8 + G8 * ((PER_X - 1 - r8) / G8);
    un = attn_decode(x8 * PER_X + (jl + G8 < jlast ? jl + G8 : jlast)); attn_issue(qkv, un, tid, kr, vr);
    int buf = 0;
    for (; jl < PER_X; jl += G8) {
        __syncthreads();
        LAS unsigned char* kb = F.lds + buf * ABUF;
        const bf16x8 q0 = qn0, q1 = qn1;
        {
            LAS unsigned char* ob = F.lds + (buf ^ 1) * ABUF;
#pragma unroll
            for (int jj = 0; jj < 4; ++jj) { const int ch = tid + 512 * jj, row = ch >> 3, c16 = ch & 7;
                *(LAS u32x4*)(ob + row * ATT_ROWB + c16 * 16) = kr[jj]; *(LAS u32x4*)(ob + ATT_VOFF + row * ATT_ROWB + c16 * 16) = vr[jj]; }
        }
        const AttnUnit nu = un;
        un = attn_decode(x8 * PER_X + (jl + 2 * G8 < jlast ? jl + 2 * G8 : jlast)); attn_issue(qkv, un, tid, kr, vr);
        { const size_t tq = (size_t)nu.b * SEQ + (size_t)(128 * nu.n + 16 * w + fr) * nu.d + nu.r; const bf16_t* qp = qkv + tq * NPROJ + nu.h * 64 + 8 * fq; qn0 = *(const bf16x8*)qp; qn1 = *(const bf16x8*)(qp + 32); }
        const size_t tokq = (size_t)cu.b * SEQ + (size_t)(128 * cu.n + 16 * w + fr) * cu.d + cu.r;
        const float c1 = 0.125f * LOG2E;
        const float nc2 = -__builtin_amdgcn_exp2f(-(float)(cu.h + 1)) * (float)cu.d * LOG2E;
        const bool first = cu.n == 0;
        f32x4 St[9];
        float mx = -INFINITY;
        bf16x8 kf[9][2];
#pragma unroll
        for (int T = 0; T < 9; ++T) { LAS unsigned char* ka = kb + (16 * (w + T) + fr) * ATT_ROWB + fq * 16; kf[T][0] = *(LAS bf16x8*)ka; kf[T][1] = *(LAS bf16x8*)(ka + 64); }
        __builtin_amdgcn_sched_barrier(0);
#pragma unroll
        for (int T = 0; T < 9; ++T) {
            f32x4 sa = (f32x4){0.f, 0.f, 0.f, 0.f};
            sa = __builtin_amdgcn_mfma_f32_16x16x32_bf16(kf[T][0], q0, sa, 0, 0, 0);
            sa = __builtin_amdgcn_mfma_f32_16x16x32_bf16(kf[T][1], q1, sa, 0, 0, 0);
            const float kT = (!first || w + T >= 8) ? nc2 * (float)(128 - 16 * T) : -INFINITY;
#pragma unroll
            for (int rg = 0; rg < 4; ++rg) {
                float s2 = __builtin_fmaf(ef[rg], nc2, __builtin_fmaf(sa[rg], c1, kT));
                if (T == 0) s2 = ef[rg] <= 0.f ? s2 : -INFINITY;
                if (T == 8) s2 = ef[rg] >= 0.f ? s2 : -INFINITY;
                sa[rg] = s2;
            }
            St[T] = sa;
            mx = fmaxf(mx, fmaxf(fmaxf(sa[0], sa[1]), fmaxf(sa[2], sa[3])));
        }
        mx = fmaxf(mx, __shfl_xor(mx, 16)); mx = fmaxf(mx, __shfl_xor(mx, 32));
        float l = 0.f;
#pragma unroll
        for (int T = 0; T < 9; ++T)
#pragma unroll
            for (int rg = 0; rg < 4; ++rg) { const float p = fast_exp2(St[T][rg] - mx); St[T][rg] = p; l += p; }
        l += __shfl_xor(l, 16); l += __shfl_xor(l, 32);
        f32x4 O[4];
#pragma unroll
        for (int dt = 0; dt < 4; ++dt) O[dt] = (f32x4){0.f, 0.f, 0.f, 0.f};
#pragma unroll
        for (int T = 0; T < 9; ++T) {
            u32x2 pw; pw.x = cvt_pk_bf16(St[T][0], St[T][1]); pw.y = cvt_pk_bf16(St[T][2], St[T][3]);
            const s16x4 pb = __builtin_bit_cast(s16x4, pw);
            LAS unsigned char* va = kb + ATT_VOFF + (16 * (w + T) + 4 * fq + (fr >> 2)) * ATT_ROWB + (8 * (fr & 3)) * 2;
#pragma unroll
            for (int dt = 0; dt < 4; ++dt) O[dt] = __builtin_amdgcn_mfma_f32_16x16x16bf16_1k(tr_read(va + 64 * (dt >> 1) + 8 * (dt & 1)), pb, O[dt], 0, 0, 0);
        }
        const float inv = 1.f / l;
        bf16_t* op = part + ((size_t)cu.dsel * NTOK + tokq) * 512 + cu.h * 64 + 8 * fq;
#pragma unroll
        for (int u2 = 0; u2 < 2; ++u2) { u32x4 o4; o4.x = cvt_pk_bf16(O[2 * u2][0] * inv, O[2 * u2][1] * inv); o4.y = cvt_pk_bf16(O[2 * u2][2] * inv, O[2 * u2][3] * inv);
            o4.z = cvt_pk_bf16(O[2 * u2 + 1][0] * inv, O[2 * u2 + 1][1] * inv); o4.w = cvt_pk_bf16(O[2 * u2 + 1][2] * inv, O[2 * u2 + 1][3] * inv); *(u32x4*)(op + 32 * u2) = o4; }
        if (fq == 0) lse[((size_t)cu.dsel * NTOK + tokq) * 8 + cu.h] = mx + __builtin_amdgcn_logf(l);
        cu = nu; buf ^= 1;
    }
    __syncthreads();
}

constexpr int SGU_ROWB = 1040;
__device__ __forceinline__ void phase_sgu(Frame& F) {
    const bf16_t* qkv = WSP(F, WS_B, bf16_t);
    bf16_t* sgu = (bf16_t*)F.a->out + (size_t)3 * NTOK * 512;
    const bf16_t* Wsp = WSP(F, WS_WSP, bf16_t);
    const float* lng = F.a->in[I_LNG]; const float* lnb = F.a->in[I_LNB]; const float* bsp = F.a->in[I_BSP];
    const int w = F.wave, lane = F.lane, fr = lane & 15, fq = lane >> 4;
    for (int un = blockIdx.x; un < NTOK / 128; un += F.G) {
        const size_t tok0 = (size_t)un * 128;
        __syncthreads();
        float g8[8], b8[8];
#pragma unroll
        for (int j = 0; j < 8; ++j) { g8[j] = lng[8 * lane + j]; b8[j] = lnb[8 * lane + j]; }
#pragma unroll 1
        for (int i0 = 0; i0 < 16; i0 += 8) {
        u32x4 zrv[8];
#pragma unroll
        for (int i = 0; i < 8; ++i) zrv[i] = *(const u32x4*)(qkv + (tok0 + 16 * w + i0 + i) * NPROJ + 2048 + 8 * lane);
#pragma unroll
        for (int i = 0; i < 8; ++i) { const int s = 16 * w + i0 + i;
            const u32x4 zr = zrv[i];
            float z[8]; z[0] = bflo(zr.x); z[1] = bfhi(zr.x); z[2] = bflo(zr.y); z[3] = bfhi(zr.y); z[4] = bflo(zr.z); z[5] = bfhi(zr.z); z[6] = bflo(zr.w); z[7] = bfhi(zr.w);
            float sm = 0.f;
#pragma unroll
            for (int j = 0; j < 8; ++j) { z[j] = gelu_f(z[j]); sm += z[j]; }
            const float mean = wave_sum(sm) * (1.f / 512.f); float sq = 0.f;
#pragma unroll
            for (int j = 0; j < 8; ++j) { z[j] -= mean; sq += z[j] * z[j]; }
            const float rstd = 1.f / sqrtf(wave_sum(sq) * (1.f / 512.f) + EPS);
#pragma unroll
            for (int j = 0; j < 8; ++j) z[j] = z[j] * rstd * g8[j] + b8[j];
            u32x4 o; o.x = cvt_pk_bf16(z[0], z[1]); o.y = cvt_pk_bf16(z[2], z[3]); o.z = cvt_pk_bf16(z[4], z[5]); o.w = cvt_pk_bf16(z[6], z[7]);
            *(LAS u32x4*)(F.lds + s * SGU_ROWB + lane * 16) = o; }
        }
        __syncthreads();
        const int cw = 64 * w, g = w >> 1;
        f32x4 acc[4][8];
#pragma unroll
        for (int ct = 0; ct < 4; ++ct)
#pragma unroll
            for (int tt = 0; tt < 8; ++tt) acc[ct][tt] = (f32x4){0.f, 0.f, 0.f, 0.f};
#pragma unroll
        for (int ks = 0; ks < 4; ++ks) {
            bf16x8 af[4];
#pragma unroll
            for (int ct = 0; ct < 4; ++ct) {
                LAS unsigned char* pa = F.lds + (32 * ks + 8 * fq + (fr >> 2)) * SGU_ROWB + (cw + 32 * (ct >> 1) + 8 * (fr & 3) + 4 * (ct & 1)) * 2;
                const s16x4 lo = tr_read(pa), hi = tr_read(pa + 4 * SGU_ROWB);
                af[ct].s0 = lo.x; af[ct].s1 = lo.y; af[ct].s2 = lo.z; af[ct].s3 = lo.w; af[ct].s4 = hi.x; af[ct].s5 = hi.y; af[ct].s6 = hi.z; af[ct].s7 = hi.w;
            }
            bf16x8 bfr[8];
#pragma unroll
            for (int tt = 0; tt < 8; ++tt) if (16 * tt + 15 >= 32 * ks) bfr[tt] = *(const bf16x8*)(Wsp + ((size_t)(g * 128 + 16 * tt + fr) * 128 + 32 * ks + 8 * fq));
#pragma unroll
            for (int tt = 0; tt < 8; ++tt) {
                if (16 * tt + 15 < 32 * ks) continue;
#pragma unroll
                for (int ct = 0; ct < 4; ++ct) acc[ct][tt] = __builtin_amdgcn_mfma_f32_16x16x32_bf16(af[ct], bfr[tt], acc[ct][tt], 0, 0, 0);
            }
        }
        float bsv[8];
#pragma unroll
        for (int tt = 0; tt < 8; ++tt) bsv[tt] = bsp[g * 128 + 16 * tt + fr];
#pragma unroll
        for (int th = 0; th < 2; ++th) {
            u32x4 urv[4][2];
#pragma unroll
            for (int i = 0; i < 4; ++i)
#pragma unroll
                for (int cp = 0; cp < 2; ++cp) urv[i][cp] = *(const u32x4*)(qkv + (tok0 + 16 * (4 * th + i) + fr) * NPROJ + 1536 + cw + 32 * cp + 8 * fq);
#pragma unroll
            for (int i = 0; i < 4; ++i) { const int tt = 4 * th + i, t = 16 * tt + fr; const float bs = bsv[tt];
#pragma unroll
                for (int cp = 0; cp < 2; ++cp) { const int c0 = cw + 32 * cp + 8 * fq;
                    const u32x4 ur = urv[i][cp];
                    u32x4 o;
                    o.x = cvt_pk_bf16(gelu_f(bflo(ur.x)) * (acc[2 * cp][tt][0] + bs), gelu_f(bfhi(ur.x)) * (acc[2 * cp][tt][1] + bs));
                    o.y = cvt_pk_bf16(gelu_f(bflo(ur.y)) * (acc[2 * cp][tt][2] + bs), gelu_f(bfhi(ur.y)) * (acc[2 * cp][tt][3] + bs));
                    o.z = cvt_pk_bf16(gelu_f(bflo(ur.z)) * (acc[2 * cp + 1][tt][0] + bs), gelu_f(bfhi(ur.z)) * (acc[2 * cp + 1][tt][1] + bs));
                    o.w = cvt_pk_bf16(gelu_f(bflo(ur.w)) * (acc[2 * cp + 1][tt][2] + bs), gelu_f(bfhi(ur.w)) * (acc[2 * cp + 1][tt][3] + bs));
                    *(u32x4*)(sgu + (tok0 + t) * 512 + c0) = o; } }
        }
    }
    __syncthreads();
}

__device__ __forceinline__ void phase_merge(Frame& F) {
    const bf16_t* part = (const bf16_t*)F.a->out; const bf16_t* sgu = part + (size_t)3 * NTOK * 512;
    const float* lse = WSP(F, WS_LSE, float); bf16_t* mixed = WSP(F, WS_A, bf16_t);
    const float* goa = F.a->in[I_GOA]; const float* gos = F.a->in[I_GOS];
    const int lane = F.lane, gw = F.vcu * 8 + F.wave, NGW = F.G * 8, h = lane >> 3;
    const f32x4 ga0 = *(const f32x4*)(goa + 8 * lane), ga1 = *(const f32x4*)(goa + 8 * lane + 4), gs0 = *(const f32x4*)(gos + 8 * lane), gs1 = *(const f32x4*)(gos + 8 * lane + 4);
    constexpr int NT = 2;
#pragma unroll 1
    for (int mb = gw; mb < NTOK; mb += NT * NGW) {
        float lv[NT][3]; u32x4 pv[NT][3], sr[NT];
#pragma unroll
        for (int t = 0; t < NT; ++t) { const int m = mb + t * NGW;
#pragma unroll
            for (int k = 0; k < 3; ++k) { lv[t][k] = lse[((size_t)k * NTOK + m) * 8 + h]; pv[t][k] = *(const u32x4*)(part + ((size_t)k * NTOK + m) * 512 + 8 * lane); }
            sr[t] = *(const u32x4*)(sgu + (size_t)m * 512 + 8 * lane); }
        float a[NT][8], sv[NT][8], sqa[NT], sqs[NT];
#pragma unroll
        for (int t = 0; t < NT; ++t) {
            const float mx = fmaxf(lv[t][0], fmaxf(lv[t][1], lv[t][2]));
            float w0 = fast_exp2(lv[t][0] - mx), w1 = fast_exp2(lv[t][1] - mx), w2 = fast_exp2(lv[t][2] - mx);
            const float iw = 1.f / (w0 + w1 + w2); w0 *= iw; w1 *= iw; w2 *= iw;
            sqa[t] = 0.f; sqs[t] = 0.f;
#pragma unroll
            for (int j = 0; j < 4; ++j) { a[t][2 * j] = w0 * bflo(pv[t][0][j]) + w1 * bflo(pv[t][1][j]) + w2 * bflo(pv[t][2][j]); a[t][2 * j + 1] = w0 * bfhi(pv[t][0][j]) + w1 * bfhi(pv[t][1][j]) + w2 * bfhi(pv[t][2][j]);
                sv[t][2 * j] = bflo(sr[t][j]); sv[t][2 * j + 1] = bfhi(sr[t][j]); }
#pragma unroll
            for (int j = 0; j < 8; ++j) { sqa[t] += a[t][j] * a[t][j]; sqs[t] += sv[t][j] * sv[t][j]; }
        }
#pragma unroll
        for (int t = 0; t < NT; ++t) { sqa[t] = wave_sum(sqa[t]); sqs[t] = wave_sum(sqs[t]); }
#pragma unroll
        for (int t = 0; t < NT; ++t) { const int m = mb + t * NGW;
            const float rsa = 1.f / sqrtf(sqa[t] * (1.f / 512.f) + EPS), rss = 1.f / sqrtf(sqs[t] * (1.f / 512.f) + EPS);
            float oa[8], os[8];
            oa[0] = a[t][0] * rsa * ga0.x; oa[1] = a[t][1] * rsa * ga0.y; oa[2] = a[t][2] * rsa * ga0.z; oa[3] = a[t][3] * rsa * ga0.w;
            oa[4] = a[t][4] * rsa * ga1.x; oa[5] = a[t][5] * rsa * ga1.y; oa[6] = a[t][6] * rsa * ga1.z; oa[7] = a[t][7] * rsa * ga1.w;
            os[0] = sv[t][0] * rss * gs0.x; os[1] = sv[t][1] * rss * gs0.y; os[2] = sv[t][2] * rss * gs0.z; os[3] = sv[t][3] * rss * gs0.w;
            os[4] = sv[t][4] * rss * gs1.x; os[5] = sv[t][5] * rss * gs1.y; os[6] = sv[t][6] * rss * gs1.z; os[7] = sv[t][7] * rss * gs1.w;
#pragma unroll
            for (int j = 0; j < 8; ++j) { oa[j] = fminf(fmaxf(oa[j], -448.f), 448.f); os[j] = fminf(fmaxf(os[j], -448.f), 448.f); }
            u32x2 wa, wsg;
            { int w0 = __builtin_amdgcn_cvt_pk_fp8_f32(oa[0], oa[1], 0, false); w0 = __builtin_amdgcn_cvt_pk_fp8_f32(oa[2], oa[3], w0, true);
              int w1 = __builtin_amdgcn_cvt_pk_fp8_f32(oa[4], oa[5], 0, false); w1 = __builtin_amdgcn_cvt_pk_fp8_f32(oa[6], oa[7], w1, true); wa.x = (unsigned)w0; wa.y = (unsigned)w1; }
            { int w0 = __builtin_amdgcn_cvt_pk_fp8_f32(os[0], os[1], 0, false); w0 = __builtin_amdgcn_cvt_pk_fp8_f32(os[2], os[3], w0, true);
              int w1 = __builtin_amdgcn_cvt_pk_fp8_f32(os[4], os[5], 0, false); w1 = __builtin_amdgcn_cvt_pk_fp8_f32(os[6], os[7], w1, true); wsg.x = (unsigned)w0; wsg.y = (unsigned)w1; }
            unsigned char* mrow = (unsigned char*)mixed + (size_t)m * D;
            *(u32x2*)(mrow + 8 * lane) = wa;
            *(u32x2*)(mrow + 512 + 8 * lane) = wsg; }
    }
}

__device__ __forceinline__ float wave_max_bcast(float v) {
    const float ninf = -INFINITY;
    v = fmaxf(v, dpp_f<0x111>(ninf, v)); v = fmaxf(v, dpp_f<0x112>(ninf, v)); v = fmaxf(v, dpp_f<0x114>(ninf, v)); v = fmaxf(v, dpp_f<0x118>(ninf, v));
    v = fmaxf(v, dpp_f<0x142, 0xa>(ninf, v)); v = fmaxf(v, dpp_f<0x143, 0xc>(ninf, v));
    return __builtin_bit_cast(float, __builtin_amdgcn_readlane(__builtin_bit_cast(int, v), 63));
}
__device__ __forceinline__ void router_topk(Frame& F, int tile) {
    const float* logits = WSP(F, WS_B, float); const float* br = F.a->in[I_BR];
    int* tk_e = WSP(F, WS_TOPK_E, int); float* tk_g = WSP(F, WS_TOPK_G, float); int* tk_p = WSP(F, WS_TOPK_P, int);
    int* gcnt = (int*)(F.a->ws + WS_CTL + CTL_CNT);
    LAS int* hist = (LAS int*)F.lds; LAS int* base = hist + 256;
    const int lane = F.lane, w = F.wave;
    if (F.tid < 256) hist[F.tid] = 0;
    __syncthreads();
    const f32x4 bias = *(const f32x4*)(br + 4 * lane);
    f32x4 lgn = *(const f32x4*)(logits + (size_t)(tile * 256 + w * 32) * 256 + 4 * lane);
    for (int i = 0; i < 32; ++i) {
        const int tok = tile * 256 + w * 32 + i;
        const f32x4 lg = lgn;
        if (i + 1 < 32) lgn = *(const f32x4*)(logits + (size_t)(tok + 1) * 256 + 4 * lane);
        float sc[4], ch[4];
#pragma unroll
        for (int j = 0; j < 4; ++j) { sc[j] = 1.f / (1.f + __expf(-lg[j])); ch[j] = sc[j] + bias[j]; }
        float t1 = fmaxf(ch[0], ch[1]), t2 = fminf(ch[0], ch[1]);
        { const float a = fmaxf(ch[2], ch[3]), b = fminf(ch[2], ch[3]); const float n1 = fmaxf(t1, a), n2 = fmaxf(fminf(t1, a), fmaxf(t2, b)); t1 = n1; t2 = n2; }
        { const float a = dpp_f<0xB1>(t1, t1), b = dpp_f<0xB1>(t2, t2); const float n1 = fmaxf(t1, a), n2 = fmaxf(fminf(t1, a), fmaxf(t2, b)); t1 = n1; t2 = n2; }
        { const float a = dpp_f<0x4E>(t1, t1), b = dpp_f<0x4E>(t2, t2); const float n1 = fmaxf(t1, a), n2 = fmaxf(fminf(t1, a), fmaxf(t2, b)); t1 = n1; t2 = n2; }
        { const float a = dpp_f<0x141>(t1, t1), b = dpp_f<0x141>(t2, t2); const float n1 = fmaxf(t1, a), n2 = fmaxf(fminf(t1, a), fmaxf(t2, b)); t1 = n1; t2 = n2; }
        const float gs = t1 + t2; int ngt = 0;
#pragma unroll
        for (int j = 0; j < 8; ++j) { const float o = __builtin_bit_cast(float, __builtin_amdgcn_readlane(__builtin_bit_cast(int, gs), 8 * j)); ngt += (o > gs) ? 1 : 0; }
        const bool keep = ngt < 4;
#pragma unroll
        for (int j = 0; j < 4; ++j) ch[j] = keep ? ch[j] : -INFINITY;
        int my_e = 0; float my_s = 0.f;
#pragma unroll 1
        for (int k = 0; k < 8; ++k) {
            float bv = ch[0]; int bj = 0; float bs = sc[0];
#pragma unroll
            for (int j = 1; j < 4; ++j) if (ch[j] > bv) { bv = ch[j]; bj = j; bs = sc[j]; }
            const float M = wave_max_bcast(bv);
            const unsigned long long hit = __ballot(bv == M);
            const int owner = __builtin_ctzll(hit);
            const int be = __builtin_amdgcn_readlane(4 * lane + bj, owner);
            const float bsc = __builtin_bit_cast(float, __builtin_amdgcn_readlane(__builtin_bit_cast(int, bs), owner));
            if (lane == k) { my_e = be; my_s = bsc; }
            if (lane == owner) {
#pragma unroll
                for (int j = 0; j < 4; ++j) if (bj == j) ch[j] = -INFINITY;
            }
        }
        float ssum = my_s;
        ssum += dpp_f<0xB1>(0.f, ssum); ssum += dpp_f<0x4E>(0.f, ssum); ssum += dpp_f<0x141>(0.f, ssum);
        if (lane < 8) {
            const int p = __hip_atomic_fetch_add(&hist[my_e], 1, __ATOMIC_RELAXED, __HIP_MEMORY_SCOPE_WORKGROUP);
            tk_e[(size_t)tok * 8 + lane] = my_e; tk_g[(size_t)tok * 8 + lane] = my_s / ssum * 2.5f; tk_p[(size_t)tok * 8 + lane] = p;
        }
    }
    __syncthreads();
    const int chunk = (tile * 256) / CHT;
    if (F.tid < 256) { const int c = hist[F.tid]; base[F.tid] = c > 0 ? atomicAdd(&gcnt[chunk * NE + F.tid], c) : 0; }
    __syncthreads();
    {
      const size_t e0 = (size_t)(tile * 256 + w * 32) * 8 + 4 * lane;
      const i32x4 e4 = *(const i32x4*)(tk_e + e0); i32x4 p4 = *(const i32x4*)(tk_p + e0);
      p4.x += base[e4.x]; p4.y += base[e4.y]; p4.z += base[e4.z]; p4.w += base[e4.w];
      *(i32x4*)(tk_p + e0) = p4; }
    __syncthreads();
}

__device__ __forceinline__ void phase_dispatch(Frame& F) {
    const int* gcnt = (const int*)(F.a->ws + WS_CTL + CTL_CNT);
    LAS int* off = (LAS int*)F.lds;
    LAS int* tst = off + NCH * NE;
    LAS int* cnt = tst + NCH * NE;
    LAS int* ntl = cnt + NCH * NE;
    for (int i = F.tid; i < NCH * NE; i += NTHR) cnt[i] = gcnt[i];
    __syncthreads();
    if (F.wave < NCH) {
        const int c = F.wave; int cv[4], tv[4], so = 0, st = 0;
#pragma unroll
        for (int j = 0; j < 4; ++j) { cv[j] = cnt[c * NE + 4 * F.lane + j]; tv[j] = (cv[j] + 255) >> 8; so += cv[j]; st += tv[j]; }
        int io = so, it = st;
#define ISCAN(v) do { v += __builtin_amdgcn_update_dpp(0, v, 0x111, 0xf, 0xf, false); v += __builtin_amdgcn_update_dpp(0, v, 0x112, 0xf, 0xf, false); v += __builtin_amdgcn_update_dpp(0, v, 0x114, 0xf, 0xf, false); \
        v += __builtin_amdgcn_update_dpp(0, v, 0x118, 0xf, 0xf, false); v += __builtin_amdgcn_update_dpp(0, v, 0x142, 0xa, 0xf, false); v += __builtin_amdgcn_update_dpp(0, v, 0x143, 0xc, 0xf, false); } while (0)
        ISCAN(io); ISCAN(it);
#undef ISCAN
        int o = io - so, t = it - st;
#pragma unroll
        for (int j = 0; j < 4; ++j) { off[c * NE + 4 * F.lane + j] = o; tst[c * NE + 4 * F.lane + j] = t; o += cv[j]; t += tv[j]; }
        if (F.lane == 63) ntl[c] = it;
    }
    __syncthreads();
    int* te = WSP(F, WS_TILE, int); int* trow0 = te + NCH * MAXTILES; int* tnv = trow0 + NCH * MAXTILES; int* ntiles = tnv + NCH * MAXTILES;
    if (blockIdx.x < NCH) { const int c = blockIdx.x;
        for (int e = F.tid; e < NE; e += NTHR) { const int n = cnt[c * NE + e], t0 = tst[c * NE + e], o = off[c * NE + e];
            for (int m = 0; m * 256 < n; ++m) { te[c * MAXTILES + t0 + m] = e; trow0[c * MAXTILES + t0 + m] = o + 256 * m; tnv[c * MAXTILES + t0 + m] = (n - 256 * m) < 256 ? (n - 256 * m) : 256; } }
        const int nr = ntl[c];
        for (int m = F.tid; m < CHT / 256; m += NTHR) { te[c * MAXTILES + nr + m] = NE; trow0[c * MAXTILES + nr + m] = CH_ROUTED + 256 * m; tnv[c * MAXTILES + nr + m] = 256; }
        if (F.tid == 0) ntiles[c] = nr + CHT / 256;
    }
    const int* tk_e = WSP(F, WS_TOPK_E, int); int* tk_p = WSP(F, WS_TOPK_P, int);
    int* rowtok = WSP(F, WS_ROWTOK, int);
    for (int a = blockIdx.x * NTHR + F.tid; a < NTOK * 8; a += F.G * NTHR) { const int tok = a >> 3, c = tok / CHT;
        const int e = tk_e[a], slot = off[c * NE + e] + tk_p[a];
        rowtok[(size_t)c * CH_ROUTED + slot] = tok; tk_p[a] = slot; }
    __syncthreads();
}

__device__ __forceinline__ void phase_combine(Frame& F, int chunk) {
    const unsigned char* Y = WSP(F, WS_B, unsigned char); const int* slot = WSP(F, WS_TOPK_P, int); const float* tkg = WSP(F, WS_TOPK_G, float);
    const float* mod = WSP(F, WS_MOD, float); const float* gf = F.a->in[I_GFIN];
    const int lane = F.lane, gw = F.vcu * 8 + F.wave, NGW = F.G * 8, c0 = 16 * lane;
    typedef float f32x2 __attribute__((ext_vector_type(2)));
    typedef int i32x4 __attribute__((ext_vector_type(4)));
    int mi = gw;
    if (mi >= CHT) return;
    f32x4 gfv[4];
#pragma unroll
    for (int i = 0; i < 4; ++i) gfv[i] = *(const f32x4*)(gf + c0 + 4 * i);
    i32x4 rn0, rn1; f32x4 gn0, gn1;
    { const size_t m = (size_t)chunk * CHT + mi; rn0 = *(const i32x4*)(slot + m * 8); rn1 = *(const i32x4*)(slot + m * 8 + 4); gn0 = *(const f32x4*)(tkg + m * 8); gn1 = *(const f32x4*)(tkg + m * 8 + 4); }
#pragma unroll 1
    for (; mi < CHT; mi += NGW) { const int m = chunk * CHT + mi, b = m / SEQ;
        const i32x4 r0 = rn0, r1 = rn1; const f32x4 g0 = gn0 * (1.f / YSCALE), g1 = gn1 * (1.f / YSCALE);
        u32x4 yv[9];
        yv[0] = *(const u32x4*)(Y + (size_t)r0.x * D + c0); yv[1] = *(const u32x4*)(Y + (size_t)r0.y * D + c0); yv[2] = *(const u32x4*)(Y + (size_t)r0.z * D + c0); yv[3] = *(const u32x4*)(Y + (size_t)r0.w * D + c0);
        yv[4] = *(const u32x4*)(Y + (size_t)r1.x * D + c0); yv[5] = *(const u32x4*)(Y + (size_t)r1.y * D + c0); yv[6] = *(const u32x4*)(Y + (size_t)r1.z * D + c0); yv[7] = *(const u32x4*)(Y + (size_t)r1.w * D + c0);
        yv[8] = *(const u32x4*)(Y + (size_t)(CH_ROUTED + mi) * D + c0);
        float* hrow = F.a->out + (size_t)m * D;
        f32x4 g2v[4];
#pragma unroll
        for (int i = 0; i < 4; ++i) g2v[i] = *(const f32x4*)(mod + b * 6144 + 5120 + c0 + 4 * i);
        f32x4 hv[4];
        { const bf16_t* hb = h_row(F.a->out, F.a->ws, m) + c0; const u32x4 ha = *(const u32x4*)hb, hc = *(const u32x4*)(hb + 8);
          hv[0] = (f32x4){bflo(ha.x), bfhi(ha.x), bflo(ha.y), bfhi(ha.y)}; hv[1] = (f32x4){bflo(ha.z), bfhi(ha.z), bflo(ha.w), bfhi(ha.w)};
          hv[2] = (f32x4){bflo(hc.x), bfhi(hc.x), bflo(hc.y), bfhi(hc.y)}; hv[3] = (f32x4){bflo(hc.z), bfhi(hc.z), bflo(hc.w), bfhi(hc.w)}; }
        if (mi + NGW < CHT) { const size_t mn = (size_t)m + NGW; rn0 = *(const i32x4*)(slot + mn * 8); rn1 = *(const i32x4*)(slot + mn * 8 + 4); gn0 = *(const f32x4*)(tkg + mn * 8); gn1 = *(const f32x4*)(tkg + mn * 8 + 4); }
        const float gk[9] = {g0.x, g0.y, g0.z, g0.w, g1.x, g1.y, g1.z, g1.w, 1.f / YSCALE};
        f32x4 acc[4];
#pragma unroll
        for (int i = 0; i < 4; ++i) acc[i] = (f32x4){0.f, 0.f, 0.f, 0.f};
#pragma unroll
        for (int k = 0; k < 9; ++k)
#pragma unroll
            for (int i = 0; i < 4; ++i) { const f32x2 lo = __builtin_amdgcn_cvt_pk_f32_fp8((int)yv[k][i], false), hi = __builtin_amdgcn_cvt_pk_f32_fp8((int)yv[k][i], true);
                acc[i].x += gk[k] * lo.x; acc[i].y += gk[k] * lo.y; acc[i].z += gk[k] * hi.x; acc[i].w += gk[k] * hi.y; }
        float sq = 0.f;
#pragma unroll
        for (int i = 0; i < 4; ++i) { const f32x4 g2 = g2v[i];
            hv[i] = hv[i] + g2 * acc[i];
            sq += (hv[i].x * hv[i].x + hv[i].y * hv[i].y) + (hv[i].z * hv[i].z + hv[i].w * hv[i].w); }
        const float rs = 1.f / sqrtf(wave_sum(sq) * (1.f / D) + EPS);
#pragma unroll
        for (int i = 0; i < 4; ++i) *(f32x4*)(hrow + c0 + 4 * i) = hv[i] * rs * gfv[i];
    }
}

constexpr int N_PHASES = 9 + 3 * NCH;
#ifndef REP_MASK
#define REP_MASK 0u
#endif
#define NREP(k) (1 + (int)((REP_MASK >> (k)) & 1u))
#ifndef PROBE_KIND
#define PROBE_KIND 0
#endif
__global__ void __launch_bounds__(NTHR, 2) hybrid_fwd(Args args) {
    extern __shared__ __attribute__((aligned(16))) unsigned char lds_raw[];
    LAS unsigned char* const lds = (LAS unsigned char*)lds_raw;
    volatile LAS unsigned* MISC = (volatile LAS unsigned*)(lds + MISC_OFF);
    if (threadIdx.x < 64) MISC[threadIdx.x] = 0u;
    __syncthreads();
    XcdBarrier bar; bar.bar = (unsigned*)(args.ws + WS_CTL); bar.x = 0; bar.st = nullptr;
    const int lo = args.ph_lo, hi = args.ph_hi;
    if (hi - lo > 1) bar = xcd_barrier_post((unsigned*)(args.ws + WS_CTL), MISC + 8);
#define IN(k) (lo <= (k) && (k) < hi)
#define SEAM(k) do { if (IN(k) && IN((k) + 1)) xcd_barrier(bar); } while (0)

    if (IN(0)) { for (int rep = 0; rep < NREP(0); ++rep) { Frame F = make_frame(lds); phase_mod(F); } } SEAM(0);
    if (IN(1)) { for (int rep = 0; rep < NREP(1); ++rep) { Frame F = make_frame(lds); phase_prep(F); } } SEAM(1);
    if (IN(2)) for (int rep = 0; rep < NREP(2); ++rep) {
        const bool conv_first = (blockIdx.x >> 3) & 1;
        if (conv_first && rep == 0) { Frame F = make_frame(lds); convert_experts(F, 0, CONV_ITEMS); }
        { Frame F = make_frame(lds);
        pg8::DenseSched<512> S; S.init(F.a->ws + WS_A, F.a->ws + WS_WTIN, NTOK, NPROJ, F.G, (int)blockIdx.x, F.tid);
        EpiBf16T<true> E{WSP(F, WS_B, bf16_t), NPROJ};
        pg8::gemm_phase<512, EpiBf16T<true>, pg8::DenseSched<512>, true, true>(F.lds, F.tid, S, E); }
        if (!conv_first && rep == 0) { Frame F = make_frame(lds); convert_experts(F, 0, CONV_ITEMS); }
    } SEAM(2);
    if (IN(3)) { for (int rep = 0; rep < NREP(3); ++rep) { Frame F = make_frame(lds); phase_attn(F); } for (int rep = 0; rep < NREP(21); ++rep) { Frame F = make_frame(lds); phase_sgu(F); } } SEAM(3);
    if (IN(4)) { for (int rep = 0; rep < NREP(4); ++rep) { Frame F = make_frame(lds); phase_merge(F); } } SEAM(4);
    if (IN(5)) for (int rep = 0; rep < NREP(5); ++rep) {
        Frame F = make_frame(lds);
        pg8::DenseSched<512> S; S.init(F.a->ws + WS_A, F.a->ws + WS_WTOUT, NTOK, D, F.G, (int)blockIdx.x, F.tid);
        EpiResH E{F.a->in[I_X], WSP(F, WS_MOD, float) + 2048, F.a->out, F.a->ws};
        pg8::gemm_phase<512, EpiResH, pg8::DenseSched<512>, true, true>(F.lds, F.tid, S, E);
    } SEAM(5);
    if (IN(7)) {
        Frame F = make_frame(lds);
        pg8::DenseSched<1024> S; S.init(F.a->ws + WS_A, F.a->ws + WS_WTR, NTOK, NE, F.G, (int)blockIdx.x, F.tid);
        { const float* mod = WSP(F, WS_MOD, float); bf16_t* n2 = WSP(F, WS_A, bf16_t); Unit u0;
          for (int i = 0; S.next(i, u0); ++i) for (int r = 4 * F.wave; r < 256; r += 32) { const int m = u0.t * 256 + r, b = m / SEQ;
              norm_mod_rows<4, true>(h_row(F.a->out, F.a->ws, m), D, F.a->in[I_GFFN], mod + b * 6144 + 3072, mod + b * 6144 + 4096, n2 + (size_t)m * D, D, F.lane, WSP(F, WS_N2F8, unsigned char) + (size_t)m * D); }
          asm volatile("s_waitcnt vmcnt(0)" ::: "memory"); __syncthreads(); }
        EpiF32 E{WSP(F, WS_B, float), NE};
        pg8::gemm_phase<1024, EpiF32, pg8::DenseSched<1024>, true, true>(F.lds, F.tid, S, E);
        asm volatile("s_waitcnt vmcnt(0)" ::: "memory"); __syncthreads();
        Unit u; for (int i = 0; S.next(i, u); ++i) router_topk(F, u.t);
    } SEAM(7);
    if (IN(8)) { Frame F = make_frame(lds); phase_dispatch(F); } SEAM(8);
    const bool comb_late = (blockIdx.x >> 4) & 1;
#pragma unroll
    for (int c = 0; c < NCH; ++c) {
        if (IN(9 + 3 * c)) for (int rep = 0; rep < NREP(9); ++rep) {
            Frame F = make_frame(lds);
            const int* te = WSP(F, WS_TILE, int);
            TileTabs T; T.te = te + c * MAXTILES; T.trow0 = te + NCH * MAXTILES + c * MAXTILES; T.tnv = te + 2 * NCH * MAXTILES + c * MAXTILES;
            T.ntiles = __builtin_amdgcn_readfirstlane((te + 3 * NCH * MAXTILES)[c]);
            Gemm1Sched S; S.init(F.lds, F.a->ws + WS_N2F8, F.a->ws + WS_W1T, WSP(F, WS_ROWTOK, int) + (size_t)c * CH_ROUTED, T, c, F.tid);
            EpiAct E{WSP(F, WS_ACT, unsigned char)};
            pg8::gemm_phase<512, EpiAct, Gemm1Sched, true, true>(F.lds, F.tid, S, E, (NREP(9) > 1 && rep == 0) ? PROBE_KIND : 0);
        }
        if (c > 0 && comb_late && IN(11 + 3 * (c - 1))) { Frame F = make_frame(lds); phase_combine(F, c - 1); }
        SEAM(9 + 3 * c);
        if (IN(10 + 3 * c)) for (int rep = 0; rep < NREP(10); ++rep) {
            Frame F = make_frame(lds);
            const int* te = WSP(F, WS_TILE, int);
            TileTabs T; T.te = te + c * MAXTILES; T.trow0 = te + NCH * MAXTILES + c * MAXTILES; T.tnv = te + 2 * NCH * MAXTILES + c * MAXTILES;
            T.ntiles = __builtin_amdgcn_readfirstlane((te + 3 * NCH * MAXTILES)[c]);
            Gemm2Sched S; S.init(F.lds, F.a->ws + WS_ACT, F.a->ws + WS_W2T, nullptr, T, c, F.tid);
            EpiDown E{WSP(F, WS_B, unsigned char), F.lds, (NREP(10) > 1 && rep == 0 && (PROBE_KIND & 4)) ? 1 : 0};
            pg8::gemm_phase<128, EpiDown, Gemm2Sched, true, true>(F.lds, F.tid, S, E, (NREP(10) > 1 && rep == 0) ? PROBE_KIND : 0);
        } SEAM(10 + 3 * c);
        if (IN(11 + 3 * c) && !(c + 1 < NCH && comb_late)) { Frame F = make_frame(lds); phase_combine(F, c); }
    }
#undef IN
#undef SEAM
}

extern "C" void kernel_launch(void* const* d_in, const int* in_sizes, int n_in, void* d_out, int out_size, void* d_ws, size_t ws_size, hipStream_t stream) {
    static int grid = 0;
    if (grid == 0) {
        if (n_in != 23 || out_size != NTOK * D || ws_size < WS_END) { fprintf(stderr, "kernel_launch: unexpected shapes (n_in %d out %d ws %zu need %zu)\n", n_in, out_size, ws_size, (size_t)WS_END); grid = -1; return; }
        int dev = 0, cus = 0, per_cu = 0;
        if (hipGetDevice(&dev) != hipSuccess || hipDeviceGetAttribute(&cus, hipDeviceAttributeMultiprocessorCount, dev) != hipSuccess) { grid = -1; return; }
        if (hipFuncSetAttribute((const void*)hybrid_fwd, hipFuncAttributeMaxDynamicSharedMemorySize, LDS_BYTES) != hipSuccess) { fprintf(stderr, "kernel_launch: hipFuncSetAttribute failed\n"); grid = -1; return; }
        if (hipOccupancyMaxActiveBlocksPerMultiprocessor(&per_cu, (const void*)hybrid_fwd, NTHR, LDS_BYTES) != hipSuccess || per_cu < 1) fprintf(stderr, "kernel_launch: occupancy query says %d\n", per_cu);
        (void)hipGetLastError();
        grid = cus & ~7;
        if (grid <= 0) { grid = -1; return; }
    }
    if (grid < 0) return;
    if (hipMemsetAsync((char*)d_ws + WS_CTL, 0, CTL_BYTES, stream) != hipSuccess) return;
    Args a{};
    for (int i = 0; i < 23; ++i) a.in[i] = (const float*)d_in[i];
    a.out = (float*)d_out; a.ws = (unsigned char*)d_ws;
#if MK_MULTI
    for (int p = 0; p < N_PHASES; ++p) { a.ph_lo = p; a.ph_hi = p + 1; hipLaunchKernelGGL(hybrid_fwd, dim3(grid), dim3(NTHR), LDS_BYTES, stream, a); }
#else
    a.ph_lo = 0; a.ph_hi = N_PHASES;
    hipLaunchKernelGGL(hybrid_fwd, dim3(grid), dim3(NTHR), LDS_BYTES, stream, a);
#endif
    const hipError_t le = hipPeekAtLastError();
    if (le != hipSuccess) fprintf(stderr, "kernel_launch: launch failed: %s\n", hipGetErrorName(le));
}
```

```cpp
#include <hip/hip_runtime.h>
#include <cstdio>
#include <cstdint>

#ifndef MK_MULTI
#define MK_MULTI 0
#endif

#define GAS __attribute__((address_space(1)))
#define LAS __attribute__((address_space(3)))
#define CAS __attribute__((address_space(4)))
typedef unsigned short bf16_t;
typedef short bf16x8 __attribute__((ext_vector_type(8)));
typedef short s16x4 __attribute__((ext_vector_type(4)));
typedef float f32x4 __attribute__((ext_vector_type(4)));
typedef unsigned u32x4 __attribute__((ext_vector_type(4)));
typedef unsigned u32x2 __attribute__((ext_vector_type(2)));
typedef int i32x4 __attribute__((ext_vector_type(4)));
typedef int i32x8 __attribute__((ext_vector_type(8)));

constexpr int D = 1024, NBATCH = 16, SEQ = 4096, NTOK = NBATCH * SEQ;
constexpr int NPROJ = 2560;
constexpr int NE = 256, TOPK = 8, EDIM = 256;
constexpr int NCH = 2, CHT = NTOK / NCH;
constexpr int CH_ROUTED = CHT * TOPK;
constexpr int CH_ROWS = CH_ROUTED + CHT;
constexpr int MAXTILES = CH_ROUTED / 256 + NE + CHT / 256;
constexpr float W1_PRE = 64.f, W2_PRE = 8.f, ACT_PRE = 4.f;
constexpr int E8M0_ONE = 127;
constexpr int SC_W1 = (E8M0_ONE - 6) * 0x01010101, SC_W2 = (E8M0_ONE - 3) * 0x01010101, SC_ACT = (E8M0_ONE - 2) * 0x01010101, SC_N2 = E8M0_ONE * 0x01010101;
constexpr float YSCALE = 8.f;
constexpr float EPS = 1e-6f;
constexpr float LOG2E = 1.4426950408889634f;

constexpr size_t WS_CTL = 0, CTL_BYTES = 65536;
constexpr size_t CTL_CNT = 16384;
constexpr size_t WS_MOD = 65536;
constexpr size_t WS_WSP = WS_MOD + 393216;
constexpr size_t WS_TILE = WS_WSP + 131072;
constexpr size_t TILE_TAB = (size_t)NCH * MAXTILES * 4;
constexpr size_t WS_OFFS = WS_TILE + 3 * TILE_TAB + 256;
constexpr size_t WS_WTIN = 1048576;
constexpr size_t WS_WTOUT = WS_WTIN + 5242880;
constexpr size_t WS_WTR = WS_WTOUT + 2097152;
constexpr size_t WS_TOPK_E = 9437184;
constexpr size_t WS_TOPK_G = WS_TOPK_E + 2097152;
constexpr size_t WS_TOPK_P = WS_TOPK_G + 2097152;
constexpr size_t WS_ROWTOK = WS_TOPK_P + 2097152;
constexpr size_t WS_W1T = WS_ROWTOK + 2097152;
constexpr size_t WS_W2T = WS_W1T + (size_t)257 * 524288;
constexpr size_t WS_A = WS_W2T + (size_t)257 * 262144;
constexpr size_t WS_B = WS_A + (size_t)NTOK * D * 2;
constexpr size_t WS_ACT = WS_B + (size_t)NTOK * NPROJ * 2;
constexpr size_t WS_LSE = WS_ACT;
constexpr size_t WS_H1 = WS_ACT + (size_t)(CH_ROWS + 256) * EDIM;
constexpr size_t WS_N2F8 = WS_H1 + (size_t)(NTOK / 2) * D * 2;
constexpr size_t WS_END = WS_N2F8 + (size_t)NTOK * D;
static_assert((size_t)(CH_ROWS + 256) * EDIM >= (size_t)3 * NTOK * 8 * 4, "lse fits the act region");
static_assert(WS_OFFS + 4096 <= WS_WTIN && WS_WTR + 524288 <= WS_TOPK_E && (WS_W1T % 256) == 0, "ws map");
static_assert((size_t)CH_ROWS * D <= (size_t)NTOK * NPROJ * 2, "Y chunk (fp8) fits region B");
static_assert(WS_END <= 1118000000ull, "workspace");

constexpr int LDS_BYTES = 155648;
constexpr int MISC_OFF = 153600;
constexpr int NTHR = 512;

__device__ __forceinline__ unsigned cvt_pk_bf16(float lo, float hi) { unsigned r; asm("v_cvt_pk_bf16_f32 %0, %1, %2" : "=v"(r) : "v"(lo), "v"(hi)); return r; }
__device__ __forceinline__ float bf2f(unsigned short b) { return __builtin_bit_cast(float, (unsigned)b << 16); }
__device__ __forceinline__ float bflo(unsigned w) { return __builtin_bit_cast(float, w << 16); }
__device__ __forceinline__ float bfhi(unsigned w) { return __builtin_bit_cast(float, w & 0xffff0000u); }
template <int CTRL, int ROW_MASK = 0xf>
__device__ __forceinline__ float dpp_f(float old, float v) { return __builtin_bit_cast(float, __builtin_amdgcn_update_dpp(__builtin_bit_cast(int, old), __builtin_bit_cast(int, v), CTRL, ROW_MASK, 0xf, false)); }
__device__ __forceinline__ float wave_sum(float v) {
    v += dpp_f<0x111>(0.f, v); v += dpp_f<0x112>(0.f, v); v += dpp_f<0x114>(0.f, v); v += dpp_f<0x118>(0.f, v);
    v += dpp_f<0x142, 0xa>(0.f, v); v += dpp_f<0x143, 0xc>(0.f, v);
    return __builtin_bit_cast(float, __builtin_amdgcn_readlane(__builtin_bit_cast(int, v), 63));
}
__device__ __forceinline__ float fast_exp2(float x) { return __builtin_amdgcn_exp2f(x); }
__device__ __forceinline__ float fast_rcp(float x) { return __builtin_amdgcn_rcpf(x); }
__device__ __forceinline__ float silu_f(float x) { return x * fast_rcp(1.f + fast_exp2(-x * LOG2E)); }
__device__ __forceinline__ float gelu_f(float x) { const float y2 = 2.3022082f * (x + 0.044715f * x * x * x); return x * fast_rcp(1.f + fast_exp2(-y2)); }

#define XB_TMO      128
#define XB_XCNT(j)  (256  + 64 * (j))
#define XB_XSUB(j)  (1280 + 64 * (j))
#define XB_XGEN(j)  (2304 + 64 * (j))
#define XB_TOP      3328
#define XB_TOPGEN   3392
#define XCD_BAR_WORDS 3456
#define XB_SPIN_CAP (1u << 20)
__device__ __forceinline__ unsigned xb_ld(unsigned* p)              { return __hip_atomic_load(p, __ATOMIC_RELAXED, __HIP_MEMORY_SCOPE_AGENT); }
__device__ __forceinline__ unsigned xb_add(unsigned* p, unsigned v) { return __hip_atomic_fetch_add(p, v, __ATOMIC_RELAXED, __HIP_MEMORY_SCOPE_AGENT); }
__device__ __forceinline__ unsigned xb_xcc_id() { return (unsigned)__builtin_amdgcn_s_getreg((3 << 11) | 20) & 0xFu; }
#define XB_SPIN(cond, bar) do { unsigned _sp = 0; while (cond) { __builtin_amdgcn_s_sleep(1); \
    if ((++_sp & 255u) == 0u) { if (xb_ld(&(bar)[XB_TMO])) break; if (_sp > XB_SPIN_CAP) { atomicAdd(&(bar)[XB_TMO], 1u); break; } } } } while (0)
struct XcdBarrier { unsigned* bar; unsigned x; volatile LAS unsigned* st; };
__device__ __forceinline__ XcdBarrier xcd_barrier_post(unsigned* bar, volatile LAS unsigned* st) {
    XcdBarrier b; b.bar = bar; b.x = xb_xcc_id(); b.st = st;
    if (threadIdx.x == 0) (void)xb_add(&bar[XB_XCNT(b.x)], 1u);
    return b;
}
__device__ __forceinline__ void xcd_barrier_complete(unsigned* bar, unsigned x, unsigned& nloc, unsigned& nx) {
    const unsigned G = gridDim.x * gridDim.y * gridDim.z;
    unsigned sum, cnt, mine, sp = 0u;
    for (;;) {
        sum = 0u; cnt = 0u; mine = 0u;
#pragma unroll
        for (unsigned j = 0; j < 16; ++j) { const unsigned c = xb_ld(&bar[XB_XCNT(j)]); sum += c; cnt += (c > 0u) ? 1u : 0u; mine = (j == x) ? c : mine; }
        if (sum == G) break;
        __builtin_amdgcn_s_sleep(1);
        if ((++sp & 255u) == 0u) { if (xb_ld(&bar[XB_TMO])) break; if (sp > XB_SPIN_CAP) { atomicAdd(&bar[XB_TMO], 1u); break; } }
    }
    nloc = mine > 0u ? mine : 1u; nx = cnt > 0u ? cnt : 1u;
}
__device__ __forceinline__ void xcd_barrier(const XcdBarrier& b) {
    asm volatile("s_waitcnt vmcnt(0)" ::: "memory");
    __syncthreads();
    if (threadIdx.x == 0) {
        unsigned* bar = b.bar;
        __builtin_amdgcn_s_waitcnt(0);
        unsigned nloc = b.st[0], nx = b.st[1];
        if (nloc == 0u) { xcd_barrier_complete(bar, b.x, nloc, nx); b.st[0] = nloc; b.st[1] = nx; }
        const unsigned old = xb_add(&bar[XB_XSUB(b.x)], 1u);
        const unsigned gen = old / nloc;
        if (old + 1u == (gen + 1u) * nloc) {
            __builtin_amdgcn_fence(__ATOMIC_RELEASE, "agent");
            asm volatile("s_waitcnt vmcnt(0)" ::: "memory");
            const unsigned og = xb_add(&bar[XB_TOP], 1u);
            const unsigned tg = og / nx;
            if (og + 1u == (tg + 1u) * nx) xb_add(&bar[XB_TOPGEN], 1u);
            else XB_SPIN(xb_ld(&bar[XB_TOPGEN]) == tg, bar);
            __builtin_amdgcn_fence(__ATOMIC_ACQUIRE, "agent");
            xb_add(&bar[XB_XGEN(b.x)], 1u);
            asm volatile("s_waitcnt vmcnt(0)" ::: "memory");
        } else {
            XB_SPIN(xb_ld(&bar[XB_XGEN(b.x)]) == gen, bar);
            __builtin_amdgcn_fence(__ATOMIC_ACQUIRE, "agent");
            asm volatile("s_waitcnt vmcnt(0)" ::: "memory");
        }
    }
    __syncthreads();
}

struct Args { const float* in[23]; float* out; unsigned char* ws; int ph_lo, ph_hi; };
__device__ __forceinline__ bf16_t* h_row(float* out, unsigned char* ws, int m) {
    return m < NTOK / 2 ? (bf16_t*)((unsigned char*)out + (size_t)NTOK * D * 2) + (size_t)m * D : (bf16_t*)(ws + WS_H1) + (size_t)(m - NTOK / 2) * D; }
enum { I_X = 0, I_C, I_WADA, I_BADA, I_GMIX, I_WIN, I_LNG, I_LNB, I_WSP, I_BSP, I_GOA, I_GOS, I_WOUT, I_GFFN, I_WR, I_BR, I_WEG, I_WEU, I_WED, I_WSG, I_WSU, I_WSD, I_GFIN };

namespace pg8 {
constexpr int BM = 256, BK = 64, HALF = 128, HTB = HALF * BK * 2, STAGE_BYTES = 8 * HTB;
__device__ __forceinline__ int lds_byte(int r, int c) { const int st = (r >> 4) * 2 + (c >> 5), rr = r & 15, cc = c & 31, ob = rr * 64 + cc * 2; return st * 1024 + (ob ^ (((ob >> 9) & 1) << 5)); }
__device__ __forceinline__ void stage_rc(int b, int& R, int& C) { const int st = b / 1024, sb = b % 1024, swz = sb ^ (((sb >> 9) & 1) << 5); R = (st >> 1) * 16 + swz / 64; C = (st & 1) * 32 + (swz % 64) / 2; }
__device__ __forceinline__ int perm32(int rho) { const int n = rho >> 4, i = rho & 15; return 8 * (i >> 2) + 4 * n + (i & 3); }

struct Unit { int t, nt, row0, nv, e; };

template <int K, class Epi, class Sched, bool ALIGN_EPI, bool SP2>
__device__ __forceinline__ void gemm_phase(LAS unsigned char* lds, const int tid, const Sched& S, const Epi& E, const int probe = 0) {
    const int wid = __builtin_amdgcn_readfirstlane(tid >> 6), lane = tid & 63, wr = wid >> 2, wc = wid & 3, fr = lane & 15, fq = lane >> 4;
    constexpr int nt = K / BK;
    unsigned voffB[2];
#pragma unroll
    for (int i = 0; i < 2; ++i) { int R, C; stage_rc(tid * 16 + i * 8192, R, C);
        const int Rb = Epi::COL16 ? (64 * (R >> 5) + 16 * ((R & 15) >> 2) + 4 * ((R >> 4) & 1) + (R & 3)) : ((R & ~31) + perm32(R & 31));
        voffB[i] = (unsigned)(Rb * K + C) * 2u; }
    constexpr size_t kstep = (size_t)(BK * 2);
    constexpr size_t hstep = (size_t)HALF * K * 2;
    constexpr size_t bstep = Epi::COL16 ? (size_t)8 * K * 2 : hstep;
    const unsigned ldsw = (unsigned)wid * 1024u;
    const int aoff = lds_byte(wr * 64 + fr, fq * 8), boff = lds_byte(wc * 32 + fr, fq * 8);
#define PG8_SA(b, h) (((b) * 2 + (h)) * HTB)
#define PG8_SB(b, h) ((4 + (b) * 2 + (h)) * HTB)
#define PG8_STAGE(bufoff, gbase, voff) do { _Pragma("unroll") for (int _i = 0; _i < 2; ++_i) \
        __builtin_amdgcn_global_load_lds((const unsigned*)((const char*)(gbase) + (voff)[_i]), (LAS unsigned*)(lds + (bufoff) + ldsw + _i * 8192), 16, 0, 0); } while (0)
#define PG8_LDA(dst, b, h) do { _Pragma("unroll") for (int m = 0; m < 4; ++m) _Pragma("unroll") for (int k = 0; k < 2; ++k) dst[m][k] = *(const LAS bf16x8*)(lds + PG8_SA(b, h) + aoff + m * 2048 + k * 1024); } while (0)
#define PG8_LDB(dst, b, h) do { _Pragma("unroll") for (int n = 0; n < 2; ++n) _Pragma("unroll") for (int k = 0; k < 2; ++k) dst[n][k] = *(const LAS bf16x8*)(lds + PG8_SB(b, h) + boff + n * 2048 + k * 1024); } while (0)
#define PG8_MMA(ai, bj, At, Bt) do { if (probe & 1) break; __builtin_amdgcn_s_setprio(1); _Pragma("unroll") for (int m = 0; m < 4; ++m) _Pragma("unroll") for (int n = 0; n < 2; ++n) { \
        if constexpr (Epi::F8) { \
            const i32x8 wa_ = __builtin_shufflevector(__builtin_bit_cast(i32x4, Bt[n][0]), __builtin_bit_cast(i32x4, Bt[n][1]), 0, 1, 2, 3, 4, 5, 6, 7); \
            const i32x8 xa_ = __builtin_shufflevector(__builtin_bit_cast(i32x4, At[m][0]), __builtin_bit_cast(i32x4, At[m][1]), 0, 1, 2, 3, 4, 5, 6, 7); \
            asm volatile("v_mfma_scale_f32_16x16x128_f8f6f4 %0, %1, %2, %0, %3, %4 op_sel_hi:[0,0,0]" : "+v"(acc[ai][bj][m][n]) : "v"(wa_), "v"(xa_), "v"(scw_), "v"(scx_)); \
        } else { _Pragma("unroll") for (int k = 0; k < 2; ++k) acc[ai][bj][m][n] = __builtin_amdgcn_mfma_f32_16x16x32_bf16(Bt[n][k], At[m][k], acc[ai][bj][m][n], 0, 0, 0); } } \
        __builtin_amdgcn_s_setprio(0); } while (0)
#define PG8_WAIT_V(n) asm volatile("s_waitcnt vmcnt(" #n ")" ::: "memory")
#define PG8_WAIT_L(n) asm volatile("s_waitcnt lgkmcnt(" #n ")" ::: "memory")
#define PG8_BAR __builtin_amdgcn_s_barrier()
#define PG8_SCHED __builtin_amdgcn_sched_barrier(0)
    Unit cur, nxt; int ui = 0;
    if (!S.next(0, cur)) return;
    f32x4 acc[2][2][4][2];
#pragma unroll
    for (int a = 0; a < 2; ++a)
#pragma unroll
        for (int b = 0; b < 2; ++b)
#pragma unroll
            for (int m = 0; m < 4; ++m)
#pragma unroll
                for (int n = 0; n < 2; ++n) acc[a][b][m][n] = (f32x4){0.f, 0.f, 0.f, 0.f};
    bf16x8 At[4][2], B0[2][2], B1[2][2];
    int scw_ = Epi::SC_W, scx_ = Epi::SC_X; asm volatile("" : "+v"(scw_), "+v"(scx_));
    constexpr bool GATHER = Sched::GATHER;
    constexpr size_t ah = GATHER ? 0 : hstep;
    unsigned va[2][2], vn[2][2];
    S.a_voff(cur, va);
#define VA1 (GATHER ? va[1] : va[0])
    const char* cA = S.a_base(cur); const char* cB = S.b_base(cur);
    if constexpr (SP2) {
        PG8_STAGE(PG8_SB(0, 0), cB, voffB); PG8_STAGE(PG8_SB(0, 1), cB + bstep, voffB); PG8_STAGE(PG8_SA(0, 0), cA, va[0]); PG8_STAGE(PG8_SA(0, 1), cA + ah, VA1);
        if (wr == 1) PG8_BAR;
        PG8_WAIT_V(2); PG8_BAR;
        PG8_STAGE(PG8_SB(1, 0), cB + kstep, voffB); PG8_STAGE(PG8_SA(1, 0), cA + kstep, va[0]); PG8_STAGE(PG8_SB(1, 1), cB + bstep + kstep, voffB);
        PG8_WAIT_V(6); PG8_BAR;
    } else {
        PG8_STAGE(PG8_SB(0, 0), cB, voffB); PG8_STAGE(PG8_SA(0, 0), cA, va[0]); PG8_STAGE(PG8_SB(0, 1), cB + bstep, voffB); PG8_STAGE(PG8_SA(0, 1), cA + ah, VA1);
        if (wr == 1) PG8_BAR;
        PG8_WAIT_V(4); PG8_BAR;
        PG8_STAGE(PG8_SB(1, 0), cB + kstep, voffB); PG8_STAGE(PG8_SA(1, 0), cA + kstep, va[0]); PG8_STAGE(PG8_SB(1, 1), cB + bstep + kstep, voffB);
        PG8_WAIT_V(6); PG8_BAR;
    }
    for (;;) {
        const bool has_next = S.next(ui + 1, nxt);
        const char* nA = has_next ? S.a_base(nxt) : cA; const char* nB = has_next ? S.b_base(nxt) : cB;
        const bool full = cur.nv > 128;
        if constexpr (GATHER) { if (has_next) S.a_voff(nxt, vn); else { vn[0][0] = va[0][0]; vn[0][1] = va[0][1]; vn[1][0] = va[1][0]; vn[1][1] = va[1][1]; } }
#pragma unroll 1
        for (int t = 0; t < nt; t += 2) {
            const bool last = (t == nt - 2);
            const char* a1 = cA + (size_t)(t + 1) * kstep;
            const char* a2 = last ? nA : cA + (size_t)(t + 2) * kstep; const char* b2 = last ? nB : cB + (size_t)(t + 2) * kstep;
            const char* a3 = a2 + kstep; const char* b3 = b2 + kstep;
            unsigned v2[2][2];
            if constexpr (GATHER) { v2[0][0] = last ? vn[0][0] : va[0][0]; v2[0][1] = last ? vn[0][1] : va[0][1]; v2[1][0] = last ? vn[1][0] : va[1][0]; v2[1][1] = last ? vn[1][1] : va[1][1]; }
            else { v2[0][0] = va[0][0]; v2[0][1] = va[0][1]; v2[1][0] = va[0][0]; v2[1][1] = va[0][1]; }
            if constexpr (SP2) {
            PG8_LDB(B0, 0, 0); PG8_LDB(B1, 0, 1); PG8_SCHED; PG8_LDA(At, 0, 0); PG8_STAGE(PG8_SA(1, 1), a1 + ah, VA1);
            PG8_WAIT_V(8); PG8_WAIT_L(0); PG8_BAR; PG8_MMA(0, 0, At, B0); PG8_MMA(0, 1, At, B1); PG8_BAR; PG8_SCHED;
            PG8_LDA(At, 0, 1); PG8_STAGE(PG8_SB(0, 0), b2, voffB); PG8_STAGE(PG8_SB(0, 1), b2 + bstep, voffB); PG8_STAGE(PG8_SA(0, 0), a2, v2[0]);
            PG8_WAIT_V(8); PG8_WAIT_L(0); PG8_BAR; if (full) { PG8_MMA(1, 0, At, B0); PG8_MMA(1, 1, At, B1); } PG8_BAR; PG8_SCHED;
            PG8_LDB(B0, 1, 0); PG8_LDB(B1, 1, 1); PG8_SCHED; PG8_LDA(At, 1, 0); PG8_STAGE(PG8_SA(0, 1), a2 + ah, v2[1]);
            PG8_WAIT_V(8); PG8_WAIT_L(0); PG8_BAR; PG8_MMA(0, 0, At, B0); PG8_MMA(0, 1, At, B1); PG8_BAR; PG8_SCHED;
            PG8_LDA(At, 1, 1); PG8_STAGE(PG8_SB(1, 0), b3, voffB); PG8_STAGE(PG8_SB(1, 1), b3 + bstep, voffB); PG8_STAGE(PG8_SA(1, 0), a3, v2[0]);
            PG8_WAIT_V(8); PG8_WAIT_L(0); PG8_BAR; if (full) { PG8_MMA(1, 0, At, B0); PG8_MMA(1, 1, At, B1); } PG8_BAR; PG8_SCHED;
            } else {
            PG8_LDB(B0, 0, 0); PG8_SCHED; PG8_LDA(At, 0, 0); PG8_STAGE(PG8_SA(1, 1), a1 + ah, VA1);
            PG8_WAIT_L(8); PG8_BAR; PG8_WAIT_L(0); PG8_MMA(0, 0, At, B0); PG8_BAR; PG8_SCHED;
            PG8_LDB(B1, 0, 1); PG8_STAGE(PG8_SB(0, 0), b2, voffB);
            PG8_BAR; PG8_WAIT_L(0); PG8_MMA(0, 1, At, B1); PG8_BAR;
            PG8_LDA(At, 0, 1); PG8_STAGE(PG8_SA(0, 0), a2, v2[0]);
            PG8_BAR; PG8_WAIT_L(0); PG8_MMA(1, 0, At, B0); PG8_BAR; PG8_SCHED;
            PG8_STAGE(PG8_SB(0, 1), b2 + bstep, voffB);
            PG8_WAIT_V(6); PG8_BAR; PG8_MMA(1, 1, At, B1); PG8_BAR;
            PG8_LDB(B0, 1, 0); PG8_SCHED; PG8_LDA(At, 1, 0); PG8_STAGE(PG8_SA(0, 1), a2 + ah, v2[1]);
            PG8_WAIT_L(8); PG8_BAR; PG8_WAIT_L(0); PG8_MMA(0, 0, At, B0); PG8_BAR; PG8_SCHED;
            PG8_LDB(B1, 1, 1); PG8_STAGE(PG8_SB(1, 0), b3, voffB);
            PG8_BAR; PG8_WAIT_L(0); PG8_MMA(0, 1, At, B1); PG8_BAR;
            PG8_LDA(At, 1, 1); PG8_STAGE(PG8_SA(1, 0), a3, v2[0]);
            PG8_BAR; PG8_WAIT_L(0); PG8_MMA(1, 0, At, B0); PG8_BAR; PG8_SCHED;
            PG8_STAGE(PG8_SB(1, 1), b3 + bstep, voffB);
            PG8_WAIT_V(6); PG8_BAR; PG8_MMA(1, 1, At, B1); PG8_BAR;
            }
        }
        if constexpr (ALIGN_EPI) { if (wr == 0) PG8_BAR; }
        if constexpr (Epi::F8) asm volatile("s_nop 15\n\ts_nop 15" ::: "memory");
        if (!(probe & 2)) E(acc, cur, wr, wc, fr, fq);
        if (!has_next) break;
#pragma unroll
        for (int a = 0; a < 2; ++a)
#pragma unroll
            for (int b = 0; b < 2; ++b)
#pragma unroll
                for (int m = 0; m < 4; ++m)
#pragma unroll
                    for (int n = 0; n < 2; ++n) acc[a][b][m][n] = (f32x4){0.f, 0.f, 0.f, 0.f};
        cur = nxt; cA = nA; cB = nB; ++ui;
        if constexpr (GATHER) { va[0][0] = vn[0][0]; va[0][1] = vn[0][1]; va[1][0] = vn[1][0]; va[1][1] = vn[1][1]; }
        if constexpr (ALIGN_EPI) { if (wr == 1) PG8_BAR; }
    }
    PG8_WAIT_V(0);
    if constexpr (!ALIGN_EPI) { if (wr == 0) PG8_BAR; }
    PG8_BAR;
#undef VA1
#undef PG8_SA
#undef PG8_SB
#undef PG8_STAGE
#undef PG8_LDA
#undef PG8_LDB
#undef PG8_MMA
#undef PG8_WAIT_V
#undef PG8_WAIT_L
#undef PG8_BAR
#undef PG8_SCHED
}

template <int K> struct DenseSched {
    static constexpr bool GATHER = false;
    const char* A; const char* Bt; int nM, nN, nwg, G, c, tid;
    __device__ __forceinline__ void init(const void* A_, const void* Bt_, int M, int N, int G_, int c_, int tid_) { tid = tid_; A = (const char*)A_; Bt = (const char*)Bt_; nM = M / BM; nN = N / BM; nwg = nM * nN; G = G_; c = c_; }
    __device__ __forceinline__ bool next(int i, Unit& u) const {
        const long L = (long)i * G + c; if (L >= nwg) return false;
        int wgid = (int)L; { const int q = nwg / 8, r = nwg % 8, xcd = wgid % 8, off = wgid / 8; wgid = (xcd < r ? xcd * (q + 1) : r * (q + 1) + (xcd - r) * q) + off; }
        const int nig = 8 * nN, gid = wgid / nig, fm = gid * 8, gsz = (nM - fm) < 8 ? (nM - fm) : 8;
        u.t = fm + ((wgid % nig) % gsz); u.nt = (wgid % nig) / gsz; u.row0 = 0; u.nv = 256; u.e = 0; return true;
    }
    __device__ __forceinline__ const char* a_base(const Unit& u) const { return A + (size_t)u.t * (BM * K * 2); }
    __device__ __forceinline__ const char* b_base(const Unit& u) const { return Bt + (size_t)u.nt * (BM * K * 2); }
    __device__ __forceinline__ void a_voff(const Unit&, unsigned (&v)[2][2]) const {
#pragma unroll
        for (int i = 0; i < 2; ++i) { int R, C; stage_rc(tid * 16 + i * 8192, R, C); v[0][i] = (unsigned)(R * K + C) * 2u; v[1][i] = v[0][i] + (unsigned)(HALF * K * 2); }
    }
};
}
using pg8::Unit;

struct TileTabs { const int* te; const int* trow0; const int* tnv; int ntiles; };
constexpr int UT_OFF = pg8::STAGE_BYTES;
constexpr int UT_INFO = UT_OFF + 16, UT_TOK = UT_INFO + 64 * 16, UT_MAXU = 20;
static_assert(UT_TOK + UT_MAXU * 1024 <= MISC_OFF, "unit tables fit under the LDS control words");
template <int NTN, bool G1>
struct ExpertSched {
    static constexpr bool GATHER = G1;
    const char* A; const char* W; LAS unsigned char* lds; int n, tid;
    __device__ __forceinline__ void init(LAS unsigned char* lds_, const void* A_, const void* W_, const int* rowtok, const TileTabs& T, int chunk, int tid_) {
        lds = lds_; tid = tid_; A = (const char*)A_; W = (const char*)W_;
        const int U = T.ntiles * NTN, x8 = blockIdx.x & 7, r8 = blockIdx.x >> 3, G8 = gridDim.x >> 3;
        const int q = (((U + 7) >> 3) + NTN - 1) / NTN * NTN;
        const int lo = x8 * q + r8, hi = (x8 + 1) * q < U ? (x8 + 1) * q : U;
        int cnt = hi > lo ? (hi - lo + G8 - 1) / G8 : 0; cnt = cnt > (G1 ? UT_MAXU : 64) ? (G1 ? UT_MAXU : 64) : cnt;
        n = cnt;
        LAS int* info = (LAS int*)(lds + UT_INFO);
        if (tid < cnt) { const int L = lo + G8 * tid, t = L / NTN; info[tid * 4 + 0] = T.te[t]; info[tid * 4 + 1] = T.trow0[t]; info[tid * 4 + 2] = T.tnv[t]; info[tid * 4 + 3] = L % NTN; }
        __syncthreads();
        if constexpr (G1) {
            LAS int* tok = (LAS int*)(lds + UT_TOK);
            constexpr int TPT = UT_MAXU * 256 / NTHR;
            int tv[TPT];
#pragma unroll
            for (int k = 0; k < TPT; ++k) { const int idx = tid + k * NTHR; tv[k] = chunk * CHT;
                if (idx < cnt * 256) { const int i = idx >> 8, rl = idx & 255; const int e = info[i * 4 + 0], row0 = info[i * 4 + 1], nv = info[i * 4 + 2];
                    if (e == NE) tv[k] = chunk * CHT + (row0 - CH_ROUTED) + rl; else if (rl < nv) tv[k] = rowtok[row0 + rl]; } }
#pragma unroll
            for (int k = 0; k < TPT; ++k) { const int idx = tid + k * NTHR; if (idx < cnt * 256) tok[idx] = tv[k]; }
            __syncthreads();
        }
    }
    __device__ __forceinline__ bool next(int i, Unit& u) const {
        if (i >= n) return false;
        const LAS int* info = (const LAS int*)(lds + UT_INFO);
        u.t = i; u.e = __builtin_amdgcn_readfirstlane(info[i * 4 + 0]); u.row0 = __builtin_amdgcn_readfirstlane(info[i * 4 + 1]);
        u.nv = __builtin_amdgcn_readfirstlane(info[i * 4 + 2]); u.nt = __builtin_amdgcn_readfirstlane(info[i * 4 + 3]); return true; }
    __device__ __forceinline__ const char* a_base(const Unit& u) const { if constexpr (G1) return A; else return A + (size_t)u.row0 * 256; }
    __device__ __forceinline__ const char* b_base(const Unit& u) const {
        if constexpr (G1) return W + ((size_t)u.e * 512 + u.nt * 256) * 1024; else return W + ((size_t)u.e * 1024 + u.nt * 256) * 256; }
    __device__ __forceinline__ void a_voff(const Unit& u, unsigned (&v)[2][2]) const {
        if constexpr (G1) {
            const LAS int* tok = (const LAS int*)(lds + UT_TOK) + u.t * 256;
#pragma unroll
            for (int i = 0; i < 2; ++i) { int R, C; pg8::stage_rc(tid * 16 + i * 8192, R, C);
#pragma unroll
                for (int h = 0; h < 2; ++h) v[h][i] = (unsigned)tok[R + 128 * h] * 1024u + (unsigned)C * 2u; }
        } else {
#pragma unroll
            for (int i = 0; i < 2; ++i) { int R, C; pg8::stage_rc(tid * 16 + i * 8192, R, C); v[0][i] = (unsigned)(R * 128 + C) * 2u; v[1][i] = v[0][i] + (unsigned)(128 * 128 * 2); }
        }
    }
};
typedef ExpertSched<2, true> Gemm1Sched;
typedef ExpertSched<4, false> Gemm2Sched;

template <bool F8_> struct EpiBf16T {
    static constexpr bool F8 = F8_; static constexpr int SC_W = SC_W1, SC_X = SC_N2;
    static constexpr bool COL16 = false;
    bf16_t* O; int ldc;
    __device__ __forceinline__ void operator()(const f32x4 (&acc)[2][2][4][2], const Unit& u, int wr, int wc, int fr, int fq) const {
        const int row0 = u.t * 256 + wr * 64 + fr, col0 = u.nt * 256 + wc * 32 + 8 * fq;
#pragma unroll
        for (int ai = 0; ai < 2; ++ai)
#pragma unroll
            for (int m = 0; m < 4; ++m) { bf16_t* rowp = O + (size_t)(row0 + ai * 128 + m * 16) * ldc + col0;
#pragma unroll
                for (int bj = 0; bj < 2; ++bj) { const f32x4 v0 = acc[ai][bj][m][0], v1 = acc[ai][bj][m][1];
                    u32x4 w; w.x = cvt_pk_bf16(v0[0], v0[1]); w.y = cvt_pk_bf16(v0[2], v0[3]); w.z = cvt_pk_bf16(v1[0], v1[1]); w.w = cvt_pk_bf16(v1[2], v1[3]);
                    *(u32x4*)(rowp + bj * 128) = w; } }
    }
};
struct EpiResH {
    static constexpr bool F8 = true; static constexpr int SC_W = SC_W1, SC_X = SC_N2;
    static constexpr bool COL16 = false;
    const float* x; const float* gate; float* out; unsigned char* ws;
    __device__ __forceinline__ void operator()(const f32x4 (&acc)[2][2][4][2], const Unit& u, int wr, int wc, int fr, int fq) const {
        const int row0 = u.t * 256 + wr * 64 + fr, col0 = u.nt * 256 + wc * 32 + 8 * fq;
        const int b = (u.t * 256) / SEQ;
        f32x4 g[2][2];
#pragma unroll
        for (int bj = 0; bj < 2; ++bj)
#pragma unroll
            for (int n = 0; n < 2; ++n) g[bj][n] = *(const f32x4*)(gate + (size_t)b * 6144 + col0 + bj * 128 + 4 * n);
        bf16_t* hb = h_row(out, ws, u.t * 256) + (size_t)(wr * 64 + fr) * D + col0;
#pragma unroll
        for (int ai = 0; ai < 2; ++ai)
#pragma unroll
            for (int mh = 0; mh < 2; ++mh) {
                f32x4 xv[2][2][2];
#pragma unroll
                for (int m2 = 0; m2 < 2; ++m2) { const size_t off = (size_t)(row0 + ai * 128 + (2 * mh + m2) * 16) * D + col0;
#pragma unroll
                    for (int bj = 0; bj < 2; ++bj) { xv[m2][bj][0] = *(const f32x4*)(x + off + bj * 128); xv[m2][bj][1] = *(const f32x4*)(x + off + bj * 128 + 4); } }
#pragma unroll
                for (int m2 = 0; m2 < 2; ++m2) { const int m = 2 * mh + m2;
#pragma unroll
                    for (int bj = 0; bj < 2; ++bj) {
                        const f32x4 h0 = xv[m2][bj][0] + g[bj][0] * acc[ai][bj][m][0], h1 = xv[m2][bj][1] + g[bj][1] * acc[ai][bj][m][1];
                        u32x4 w; w.x = cvt_pk_bf16(h0[0], h0[1]); w.y = cvt_pk_bf16(h0[2], h0[3]); w.z = cvt_pk_bf16(h1[0], h1[1]); w.w = cvt_pk_bf16(h1[2], h1[3]);
                        *(u32x4*)(hb + (size_t)(ai * 128 + m * 16) * D + bj * 128) = w; } } }
    }
};
struct EpiF32 {
    static constexpr bool F8 = false; static constexpr int SC_W = 0, SC_X = 0;
    static constexpr bool COL16 = false;
    float* O; int ldc;
    __device__ __forceinline__ void operator()(const f32x4 (&acc)[2][2][4][2], const Unit& u, int wr, int wc, int fr, int fq) const {
        const int row0 = u.t * 256 + wr * 64 + fr, col0 = u.nt * 256 + wc * 32 + 8 * fq;
#pragma unroll
        for (int ai = 0; ai < 2; ++ai)
#pragma unroll
            for (int m = 0; m < 4; ++m) { float* rowp = O + (size_t)(row0 + ai * 128 + m * 16) * ldc + col0;
#pragma unroll
                for (int bj = 0; bj < 2; ++bj)
#pragma unroll
                    for (int n = 0; n < 2; ++n) *(f32x4*)(rowp + bj * 128 + 4 * n) = acc[ai][bj][m][n]; }
    }
};
struct EpiAct {
    static constexpr bool F8 = true; static constexpr int SC_W = SC_W1, SC_X = SC_N2;
    static constexpr bool COL16 = false;
    unsigned char* act;
    __device__ __forceinline__ void operator()(const f32x4 (&acc)[2][2][4][2], const Unit& u, int wr, int wc, int fr, int fq) const {
        const int col0 = u.nt * 128 + wc * 32 + 8 * fq;
#pragma unroll
        for (int ai = 0; ai < 2; ++ai)
#pragma unroll
            for (int m = 0; m < 4; ++m) { const int rl = ai * 128 + wr * 64 + m * 16 + fr;
                f32x4 ov[2];
#pragma unroll
                for (int n = 0; n < 2; ++n) { const f32x4 g = acc[ai][0][m][n], gu = g * acc[ai][1][m][n];
                    f32x4 d; d.x = fast_exp2(g.x); d.y = fast_exp2(g.y); d.z = fast_exp2(g.z); d.w = fast_exp2(g.w);
                    d = d + 1.f;
                    f32x4 r; r.x = fast_rcp(d.x); r.y = fast_rcp(d.y); r.z = fast_rcp(d.z); r.w = fast_rcp(d.w);
                    ov[n] = gu * r; }
                ov[0] = ov[0] * ACT_PRE; ov[1] = ov[1] * ACT_PRE;
                int w0 = __builtin_amdgcn_cvt_pk_fp8_f32(ov[0].x, ov[0].y, 0, false); w0 = __builtin_amdgcn_cvt_pk_fp8_f32(ov[0].z, ov[0].w, w0, true);
                int w1 = __builtin_amdgcn_cvt_pk_fp8_f32(ov[1].x, ov[1].y, 0, false); w1 = __builtin_amdgcn_cvt_pk_fp8_f32(ov[1].z, ov[1].w, w1, true);
                u32x2 w; w.x = (unsigned)w0; w.y = (unsigned)w1;
                if (rl < u.nv) *(u32x2*)(act + (size_t)(u.row0 + rl) * EDIM + col0) = w; }
    }
};
struct EpiDown {
    static constexpr bool F8 = true; static constexpr int SC_W = SC_W2, SC_X = SC_ACT;
    static constexpr bool COL16 = true;
    unsigned char* Y; LAS unsigned char* lds; int nost;
    __device__ __forceinline__ u32x4 pack(const f32x4 (&acc)[2][2][4][2], int ai, int m) const {
        u32x4 w;
#pragma unroll
        for (int bj = 0; bj < 2; ++bj) {
            f32x4 v0 = acc[ai][bj][m][0], v1 = acc[ai][bj][m][1];
#pragma unroll
            for (int j = 0; j < 4; ++j) { v0[j] = fminf(fmaxf(v0[j], -448.f), 448.f); v1[j] = fminf(fmaxf(v1[j], -448.f), 448.f); }
            int w0 = __builtin_amdgcn_cvt_pk_fp8_f32(v0[0], v0[1], 0, false); w0 = __builtin_amdgcn_cvt_pk_fp8_f32(v0[2], v0[3], w0, true);
            int w1 = __builtin_amdgcn_cvt_pk_fp8_f32(v1[0], v1[1], 0, false); w1 = __builtin_amdgcn_cvt_pk_fp8_f32(v1[2], v1[3], w1, true);
            if (bj == 0) { w.x = (unsigned)w0; w.y = (unsigned)w1; } else { w.z = (unsigned)w0; w.w = (unsigned)w1; } }
        return w;
    }
    __device__ __forceinline__ void operator()(const f32x4 (&acc)[2][2][4][2], const Unit& u, int wr, int wc, int fr, int fq) const {
        const int lane = fq * 16 + fr, wv = wr * 4 + wc;
        constexpr int B0 = 3 * pg8::HTB, B1 = UT_TOK;
        const int wofs = (32 * wr + fr) * 256 + (((4 * wc + fq) ^ fr) << 4);
        const int rr0 = 8 * wv + (lane >> 4);
        const int rofs = rr0 * 256 + (((lane & 15) ^ (rr0 & 15)) << 4), rofs4 = (rr0 + 4) * 256 + (((lane & 15) ^ ((rr0 + 4) & 15)) << 4);
        const int t0 = 64 * (rr0 >> 5) + 16 * ((rr0 >> 4) & 1) + (rr0 & 15);
        unsigned char* yp = Y + (size_t)u.row0 * D + u.nt * 256 + 16 * (lane & 15);
        { const u32x4 wa = pack(acc, 0, 0), wb = pack(acc, 0, 1); *(LAS u32x4*)(lds + B0 + wofs) = wa; *(LAS u32x4*)(lds + B0 + wofs + 16 * 256) = wb; }
#pragma unroll
        for (int sl = 0; sl < 4; ++sl) { const int ai = sl >> 1, mh = sl & 1;
            asm volatile("s_waitcnt lgkmcnt(0)" ::: "memory"); __builtin_amdgcn_s_barrier();
            const int rb = (sl & 1) ? B1 : B0, wb_ = (sl & 1) ? B0 : B1;
            const u32x4 v0 = *(const LAS u32x4*)(lds + rb + rofs), v1 = *(const LAS u32x4*)(lds + rb + rofs4);
            if (sl < 3) { const int a2 = (sl + 1) >> 1, m2 = ((sl + 1) & 1) * 2;
                const u32x4 wa = pack(acc, a2, m2), wb = pack(acc, a2, m2 + 1); *(LAS u32x4*)(lds + wb_ + wofs) = wa; *(LAS u32x4*)(lds + wb_ + wofs + 16 * 256) = wb; }
            const int rl = ai * 128 + mh * 32 + t0;
            if (!nost) { if (rl < u.nv) __builtin_nontemporal_store(v0, (u32x4*)(yp + (size_t)rl * D)); if (rl + 4 < u.nv) __builtin_nontemporal_store(v1, (u32x4*)(yp + (size_t)(rl + 4) * D)); } }
    }
};

__device__ __forceinline__ void lds_barrier() { asm volatile("s_waitcnt lgkmcnt(0)\n\ts_barrier" ::: "memory"); }

struct Frame {
    LAS unsigned char* lds; int tid, lane, wave, G, vcu;
    const CAS Args* a;
};
__device__ __forceinline__ Frame make_frame(LAS unsigned char* lds) {
    Frame F; F.lds = lds;
    int t = threadIdx.x; asm volatile("" : "+v"(t));
    F.tid = t; F.lane = t & 63; F.wave = __builtin_amdgcn_readfirstlane(t >> 6);
    const CAS Args* a = (const CAS Args*)__builtin_amdgcn_kernarg_segment_ptr(); asm volatile("" : "+s"(a)); F.a = a;
    F.G = gridDim.x; { const int bx = blockIdx.x; F.vcu = (F.G % 8 == 0) ? (bx % 8) * (F.G / 8) + bx / 8 : bx; }
    return F;
}
#define WSP(F, off, T) ((T*)((F).a->ws + (off)))

__device__ __forceinline__ void phase_mod(Frame& F) {
    LAS float* cond = (LAS float*)F.lds;
    LAS float* red = (LAS float*)(F.lds + 65536);
    const float* c = F.a->in[I_C]; const float* wada = F.a->in[I_WADA]; const float* bada = F.a->in[I_BADA];
    float* mod = WSP(F, WS_MOD, float);
    { f32x4 cv[8];
#pragma unroll
      for (int u = 0; u < 8; ++u) cv[u] = *(const f32x4*)(c + 4 * (F.tid + u * NTHR));
#pragma unroll
      for (int u = 0; u < 8; ++u) { f32x4 o; o.x = silu_f(cv[u].x); o.y = silu_f(cv[u].y); o.z = silu_f(cv[u].z); o.w = silu_f(cv[u].w); *(LAS f32x4*)(cond + 4 * (F.tid + u * NTHR)) = o; } }
    __syncthreads();
    const int jj = F.tid & 31, ks = F.tid >> 5;
    for (int cb = blockIdx.x; cb < 256; cb += F.G) {
        const int j0 = cb * 24;
        float acc[16];
#pragma unroll
        for (int b = 0; b < 16; ++b) acc[b] = 0.f;
        if (jj < 24) {
#pragma unroll 1
            for (int k0 = ks * 64; k0 < ks * 64 + 64; k0 += 32) {
                float wv[32];
#pragma unroll
                for (int u = 0; u < 32; ++u) wv[u] = wada[(size_t)(k0 + u) * 6144 + j0 + jj];
#pragma unroll
                for (int u = 0; u < 32; ++u)
#pragma unroll
                    for (int b = 0; b < 16; ++b) acc[b] += cond[b * 1024 + k0 + u] * wv[u];
            }
        }
#pragma unroll
        for (int b = 0; b < 16; ++b) red[(ks * 16 + b) * 32 + jj] = acc[b];
        __syncthreads();
        if (F.tid < 16 * 24) { const int b = F.tid / 24, j = F.tid % 24; float s = 0.f;
            for (int k2 = 0; k2 < 16; ++k2) s += red[(k2 * 16 + b) * 32 + j];
            mod[b * 6144 + j0 + j] = s + bada[j0 + j]; }
        __syncthreads();
    }
    const float* wsp = F.a->in[I_WSP]; bf16_t* o = WSP(F, WS_WSP, bf16_t);
    for (int i = blockIdx.x * NTHR + F.tid; i < 4 * 128 * 128; i += F.G * NTHR) { const int s = i & 127, t = (i >> 7) & 127; o[i] = (bf16_t)(cvt_pk_bf16(s <= t ? wsp[i] : 0.f, 0.f) & 0xffffu); }
}

struct TItem { const float* W; bf16_t* WT; int K, N, gmode, item; float scale; bool f8; };
__device__ __forceinline__ void titem_issue(const TItem& t, int lane, LAS unsigned char* buf) {
    const int nblk = t.N / 32, kb = t.item / nblk, nb = t.item % nblk, k0 = 64 * kb, n0 = 32 * nb;
#pragma unroll
    for (int j = 0; j < 8; ++j) { const float* g = t.W + (size_t)(k0 + 8 * j + (lane >> 3)) * t.N + n0 + 4 * ((lane & 7) ^ j);
        __builtin_amdgcn_global_load_lds((const unsigned*)g, (LAS unsigned*)(buf + j * 1024), 16, 0, 2); }
}
__device__ __forceinline__ void titem_finish(const TItem& t, int lane, const LAS unsigned char* buf) {
    const int nblk = t.N / 32, kb = t.item / nblk, nb = t.item % nblk, k0 = 64 * kb, n0 = 32 * nb;
    const int d0 = t.gmode == 0 ? n0 : ((n0 >> 7) * 256 + (n0 & 127) + (t.gmode == 2 ? 128 : 0));
    const int c = lane & 7;
    const LAS float* sb = (const LAS float*)buf;
    float v[4][8];
    const float wsc = t.scale;
#pragma unroll
    for (int j = 0; j < 4; ++j) { const int n = (lane >> 3) + 8 * j; const LAS float* s = sb + (8 * c) * 32 + 4 * ((n >> 2) ^ c) + (n & 3);
#pragma unroll
        for (int q = 0; q < 8; ++q) v[j][q] = s[32 * q] * wsc; }
    if (t.f8) {
#pragma unroll
        for (int j = 0; j < 4; ++j) { const int n = (lane >> 3) + 8 * j;
            int w0 = __builtin_amdgcn_cvt_pk_fp8_f32(v[j][0], v[j][1], 0, false); w0 = __builtin_amdgcn_cvt_pk_fp8_f32(v[j][2], v[j][3], w0, true);
            int w1 = __builtin_amdgcn_cvt_pk_fp8_f32(v[j][4], v[j][5], 0, false); w1 = __builtin_amdgcn_cvt_pk_fp8_f32(v[j][6], v[j][7], w1, true);
            u32x2 o; o.x = (unsigned)w0; o.y = (unsigned)w1;
            __builtin_nontemporal_store(o, (u32x2*)((unsigned char*)t.WT + (size_t)(d0 + n) * t.K + k0 + 8 * c)); }
    } else {
#pragma unroll
        for (int j = 0; j < 4; ++j) { const int n = (lane >> 3) + 8 * j;
            u32x4 o; o.x = cvt_pk_bf16(v[j][0], v[j][1]); o.y = cvt_pk_bf16(v[j][2], v[j][3]); o.z = cvt_pk_bf16(v[j][4], v[j][5]); o.w = cvt_pk_bf16(v[j][6], v[j][7]);
            __builtin_nontemporal_store(o, (u32x4*)(t.WT + (size_t)(d0 + n) * t.K + k0 + 8 * c)); }
    }
}
typedef float f32x2v __attribute__((ext_vector_type(2)));
template <bool HB>
__device__ __forceinline__ void norm_mod_row2(const void* x0, const void* x1, const float* g, const float* sh0, const float* sc0, const float* sh1, const float* sc1, bf16_t* o0, bf16_t* o1, int lane) {
    f32x4 v0[4], v1[4]; float s0 = 0.f, s1 = 0.f;
#pragma unroll
    for (int j = 0; j < 4; ++j) {
        if (HB) { const u32x2 a = *(const u32x2*)((const bf16_t*)x0 + 4 * lane + 256 * j), b = *(const u32x2*)((const bf16_t*)x1 + 4 * lane + 256 * j);
            v0[j] = (f32x4){bflo(a.x), bfhi(a.x), bflo(a.y), bfhi(a.y)}; v1[j] = (f32x4){bflo(b.x), bfhi(b.x), bflo(b.y), bfhi(b.y)}; }
        else { v0[j] = *(const f32x4*)((const float*)x0 + 4 * lane + 256 * j); v1[j] = *(const f32x4*)((const float*)x1 + 4 * lane + 256 * j); } }
#pragma unroll
    for (int j = 0; j < 4; ++j) { s0 += (v0[j].x * v0[j].x + v0[j].y * v0[j].y) + (v0[j].z * v0[j].z + v0[j].w * v0[j].w);
                                  s1 += (v1[j].x * v1[j].x + v1[j].y * v1[j].y) + (v1[j].z * v1[j].z + v1[j].w * v1[j].w); }
    s0 = wave_sum(s0); s1 = wave_sum(s1);
    const float r0 = 1.f / sqrtf(s0 * (1.f / D) + EPS), r1 = 1.f / sqrtf(s1 * (1.f / D) + EPS);
#pragma unroll
    for (int j = 0; j < 4; ++j) { const int c0 = 4 * lane + 256 * j;
        const f32x4 gg = *(const f32x4*)(g + c0);
        const f32x4 y0 = v0[j] * r0 * gg * (*(const f32x4*)(sc0 + c0) + 1.f) + *(const f32x4*)(sh0 + c0);
        const f32x4 y1 = v1[j] * r1 * gg * (*(const f32x4*)(sc1 + c0) + 1.f) + *(const f32x4*)(sh1 + c0);
        u32x2 w0, w1; w0.x = cvt_pk_bf16(y0.x, y0.y); w0.y = cvt_pk_bf16(y0.z, y0.w); w1.x = cvt_pk_bf16(y1.x, y1.y); w1.y = cvt_pk_bf16(y1.z, y1.w);
        *(u32x2*)(o0 + c0) = w0; *(u32x2*)(o1 + c0) = w1; }
}
template <int NR, bool HB>
__device__ __forceinline__ void norm_mod_rows(const void* x, size_t xstride, const float* g, const float* sh, const float* sc, bf16_t* o, size_t ostride, int lane, unsigned char* o8 = nullptr) {
    f32x4 v[NR][4]; float ss[NR];
    f32x4 gq[4], sq4[4], hq[4];
#pragma unroll
    for (int j = 0; j < 4; ++j) { const int c0 = 4 * lane + 256 * j; gq[j] = *(const f32x4*)(g + c0); sq4[j] = *(const f32x4*)(sc + c0); hq[j] = *(const f32x4*)(sh + c0); }
    if constexpr (HB) {
        u32x2 raw[NR][4];
#pragma unroll
        for (int r = 0; r < NR; ++r)
#pragma unroll
            for (int j = 0; j < 4; ++j) raw[r][j] = *(const u32x2*)((const bf16_t*)x + r * xstride + 4 * lane + 256 * j);
#pragma unroll
        for (int r = 0; r < NR; ++r)
#pragma unroll
            for (int j = 0; j < 4; ++j) v[r][j] = (f32x4){bflo(raw[r][j].x), bfhi(raw[r][j].x), bflo(raw[r][j].y), bfhi(raw[r][j].y)};
    } else {
#pragma unroll
        for (int r = 0; r < NR; ++r)
#pragma unroll
            for (int j = 0; j < 4; ++j) v[r][j] = *(const f32x4*)((const float*)x + r * xstride + 4 * lane + 256 * j);
    }
#pragma unroll
    for (int r = 0; r < NR; ++r) { float s0 = 0.f;
#pragma unroll
        for (int j = 0; j < 4; ++j) s0 += (v[r][j].x * v[r][j].x + v[r][j].y * v[r][j].y) + (v[r][j].z * v[r][j].z + v[r][j].w * v[r][j].w);
        ss[r] = 1.f / sqrtf(wave_sum(s0) * (1.f / D) + EPS); }
#pragma unroll
    for (int j = 0; j < 4; ++j) { const int c0 = 4 * lane + 256 * j;
        const f32x4 gg = gq[j] * (sq4[j] + 1.f), hh = hq[j];
#pragma unroll
        for (int r = 0; r < NR; ++r) { const f32x4 y = v[r][j] * ss[r] * gg + hh;
            if (o) { u32x2 w; w.x = cvt_pk_bf16(y.x, y.y); w.y = cvt_pk_bf16(y.z, y.w); *(u32x2*)(o + r * ostride + c0) = w; }
            if (o8) { int q = __builtin_amdgcn_cvt_pk_fp8_f32(y.x, y.y, 0, false); q = __builtin_amdgcn_cvt_pk_fp8_f32(y.z, y.w, q, true); *(int*)(o8 + r * ostride + c0) = q; } } }
}
__device__ __forceinline__ void phase_prep(Frame& F) {
    const int gw = F.vcu * 8 + F.wave, NGW = F.G * 8;
    const float* mod = WSP(F, WS_MOD, float); bf16_t* nbuf = WSP(F, WS_A, bf16_t);
    for (int m = gw * 4; m < NTOK; m += 4 * NGW) { const int b = m / SEQ;
        norm_mod_rows<4, false>(F.a->in[I_X] + (size_t)m * D, D, F.a->in[I_GMIX], mod + b * 6144, mod + b * 6144 + 1024, nullptr, D, F.lane, (unsigned char*)nbuf + (size_t)m * D); }
    LAS unsigned char* scr = F.lds + F.wave * 16384;
    constexpr int IT_IN = 16 * 80, IT_OUT = 16 * 32, IT_R = 16 * 8;
    constexpr int NITEMS = IT_IN + IT_OUT + IT_R;
    for (int it = gw; it < NITEMS; it += NGW) {
        int r = it; TItem t;
        if (r < IT_IN) t = TItem{F.a->in[I_WIN], WSP(F, WS_WTIN, bf16_t), 1024, 2560, 0, r, W1_PRE, true};
        else if (r < IT_IN + IT_OUT) t = TItem{F.a->in[I_WOUT], WSP(F, WS_WTOUT, bf16_t), 1024, 1024, 0, r - IT_IN, W1_PRE, true};
        else t = TItem{F.a->in[I_WR], WSP(F, WS_WTR, bf16_t), 1024, 256, 0, r - IT_IN - IT_OUT, 1.f, false};
        titem_issue(t, F.lane, scr); asm volatile("s_waitcnt vmcnt(0)" ::: "memory"); titem_finish(t, F.lane, scr); asm volatile("s_waitcnt lgkmcnt(0)" ::: "memory");
    }
}
constexpr int CONV_ITEMS = 257 * 3 * 128;
__device__ __forceinline__ void convert_experts(Frame& F, int lo, int hi) {
    const int gw = F.vcu * 8 + F.wave, NGW = F.G * 8;
    LAS unsigned char* scr = F.lds + F.wave * 16384;
    unsigned char* W1t = WSP(F, WS_W1T, unsigned char); unsigned char* W2t = WSP(F, WS_W2T, unsigned char);
    const float* weg = F.a->in[I_WEG]; const float* weu = F.a->in[I_WEU]; const float* wed = F.a->in[I_WED];
    const float* wsg = F.a->in[I_WSG]; const float* wsu = F.a->in[I_WSU]; const float* wsd = F.a->in[I_WSD];
#define CONV_DESC(r, t) do { const int e_ = (r) / 384, w_ = ((r) >> 7) % 3; (t).item = (r) & 127; (t).f8 = true; (t).scale = w_ == 2 ? YSCALE * W2_PRE : (w_ == 0 ? -LOG2E * W1_PRE : -W1_PRE / LOG2E); (t).gmode = w_ == 2 ? 0 : w_ + 1; (t).K = w_ == 2 ? 256 : 1024; (t).N = w_ == 2 ? 1024 : 256; \
        (t).W = w_ == 0 ? (e_ < NE ? weg + (size_t)e_ * 262144 : wsg) : w_ == 1 ? (e_ < NE ? weu + (size_t)e_ * 262144 : wsu) : (e_ < NE ? wed + (size_t)e_ * 262144 : wsd); \
        (t).WT = (bf16_t*)(w_ == 2 ? W2t + (size_t)e_ * 262144 : W1t + (size_t)e_ * 524288); } while (0)
    constexpr int NPAIRS = CONV_ITEMS / 2;
    (void)lo; (void)hi;
#define CONV_RIDX(s_) ({ const int P_ = gw + ((s_) >> 1) * NGW, mi_ = P_ >> 6, pp_ = P_ & 63, nb_ = (mi_ % 3) == 2 ? 32 : 8; mi_ * 128 + (2 * (pp_ / nb_) + ((s_) & 1)) * nb_ + (pp_ % nb_); })
    if (gw < NPAIRS) {
        const int ns = 2 * ((NPAIRS - gw + NGW - 1) / NGW);
        int sq = 0, r = CONV_RIDX(0);
        TItem tc, tn; CONV_DESC(r, tc); tn = tc;
        int p = 0; bool first = true;
        titem_issue(tc, F.lane, scr);
        for (;;) {
            const bool more = sq + 1 < ns; const int rn = more ? CONV_RIDX(sq + 1) : r;
            if (more) { CONV_DESC(rn, tn); titem_issue(tn, F.lane, scr + (p ^ 1) * 8192); }
            if (!more) asm volatile("s_waitcnt vmcnt(0)" ::: "memory");
            else if (first) asm volatile("s_waitcnt vmcnt(8)" ::: "memory");
            else asm volatile("s_waitcnt vmcnt(12)" ::: "memory");
            titem_finish(tc, F.lane, scr + p * 8192);
            asm volatile("s_waitcnt lgkmcnt(0)" ::: "memory");
            if (!more) break;
            tc = tn; r = rn; ++sq; p ^= 1; first = false;
        }
    }
#undef CONV_RIDX
#undef CONV_DESC
    __syncthreads();
}

__device__ __forceinline__ s16x4 tr_read(LAS unsigned char* p) { return __builtin_bit_cast(s16x4, __builtin_amdgcn_ds_read_tr16_b64_v4i16((LAS s16x4*)p)); }
constexpr int ATT_ROWB = 144;
constexpr int ATT_VOFF = 256 * ATT_ROWB;
struct AttnUnit { int b, h, d, dsel, r, n; };
__device__ __forceinline__ AttnUnit attn_decode(int j) {
    AttnUnit u; const int bh = j / 96, rest = j % 96; u.b = bh >> 3; u.h = bh & 7;
    u.dsel = (rest >= 32 ? 1 : 0) + (rest >= 64 ? 1 : 0);
    const int x = rest - 32 * u.dsel, sh = 5 - 2 * u.dsel;
    u.d = 1 << (2 * u.dsel); u.r = x >> sh; u.n = x & ((1 << sh) - 1);
    return u;
}
__device__ __forceinline__ void attn_issue(const bf16_t* qkv, const AttnUnit& u, int tid, u32x4 (&kr)[4], u32x4 (&vr)[4]) {
#pragma unroll
    for (int jj = 0; jj < 4; ++jj) { const int ch = tid + 512 * jj, row = ch >> 3, c16 = ch & 7;
        int i = 128 * (u.n - 1) + row; i = i < 0 ? 0 : i;
        const size_t tok = (size_t)u.b * SEQ + (size_t)i * u.d + u.r;
        const bf16_t* p = qkv + tok * NPROJ + 512 + u.h * 64 + c16 * 8;
        kr[jj] = *(const u32x4*)p; vr[jj] = *(const u32x4*)(p + 512); }
}
__device__ __forceinline__ void phase_attn(Frame& F) {
    const bf16_t* qkv = WSP(F, WS_B, bf16_t);
    bf16_t* part = (bf16_t*)F.a->out;
    float* lse = WSP(F, WS_LSE, float);
    const int tid = F.tid, w = F.wave, lane = F.lane, fr = lane & 15, fq = lane >> 4;
    const int x8 = blockIdx.x & 7, r8 = blockIdx.x >> 3, G8 = F.G >> 3;
    constexpr int PER_X = 16 * 96;
    constexpr int ABUF = 2 * ATT_VOFF;
    float ef[4];
#pragma unroll
    for (int rg = 0; rg < 4; ++rg) ef[rg] = (float)(fr - 4 * fq - rg);
    u32x4 kr[4], vr[4];
    AttnUnit un;
    bf16x8 qn0, qn1;
    int jl = r8;
    if (jl >= PER_X) return;
    AttnUnit cu = attn_decode(x8 * PER_X + jl);
    attn_issue(qkv, cu, tid, kr, vr);
    { const size_t tq = (size_t)cu.b * SEQ + (size_t)(128 * cu.n + 16 * w + fr) * cu.d + cu.r; const bf16_t* qp = qkv + tq * NPROJ + cu.h * 64 + 8 * fq; qn0 = *(const bf16x8*)qp; qn1 = *(const bf16x8*)(qp + 32); }
#pragma unroll
    for (int jj = 0; jj < 4; ++jj) { const int ch = tid + 512 * jj, row = ch >> 3, c16 = ch & 7;
        *(LAS u32x4*)(F.lds + row * ATT_ROWB + c16 * 16) = kr[jj]; *(LAS u32x4*)(F.lds + ATT_VOFF + row * ATT_ROWB + c16 * 16) = vr[jj]; }
    const int jlast = r8 + G8 * ((PER_X - 1 - r8) / G8);
    un = attn_decode(x8 * PER_X + (jl + G8 < jlast ? jl + G8 : jlast)); attn_issue(qkv, un, tid, kr, vr);
    int buf = 0;
    for (; jl < PER_X; jl += G8) {
        lds_barrier();
        LAS unsigned char* kb = F.lds + buf * ABUF;
        const bf16x8 q0 = qn0, q1 = qn1;
        {
            LAS unsigned char* ob = F.lds + (buf ^ 1) * ABUF;
#pragma unroll
            for (int jj = 0; jj < 4; ++jj) { const int ch = tid + 512 * jj, row = ch >> 3, c16 = ch & 7;
                *(LAS u32x4*)(ob + row * ATT_ROWB + c16 * 16) = kr[jj]; *(LAS u32x4*)(ob + ATT_VOFF + row * ATT_ROWB + c16 * 16) = vr[jj]; }
        }
        const AttnUnit nu = un;
        un = attn_decode(x8 * PER_X + (jl + 2 * G8 < jlast ? jl + 2 * G8 : jlast)); attn_issue(qkv, un, tid, kr, vr);
        { const size_t tq = (size_t)nu.b * SEQ + (size_t)(128 * nu.n + 16 * w + fr) * nu.d + nu.r; const bf16_t* qp = qkv + tq * NPROJ + nu.h * 64 + 8 * fq; qn0 = *(const bf16x8*)qp; qn1 = *(const bf16x8*)(qp + 32); }
        const size_t tokq = (size_t)cu.b * SEQ + (size_t)(128 * cu.n + 16 * w + fr) * cu.d + cu.r;
        const float c1 = 0.125f * LOG2E;
        const float nc2 = -__builtin_amdgcn_exp2f(-(float)(cu.h + 1)) * (float)cu.d * LOG2E;
        const bool first = cu.n == 0;
        f32x4 St[9];
        float mx = -INFINITY;
        bf16x8 kf[9][2];
#pragma unroll
        for (int T = 0; T < 9; ++T) { LAS unsigned char* ka = kb + (16 * (w + T) + fr) * ATT_ROWB + fq * 16; kf[T][0] = *(LAS bf16x8*)ka; kf[T][1] = *(LAS bf16x8*)(ka + 64); }
        __builtin_amdgcn_sched_barrier(0);
#pragma unroll
        for (int T = 0; T < 9; ++T) {
            f32x4 sa = (f32x4){0.f, 0.f, 0.f, 0.f};
            sa = __builtin_amdgcn_mfma_f32_16x16x32_bf16(kf[T][0], q0, sa, 0, 0, 0);
            sa = __builtin_amdgcn_mfma_f32_16x16x32_bf16(kf[T][1], q1, sa, 0, 0, 0);
            const float kT = (!first || w + T >= 8) ? nc2 * (float)(128 - 16 * T) : -INFINITY;
#pragma unroll
            for (int rg = 0; rg < 4; ++rg) {
                float s2 = __builtin_fmaf(ef[rg], nc2, __builtin_fmaf(sa[rg], c1, kT));
                if (T == 0) s2 = ef[rg] <= 0.f ? s2 : -INFINITY;
                if (T == 8) s2 = ef[rg] >= 0.f ? s2 : -INFINITY;
                sa[rg] = s2;
            }
            St[T] = sa;
            mx = fmaxf(mx, fmaxf(fmaxf(sa[0], sa[1]), fmaxf(sa[2], sa[3])));
        }
        mx = fmaxf(mx, __shfl_xor(mx, 16)); mx = fmaxf(mx, __shfl_xor(mx, 32));
        float l = 0.f;
#pragma unroll
        for (int T = 0; T < 9; ++T)
#pragma unroll
            for (int rg = 0; rg < 4; ++rg) { const float p = fast_exp2(St[T][rg] - mx); St[T][rg] = p; l += p; }
        l += __shfl_xor(l, 16); l += __shfl_xor(l, 32);
        f32x4 O[4];
#pragma unroll
        for (int dt = 0; dt < 4; ++dt) O[dt] = (f32x4){0.f, 0.f, 0.f, 0.f};
#pragma unroll
        for (int T = 0; T < 9; ++T) {
            u32x2 pw; pw.x = cvt_pk_bf16(St[T][0], St[T][1]); pw.y = cvt_pk_bf16(St[T][2], St[T][3]);
            const s16x4 pb = __builtin_bit_cast(s16x4, pw);
            LAS unsigned char* va = kb + ATT_VOFF + (16 * (w + T) + 4 * fq + (fr >> 2)) * ATT_ROWB + (8 * (fr & 3)) * 2;
#pragma unroll
            for (int dt = 0; dt < 4; ++dt) O[dt] = __builtin_amdgcn_mfma_f32_16x16x16bf16_1k(tr_read(va + 64 * (dt >> 1) + 8 * (dt & 1)), pb, O[dt], 0, 0, 0);
        }
        const float inv = 1.f / l;
        bf16_t* op = part + ((size_t)cu.dsel * NTOK + tokq) * 512 + cu.h * 64 + 8 * fq;
#pragma unroll
        for (int u2 = 0; u2 < 2; ++u2) { u32x4 o4; o4.x = cvt_pk_bf16(O[2 * u2][0] * inv, O[2 * u2][1] * inv); o4.y = cvt_pk_bf16(O[2 * u2][2] * inv, O[2 * u2][3] * inv);
            o4.z = cvt_pk_bf16(O[2 * u2 + 1][0] * inv, O[2 * u2 + 1][1] * inv); o4.w = cvt_pk_bf16(O[2 * u2 + 1][2] * inv, O[2 * u2 + 1][3] * inv); *(u32x4*)(op + 32 * u2) = o4; }
        if (fq == 0) lse[((size_t)cu.dsel * NTOK + tokq) * 8 + cu.h] = mx + __builtin_amdgcn_logf(l);
        cu = nu; buf ^= 1;
    }
    __syncthreads();
}

constexpr int SGU_ROWB = 1040;
__device__ __forceinline__ void phase_sgu(Frame& F) {
    const bf16_t* qkv = WSP(F, WS_B, bf16_t);
    bf16_t* sgu = (bf16_t*)F.a->out + (size_t)3 * NTOK * 512;
    const bf16_t* Wsp = WSP(F, WS_WSP, bf16_t);
    const float* lng = F.a->in[I_LNG]; const float* lnb = F.a->in[I_LNB]; const float* bsp = F.a->in[I_BSP];
    const int w = F.wave, lane = F.lane, fr = lane & 15, fq = lane >> 4;
    for (int un = blockIdx.x; un < NTOK / 128; un += F.G) {
        const size_t tok0 = (size_t)un * 128;
        lds_barrier();
        float g8[8], b8[8];
#pragma unroll
        for (int j = 0; j < 8; ++j) { g8[j] = lng[8 * lane + j]; b8[j] = lnb[8 * lane + j]; }
#pragma unroll 1
        for (int i0 = 0; i0 < 16; i0 += 8) {
        u32x4 zrv[8];
#pragma unroll
        for (int i = 0; i < 8; ++i) zrv[i] = *(const u32x4*)(qkv + (tok0 + 16 * w + i0 + i) * NPROJ + 2048 + 8 * lane);
#pragma unroll
        for (int i = 0; i < 8; ++i) { const int s = 16 * w + i0 + i;
            const u32x4 zr = zrv[i];
            float z[8]; z[0] = bflo(zr.x); z[1] = bfhi(zr.x); z[2] = bflo(zr.y); z[3] = bfhi(zr.y); z[4] = bflo(zr.z); z[5] = bfhi(zr.z); z[6] = bflo(zr.w); z[7] = bfhi(zr.w);
            float sm = 0.f;
#pragma unroll
            for (int j = 0; j < 8; ++j) { z[j] = gelu_f(z[j]); sm += z[j]; }
            const float mean = wave_sum(sm) * (1.f / 512.f); float sq = 0.f;
#pragma unroll
            for (int j = 0; j < 8; ++j) { z[j] -= mean; sq += z[j] * z[j]; }
            const float rstd = 1.f / sqrtf(wave_sum(sq) * (1.f / 512.f) + EPS);
#pragma unroll
            for (int j = 0; j < 8; ++j) z[j] = z[j] * rstd * g8[j] + b8[j];
            u32x4 o; o.x = cvt_pk_bf16(z[0], z[1]); o.y = cvt_pk_bf16(z[2], z[3]); o.z = cvt_pk_bf16(z[4], z[5]); o.w = cvt_pk_bf16(z[6], z[7]);
            *(LAS u32x4*)(F.lds + s * SGU_ROWB + lane * 16) = o; }
        }
        lds_barrier();
        const int cw = 64 * w, g = w >> 1;
        f32x4 acc[4][8];
#pragma unroll
        for (int ct = 0; ct < 4; ++ct)
#pragma unroll
            for (int tt = 0; tt < 8; ++tt) acc[ct][tt] = (f32x4){0.f, 0.f, 0.f, 0.f};
#pragma unroll
        for (int ks = 0; ks < 4; ++ks) {
            bf16x8 af[4];
#pragma unroll
            for (int ct = 0; ct < 4; ++ct) {
                LAS unsigned char* pa = F.lds + (32 * ks + 8 * fq + (fr >> 2)) * SGU_ROWB + (cw + 32 * (ct >> 1) + 8 * (fr & 3) + 4 * (ct & 1)) * 2;
                const s16x4 lo = tr_read(pa), hi = tr_read(pa + 4 * SGU_ROWB);
                af[ct].s0 = lo.x; af[ct].s1 = lo.y; af[ct].s2 = lo.z; af[ct].s3 = lo.w; af[ct].s4 = hi.x; af[ct].s5 = hi.y; af[ct].s6 = hi.z; af[ct].s7 = hi.w;
            }
            bf16x8 bfr[8];
#pragma unroll
            for (int tt = 0; tt < 8; ++tt) if (16 * tt + 15 >= 32 * ks) bfr[tt] = *(const bf16x8*)(Wsp + ((size_t)(g * 128 + 16 * tt + fr) * 128 + 32 * ks + 8 * fq));
#pragma unroll
            for (int tt = 0; tt < 8; ++tt) {
                if (16 * tt + 15 < 32 * ks) continue;
#pragma unroll
                for (int ct = 0; ct < 4; ++ct) acc[ct][tt] = __builtin_amdgcn_mfma_f32_16x16x32_bf16(af[ct], bfr[tt], acc[ct][tt], 0, 0, 0);
            }
        }
        float bsv[8];
#pragma unroll
        for (int tt = 0; tt < 8; ++tt) bsv[tt] = bsp[g * 128 + 16 * tt + fr];
#pragma unroll
        for (int th = 0; th < 2; ++th) {
            u32x4 urv[4][2];
#pragma unroll
            for (int i = 0; i < 4; ++i)
#pragma unroll
                for (int cp = 0; cp < 2; ++cp) urv[i][cp] = *(const u32x4*)(qkv + (tok0 + 16 * (4 * th + i) + fr) * NPROJ + 1536 + cw + 32 * cp + 8 * fq);
#pragma unroll
            for (int i = 0; i < 4; ++i) { const int tt = 4 * th + i, t = 16 * tt + fr; const float bs = bsv[tt];
#pragma unroll
                for (int cp = 0; cp < 2; ++cp) { const int c0 = cw + 32 * cp + 8 * fq;
                    const u32x4 ur = urv[i][cp];
                    u32x4 o;
                    o.x = cvt_pk_bf16(gelu_f(bflo(ur.x)) * (acc[2 * cp][tt][0] + bs), gelu_f(bfhi(ur.x)) * (acc[2 * cp][tt][1] + bs));
                    o.y = cvt_pk_bf16(gelu_f(bflo(ur.y)) * (acc[2 * cp][tt][2] + bs), gelu_f(bfhi(ur.y)) * (acc[2 * cp][tt][3] + bs));
                    o.z = cvt_pk_bf16(gelu_f(bflo(ur.z)) * (acc[2 * cp + 1][tt][0] + bs), gelu_f(bfhi(ur.z)) * (acc[2 * cp + 1][tt][1] + bs));
                    o.w = cvt_pk_bf16(gelu_f(bflo(ur.w)) * (acc[2 * cp + 1][tt][2] + bs), gelu_f(bfhi(ur.w)) * (acc[2 * cp + 1][tt][3] + bs));
                    *(u32x4*)(sgu + (tok0 + t) * 512 + c0) = o; } }
        }
    }
    __syncthreads();
}

__device__ __forceinline__ void phase_merge(Frame& F) {
    const bf16_t* part = (const bf16_t*)F.a->out; const bf16_t* sgu = part + (size_t)3 * NTOK * 512;
    const float* lse = WSP(F, WS_LSE, float); bf16_t* mixed = WSP(F, WS_A, bf16_t);
    const float* goa = F.a->in[I_GOA]; const float* gos = F.a->in[I_GOS];
    const int lane = F.lane, gw = F.vcu * 8 + F.wave, NGW = F.G * 8, h = lane >> 3;
    const f32x4 ga0 = *(const f32x4*)(goa + 8 * lane), ga1 = *(const f32x4*)(goa + 8 * lane + 4), gs0 = *(const f32x4*)(gos + 8 * lane), gs1 = *(const f32x4*)(gos + 8 * lane + 4);
    constexpr int NT = 2;
#pragma unroll 1
    for (int mb = gw; mb < NTOK; mb += NT * NGW) {
        float lv[NT][3]; u32x4 pv[NT][3], sr[NT];
#pragma unroll
        for (int t = 0; t < NT; ++t) { const int m = mb + t * NGW;
#pragma unroll
            for (int k = 0; k < 3; ++k) { lv[t][k] = lse[((size_t)k * NTOK + m) * 8 + h]; pv[t][k] = *(const u32x4*)(part + ((size_t)k * NTOK + m) * 512 + 8 * lane); }
            sr[t] = *(const u32x4*)(sgu + (size_t)m * 512 + 8 * lane); }
        float a[NT][8], sv[NT][8], sqa[NT], sqs[NT];
#pragma unroll
        for (int t = 0; t < NT; ++t) {
            const float mx = fmaxf(lv[t][0], fmaxf(lv[t][1], lv[t][2]));
            float w0 = fast_exp2(lv[t][0] - mx), w1 = fast_exp2(lv[t][1] - mx), w2 = fast_exp2(lv[t][2] - mx);
            const float iw = 1.f / (w0 + w1 + w2); w0 *= iw; w1 *= iw; w2 *= iw;
            sqa[t] = 0.f; sqs[t] = 0.f;
#pragma unroll
            for (int j = 0; j < 4; ++j) { a[t][2 * j] = w0 * bflo(pv[t][0][j]) + w1 * bflo(pv[t][1][j]) + w2 * bflo(pv[t][2][j]); a[t][2 * j + 1] = w0 * bfhi(pv[t][0][j]) + w1 * bfhi(pv[t][1][j]) + w2 * bfhi(pv[t][2][j]);
                sv[t][2 * j] = bflo(sr[t][j]); sv[t][2 * j + 1] = bfhi(sr[t][j]); }
#pragma unroll
            for (int j = 0; j < 8; ++j) { sqa[t] += a[t][j] * a[t][j]; sqs[t] += sv[t][j] * sv[t][j]; }
        }
#pragma unroll
        for (int t = 0; t < NT; ++t) { sqa[t] = wave_sum(sqa[t]); sqs[t] = wave_sum(sqs[t]); }
#pragma unroll
        for (int t = 0; t < NT; ++t) { const int m = mb + t * NGW;
            const float rsa = 1.f / sqrtf(sqa[t] * (1.f / 512.f) + EPS), rss = 1.f / sqrtf(sqs[t] * (1.f / 512.f) + EPS);
            float oa[8], os[8];
            oa[0] = a[t][0] * rsa * ga0.x; oa[1] = a[t][1] * rsa * ga0.y; oa[2] = a[t][2] * rsa * ga0.z; oa[3] = a[t][3] * rsa * ga0.w;
            oa[4] = a[t][4] * rsa * ga1.x; oa[5] = a[t][5] * rsa * ga1.y; oa[6] = a[t][6] * rsa * ga1.z; oa[7] = a[t][7] * rsa * ga1.w;
            os[0] = sv[t][0] * rss * gs0.x; os[1] = sv[t][1] * rss * gs0.y; os[2] = sv[t][2] * rss * gs0.z; os[3] = sv[t][3] * rss * gs0.w;
            os[4] = sv[t][4] * rss * gs1.x; os[5] = sv[t][5] * rss * gs1.y; os[6] = sv[t][6] * rss * gs1.z; os[7] = sv[t][7] * rss * gs1.w;
#pragma unroll
            for (int j = 0; j < 8; ++j) { oa[j] = fminf(fmaxf(oa[j], -448.f), 448.f); os[j] = fminf(fmaxf(os[j], -448.f), 448.f); }
            u32x2 wa, wsg;
            { int w0 = __builtin_amdgcn_cvt_pk_fp8_f32(oa[0], oa[1], 0, false); w0 = __builtin_amdgcn_cvt_pk_fp8_f32(oa[2], oa[3], w0, true);
              int w1 = __builtin_amdgcn_cvt_pk_fp8_f32(oa[4], oa[5], 0, false); w1 = __builtin_amdgcn_cvt_pk_fp8_f32(oa[6], oa[7], w1, true); wa.x = (unsigned)w0; wa.y = (unsigned)w1; }
            { int w0 = __builtin_amdgcn_cvt_pk_fp8_f32(os[0], os[1], 0, false); w0 = __builtin_amdgcn_cvt_pk_fp8_f32(os[2], os[3], w0, true);
              int w1 = __builtin_amdgcn_cvt_pk_fp8_f32(os[4], os[5], 0, false); w1 = __builtin_amdgcn_cvt_pk_fp8_f32(os[6], os[7], w1, true); wsg.x = (unsigned)w0; wsg.y = (unsigned)w1; }
            unsigned char* mrow = (unsigned char*)mixed + (size_t)m * D;
            *(u32x2*)(mrow + 8 * lane) = wa;
            *(u32x2*)(mrow + 512 + 8 * lane) = wsg; }
    }
}

__device__ __forceinline__ float wave_max_bcast(float v) {
    const float ninf = -INFINITY;
    v = fmaxf(v, dpp_f<0x111>(ninf, v)); v = fmaxf(v, dpp_f<0x112>(ninf, v)); v = fmaxf(v, dpp_f<0x114>(ninf, v)); v = fmaxf(v, dpp_f<0x118>(ninf, v));
    v = fmaxf(v, dpp_f<0x142, 0xa>(ninf, v)); v = fmaxf(v, dpp_f<0x143, 0xc>(ninf, v));
    return __builtin_bit_cast(float, __builtin_amdgcn_readlane(__builtin_bit_cast(int, v), 63));
}
__device__ __forceinline__ void router_topk(Frame& F, int tile) {
    const float* logits = WSP(F, WS_B, float); const float* br = F.a->in[I_BR];
    int* tk_e = WSP(F, WS_TOPK_E, int); float* tk_g = WSP(F, WS_TOPK_G, float); int* tk_p = WSP(F, WS_TOPK_P, int);
    int* gcnt = (int*)(F.a->ws + WS_CTL + CTL_CNT);
    LAS int* hist = (LAS int*)F.lds; LAS int* base = hist + 256;
    const int lane = F.lane, w = F.wave;
    if (F.tid < 256) hist[F.tid] = 0;
    __syncthreads();
    const f32x4 bias = *(const f32x4*)(br + 4 * lane);
    f32x4 lgn = *(const f32x4*)(logits + (size_t)(tile * 256 + w * 32) * 256 + 4 * lane);
    for (int i = 0; i < 32; ++i) {
        const int tok = tile * 256 + w * 32 + i;
        const f32x4 lg = lgn;
        if (i + 1 < 32) lgn = *(const f32x4*)(logits + (size_t)(tok + 1) * 256 + 4 * lane);
        float sc[4], ch[4];
#pragma unroll
        for (int j = 0; j < 4; ++j) { sc[j] = 1.f / (1.f + __expf(-lg[j])); ch[j] = sc[j] + bias[j]; }
        float t1 = fmaxf(ch[0], ch[1]), t2 = fminf(ch[0], ch[1]);
        { const float a = fmaxf(ch[2], ch[3]), b = fminf(ch[2], ch[3]); const float n1 = fmaxf(t1, a), n2 = fmaxf(fminf(t1, a), fmaxf(t2, b)); t1 = n1; t2 = n2; }
        { const float a = dpp_f<0xB1>(t1, t1), b = dpp_f<0xB1>(t2, t2); const float n1 = fmaxf(t1, a), n2 = fmaxf(fminf(t1, a), fmaxf(t2, b)); t1 = n1; t2 = n2; }
        { const float a = dpp_f<0x4E>(t1, t1), b = dpp_f<0x4E>(t2, t2); const float n1 = fmaxf(t1, a), n2 = fmaxf(fminf(t1, a), fmaxf(t2, b)); t1 = n1; t2 = n2; }
        { const float a = dpp_f<0x141>(t1, t1), b = dpp_f<0x141>(t2, t2); const float n1 = fmaxf(t1, a), n2 = fmaxf(fminf(t1, a), fmaxf(t2, b)); t1 = n1; t2 = n2; }
        const float gs = t1 + t2; int ngt = 0;
#pragma unroll
        for (int j = 0; j < 8; ++j) { const float o = __builtin_bit_cast(float, __builtin_amdgcn_readlane(__builtin_bit_cast(int, gs), 8 * j)); ngt += (o > gs) ? 1 : 0; }
        const bool keep = ngt < 4;
#pragma unroll
        for (int j = 0; j < 4; ++j) ch[j] = keep ? ch[j] : -INFINITY;
        int my_e = 0; float my_s = 0.f;
#pragma unroll 1
        for (int k = 0; k < 8; ++k) {
            float bv = ch[0]; int bj = 0; float bs = sc[0];
#pragma unroll
            for (int j = 1; j < 4; ++j) if (ch[j] > bv) { bv = ch[j]; bj = j; bs = sc[j]; }
            const float M = wave_max_bcast(bv);
            const unsigned long long hit = __ballot(bv == M);
            const int owner = __builtin_ctzll(hit);
            const int be = __builtin_amdgcn_readlane(4 * lane + bj, owner);
            const float bsc = __builtin_bit_cast(float, __builtin_amdgcn_readlane(__builtin_bit_cast(int, bs), owner));
            if (lane == k) { my_e = be; my_s = bsc; }
            if (lane == owner) {
#pragma unroll
                for (int j = 0; j < 4; ++j) if (bj == j) ch[j] = -INFINITY;
            }
        }
        float ssum = my_s;
        ssum += dpp_f<0xB1>(0.f, ssum); ssum += dpp_f<0x4E>(0.f, ssum); ssum += dpp_f<0x141>(0.f, ssum);
        if (lane < 8) {
            const int p = __hip_atomic_fetch_add(&hist[my_e], 1, __ATOMIC_RELAXED, __HIP_MEMORY_SCOPE_WORKGROUP);
            tk_e[(size_t)tok * 8 + lane] = my_e; tk_g[(size_t)tok * 8 + lane] = my_s / ssum * 2.5f; tk_p[(size_t)tok * 8 + lane] = p;
        }
    }
    __syncthreads();
    const int chunk = (tile * 256) / CHT;
    if (F.tid < 256) { const int c = hist[F.tid]; base[F.tid] = c > 0 ? atomicAdd(&gcnt[chunk * NE + F.tid], c) : 0; }
    __syncthreads();
    {
      const size_t e0 = (size_t)(tile * 256 + w * 32) * 8 + 4 * lane;
      const i32x4 e4 = *(const i32x4*)(tk_e + e0); i32x4 p4 = *(const i32x4*)(tk_p + e0);
      p4.x += base[e4.x]; p4.y += base[e4.y]; p4.z += base[e4.z]; p4.w += base[e4.w];
      *(i32x4*)(tk_p + e0) = p4; }
    __syncthreads();
}

__device__ __forceinline__ void phase_dispatch(Frame& F) {
    const int* gcnt = (const int*)(F.a->ws + WS_CTL + CTL_CNT);
    LAS int* off = (LAS int*)F.lds;
    LAS int* tst = off + NCH * NE;
    LAS int* cnt = tst + NCH * NE;
    LAS int* ntl = cnt + NCH * NE;
    for (int i = F.tid; i < NCH * NE; i += NTHR) cnt[i] = gcnt[i];
    __syncthreads();
    if (F.wave < NCH) {
        const int c = F.wave; int cv[4], tv[4], so = 0, st = 0;
#pragma unroll
        for (int j = 0; j < 4; ++j) { cv[j] = cnt[c * NE + 4 * F.lane + j]; tv[j] = (cv[j] + 255) >> 8; so += cv[j]; st += tv[j]; }
        int io = so, it = st;
#define ISCAN(v) do { v += __builtin_amdgcn_update_dpp(0, v, 0x111, 0xf, 0xf, false); v += __builtin_amdgcn_update_dpp(0, v, 0x112, 0xf, 0xf, false); v += __builtin_amdgcn_update_dpp(0, v, 0x114, 0xf, 0xf, false); \
        v += __builtin_amdgcn_update_dpp(0, v, 0x118, 0xf, 0xf, false); v += __builtin_amdgcn_update_dpp(0, v, 0x142, 0xa, 0xf, false); v += __builtin_amdgcn_update_dpp(0, v, 0x143, 0xc, 0xf, false); } while (0)
        ISCAN(io); ISCAN(it);
#undef ISCAN
        int o = io - so, t = it - st;
#pragma unroll
        for (int j = 0; j < 4; ++j) { off[c * NE + 4 * F.lane + j] = o; tst[c * NE + 4 * F.lane + j] = t; o += cv[j]; t += tv[j]; }
        if (F.lane == 63) ntl[c] = it;
    }
    __syncthreads();
    int* te = WSP(F, WS_TILE, int); int* trow0 = te + NCH * MAXTILES; int* tnv = trow0 + NCH * MAXTILES; int* ntiles = tnv + NCH * MAXTILES;
    if (blockIdx.x < NCH) { const int c = blockIdx.x;
        for (int e = F.tid; e < NE; e += NTHR) { const int n = cnt[c * NE + e], t0 = tst[c * NE + e], o = off[c * NE + e];
            for (int m = 0; m * 256 < n; ++m) { te[c * MAXTILES + t0 + m] = e; trow0[c * MAXTILES + t0 + m] = o + 256 * m; tnv[c * MAXTILES + t0 + m] = (n - 256 * m) < 256 ? (n - 256 * m) : 256; } }
        const int nr = ntl[c];
        for (int m = F.tid; m < CHT / 256; m += NTHR) { te[c * MAXTILES + nr + m] = NE; trow0[c * MAXTILES + nr + m] = CH_ROUTED + 256 * m; tnv[c * MAXTILES + nr + m] = 256; }
        if (F.tid == 0) ntiles[c] = nr + CHT / 256;
    }
    const int* tk_e = WSP(F, WS_TOPK_E, int); int* tk_p = WSP(F, WS_TOPK_P, int);
    int* rowtok = WSP(F, WS_ROWTOK, int);
    for (int a = blockIdx.x * NTHR + F.tid; a < NTOK * 8; a += F.G * NTHR) { const int tok = a >> 3, c = tok / CHT;
        const int e = tk_e[a], slot = off[c * NE + e] + tk_p[a];
        rowtok[(size_t)c * CH_ROUTED + slot] = tok; tk_p[a] = slot; }
    __syncthreads();
}

__device__ __forceinline__ void phase_combine(Frame& F, int chunk) {
    const unsigned char* Y = WSP(F, WS_B, unsigned char); const int* slot = WSP(F, WS_TOPK_P, int); const float* tkg = WSP(F, WS_TOPK_G, float);
    const float* mod = WSP(F, WS_MOD, float); const float* gf = F.a->in[I_GFIN];
    const int lane = F.lane, gw = F.vcu * 8 + F.wave, NGW = F.G * 8, c0 = 16 * lane;
    typedef float f32x2 __attribute__((ext_vector_type(2)));
    typedef int i32x4 __attribute__((ext_vector_type(4)));
    int mi = gw;
    if (mi >= CHT) return;
    f32x4 gfv[4];
#pragma unroll
    for (int i = 0; i < 4; ++i) gfv[i] = *(const f32x4*)(gf + c0 + 4 * i);
    i32x4 rn0, rn1; f32x4 gn0, gn1;
    { const size_t m = (size_t)chunk * CHT + mi; rn0 = *(const i32x4*)(slot + m * 8); rn1 = *(const i32x4*)(slot + m * 8 + 4); gn0 = *(const f32x4*)(tkg + m * 8); gn1 = *(const f32x4*)(tkg + m * 8 + 4); }
#pragma unroll 1
    for (; mi < CHT; mi += NGW) { const int m = chunk * CHT + mi, b = m / SEQ;
        const i32x4 r0 = rn0, r1 = rn1; const f32x4 g0 = gn0 * (1.f / YSCALE), g1 = gn1 * (1.f / YSCALE);
        u32x4 yv[9];
        yv[0] = *(const u32x4*)(Y + (size_t)r0.x * D + c0); yv[1] = *(const u32x4*)(Y + (size_t)r0.y * D + c0); yv[2] = *(const u32x4*)(Y + (size_t)r0.z * D + c0); yv[3] = *(const u32x4*)(Y + (size_t)r0.w * D + c0);
        yv[4] = *(const u32x4*)(Y + (size_t)r1.x * D + c0); yv[5] = *(const u32x4*)(Y + (size_t)r1.y * D + c0); yv[6] = *(const u32x4*)(Y + (size_t)r1.z * D + c0); yv[7] = *(const u32x4*)(Y + (size_t)r1.w * D + c0);
        yv[8] = *(const u32x4*)(Y + (size_t)(CH_ROUTED + mi) * D + c0);
        float* hrow = F.a->out + (size_t)m * D;
        f32x4 g2v[4];
#pragma unroll
        for (int i = 0; i < 4; ++i) g2v[i] = *(const f32x4*)(mod + b * 6144 + 5120 + c0 + 4 * i);
        f32x4 hv[4];
        { const bf16_t* hb = h_row(F.a->out, F.a->ws, m) + c0; const u32x4 ha = *(const u32x4*)hb, hc = *(const u32x4*)(hb + 8);
          hv[0] = (f32x4){bflo(ha.x), bfhi(ha.x), bflo(ha.y), bfhi(ha.y)}; hv[1] = (f32x4){bflo(ha.z), bfhi(ha.z), bflo(ha.w), bfhi(ha.w)};
          hv[2] = (f32x4){bflo(hc.x), bfhi(hc.x), bflo(hc.y), bfhi(hc.y)}; hv[3] = (f32x4){bflo(hc.z), bfhi(hc.z), bflo(hc.w), bfhi(hc.w)}; }
        if (mi + NGW < CHT) { const size_t mn = (size_t)m + NGW; rn0 = *(const i32x4*)(slot + mn * 8); rn1 = *(const i32x4*)(slot + mn * 8 + 4); gn0 = *(const f32x4*)(tkg + mn * 8); gn1 = *(const f32x4*)(tkg + mn * 8 + 4); }
        const float gk[9] = {g0.x, g0.y, g0.z, g0.w, g1.x, g1.y, g1.z, g1.w, 1.f / YSCALE};
        f32x4 acc[4];
#pragma unroll
        for (int i = 0; i < 4; ++i) acc[i] = (f32x4){0.f, 0.f, 0.f, 0.f};
#pragma unroll
        for (int k = 0; k < 9; ++k)
#pragma unroll
            for (int i = 0; i < 4; ++i) { const f32x2 lo = __builtin_amdgcn_cvt_pk_f32_fp8((int)yv[k][i], false), hi = __builtin_amdgcn_cvt_pk_f32_fp8((int)yv[k][i], true);
                acc[i].x += gk[k] * lo.x; acc[i].y += gk[k] * lo.y; acc[i].z += gk[k] * hi.x; acc[i].w += gk[k] * hi.y; }
        float sq = 0.f;
#pragma unroll
        for (int i = 0; i < 4; ++i) { const f32x4 g2 = g2v[i];
            hv[i] = hv[i] + g2 * acc[i];
            sq += (hv[i].x * hv[i].x + hv[i].y * hv[i].y) + (hv[i].z * hv[i].z + hv[i].w * hv[i].w); }
        const float rs = 1.f / sqrtf(wave_sum(sq) * (1.f / D) + EPS);
#pragma unroll
        for (int i = 0; i < 4; ++i) *(f32x4*)(hrow + c0 + 4 * i) = hv[i] * rs * gfv[i];
    }
}

constexpr int N_PHASES = 9 + 3 * NCH;
#ifndef REP_MASK
#define REP_MASK 0u
#endif
#define NREP(k) (1 + (int)((REP_MASK >> (k)) & 1u))
#ifndef PROBE_KIND
#define PROBE_KIND 0
#endif
__global__ void __launch_bounds__(NTHR, 2) hybrid_fwd(Args args) {
    extern __shared__ __attribute__((aligned(16))) unsigned char lds_raw[];
    LAS unsigned char* const lds = (LAS unsigned char*)lds_raw;
    volatile LAS unsigned* MISC = (volatile LAS unsigned*)(lds + MISC_OFF);
    if (threadIdx.x < 64) MISC[threadIdx.x] = 0u;
    __syncthreads();
    XcdBarrier bar; bar.bar = (unsigned*)(args.ws + WS_CTL); bar.x = 0; bar.st = nullptr;
    const int lo = args.ph_lo, hi = args.ph_hi;
    if (hi - lo > 1) bar = xcd_barrier_post((unsigned*)(args.ws + WS_CTL), MISC + 8);
#define IN(k) (lo <= (k) && (k) < hi)
#define SEAM(k) do { if (IN(k) && IN((k) + 1)) xcd_barrier(bar); } while (0)

    if (IN(0)) { for (int rep = 0; rep < NREP(0); ++rep) { Frame F = make_frame(lds); phase_mod(F); } } SEAM(0);
    if (IN(1)) { for (int rep = 0; rep < NREP(1); ++rep) { Frame F = make_frame(lds); phase_prep(F); } } SEAM(1);
    if (IN(2)) for (int rep = 0; rep < NREP(2); ++rep) {
        const bool conv_first = (blockIdx.x >> 3) & 1;
        if (conv_first && rep == 0) { Frame F = make_frame(lds); convert_experts(F, 0, CONV_ITEMS); }
        { Frame F = make_frame(lds);
        pg8::DenseSched<512> S; S.init(F.a->ws + WS_A, F.a->ws + WS_WTIN, NTOK, NPROJ, F.G, (int)blockIdx.x, F.tid);
        EpiBf16T<true> E{WSP(F, WS_B, bf16_t), NPROJ};
        pg8::gemm_phase<512, EpiBf16T<true>, pg8::DenseSched<512>, true, true>(F.lds, F.tid, S, E); }
        if (!conv_first && rep == 0) { Frame F = make_frame(lds); convert_experts(F, 0, CONV_ITEMS); }
    } SEAM(2);
    if (IN(3)) { for (int rep = 0; rep < NREP(3); ++rep) { Frame F = make_frame(lds); phase_attn(F); } for (int rep = 0; rep < NREP(21); ++rep) { Frame F = make_frame(lds); phase_sgu(F); } } SEAM(3);
    if (IN(4)) { for (int rep = 0; rep < NREP(4); ++rep) { Frame F = make_frame(lds); phase_merge(F); } } SEAM(4);
    if (IN(5)) for (int rep = 0; rep < NREP(5); ++rep) {
        Frame F = make_frame(lds);
        pg8::DenseSched<512> S; S.init(F.a->ws + WS_A, F.a->ws + WS_WTOUT, NTOK, D, F.G, (int)blockIdx.x, F.tid);
        EpiResH E{F.a->in[I_X], WSP(F, WS_MOD, float) + 2048, F.a->out, F.a->ws};
        pg8::gemm_phase<512, EpiResH, pg8::DenseSched<512>, true, true>(F.lds, F.tid, S, E);
    } SEAM(5);
    if (IN(7)) {
        Frame F = make_frame(lds);
        pg8::DenseSched<1024> S; S.init(F.a->ws + WS_A, F.a->ws + WS_WTR, NTOK, NE, F.G, (int)blockIdx.x, F.tid);
        { const float* mod = WSP(F, WS_MOD, float); bf16_t* n2 = WSP(F, WS_A, bf16_t); Unit u0;
          for (int i = 0; S.next(i, u0); ++i) for (int r = 4 * F.wave; r < 256; r += 32) { const int m = u0.t * 256 + r, b = m / SEQ;
              norm_mod_rows<4, true>(h_row(F.a->out, F.a->ws, m), D, F.a->in[I_GFFN], mod + b * 6144 + 3072, mod + b * 6144 + 4096, n2 + (size_t)m * D, D, F.lane, WSP(F, WS_N2F8, unsigned char) + (size_t)m * D); }
          asm volatile("s_waitcnt vmcnt(0)" ::: "memory"); __syncthreads(); }
        EpiF32 E{WSP(F, WS_B, float), NE};
        pg8::gemm_phase<1024, EpiF32, pg8::DenseSched<1024>, true, true>(F.lds, F.tid, S, E);
        asm volatile("s_waitcnt vmcnt(0)" ::: "memory"); __syncthreads();
        Unit u; for (int i = 0; S.next(i, u); ++i) router_topk(F, u.t);
    } SEAM(7);
    if (IN(8)) { Frame F = make_frame(lds); phase_dispatch(F); } SEAM(8);
    const bool comb_late = (blockIdx.x >> 4) & 1;
#pragma unroll
    for (int c = 0; c < NCH; ++c) {
        if (IN(9 + 3 * c)) for (int rep = 0; rep < NREP(9); ++rep) {
            Frame F = make_frame(lds);
            const int* te = WSP(F, WS_TILE, int);
            TileTabs T; T.te = te + c * MAXTILES; T.trow0 = te + NCH * MAXTILES + c * MAXTILES; T.tnv = te + 2 * NCH * MAXTILES + c * MAXTILES;
            T.ntiles = __builtin_amdgcn_readfirstlane((te + 3 * NCH * MAXTILES)[c]);
            Gemm1Sched S; S.init(F.lds, F.a->ws + WS_N2F8, F.a->ws + WS_W1T, WSP(F, WS_ROWTOK, int) + (size_t)c * CH_ROUTED, T, c, F.tid);
            EpiAct E{WSP(F, WS_ACT, unsigned char)};
            pg8::gemm_phase<512, EpiAct, Gemm1Sched, true, true>(F.lds, F.tid, S, E, (NREP(9) > 1 && rep == 0) ? PROBE_KIND : 0);
        }
        if (c > 0 && comb_late && IN(11 + 3 * (c - 1))) { Frame F = make_frame(lds); phase_combine(F, c - 1); }
        SEAM(9 + 3 * c);
        if (IN(10 + 3 * c)) for (int rep = 0; rep < NREP(10); ++rep) {
            Frame F = make_frame(lds);
            const int* te = WSP(F, WS_TILE, int);
            TileTabs T; T.te = te + c * MAXTILES; T.trow0 = te + NCH * MAXTILES + c * MAXTILES; T.tnv = te + 2 * NCH * MAXTILES + c * MAXTILES;
            T.ntiles = __builtin_amdgcn_readfirstlane((te + 3 * NCH * MAXTILES)[c]);
            Gemm2Sched S; S.init(F.lds, F.a->ws + WS_ACT, F.a->ws + WS_W2T, nullptr, T, c, F.tid);
            EpiDown E{WSP(F, WS_B, unsigned char), F.lds, (NREP(10) > 1 && rep == 0 && (PROBE_KIND & 4)) ? 1 : 0};
            pg8::gemm_phase<128, EpiDown, Gemm2Sched, true, true>(F.lds, F.tid, S, E, (NREP(10) > 1 && rep == 0) ? PROBE_KIND : 0);
        } SEAM(10 + 3 * c);
        if (IN(11 + 3 * c) && !(c + 1 < NCH && comb_late)) { Frame F = make_frame(lds); phase_combine(F, c); }
    }
#undef IN
#undef SEAM
}

extern "C" void kernel_launch(void* const* d_in, const int* in_sizes, int n_in, void* d_out, int out_size, void* d_ws, size_t ws_size, hipStream_t stream) {
    static int grid = 0;
    if (grid == 0) {
        if (n_in != 23 || out_size != NTOK * D || ws_size < WS_END) { fprintf(stderr, "kernel_launch: unexpected shapes (n_in %d out %d ws %zu need %zu)\n", n_in, out_size, ws_size, (size_t)WS_END); grid = -1; return; }
        int dev = 0, cus = 0, per_cu = 0;
        if (hipGetDevice(&dev) != hipSuccess || hipDeviceGetAttribute(&cus, hipDeviceAttributeMultiprocessorCount, dev) != hipSuccess) { grid = -1; return; }
        if (hipFuncSetAttribute((const void*)hybrid_fwd, hipFuncAttributeMaxDynamicSharedMemorySize, LDS_BYTES) != hipSuccess) { fprintf(stderr, "kernel_launch: hipFuncSetAttribute failed\n"); grid = -1; return; }
        if (hipOccupancyMaxActiveBlocksPerMultiprocessor(&per_cu, (const void*)hybrid_fwd, NTHR, LDS_BYTES) != hipSuccess || per_cu < 1) fprintf(stderr, "kernel_launch: occupancy query says %d\n", per_cu);
        (void)hipGetLastError();
        grid = cus & ~7;
        if (grid <= 0) { grid = -1; return; }
    }
    if (grid < 0) return;
    if (hipMemsetAsync((char*)d_ws + WS_CTL, 0, CTL_BYTES, stream) != hipSuccess) return;
    Args a{};
    for (int i = 0; i < 23; ++i) a.in[i] = (const float*)d_in[i];
    a.out = (float*)d_out; a.ws = (unsigned char*)d_ws;
#if MK_MULTI
    for (int p = 0; p < N_PHASES; ++p) { a.ph_lo = p; a.ph_hi = p + 1; hipLaunchKernelGGL(hybrid_fwd, dim3(grid), dim3(NTHR), LDS_BYTES, stream, a); }
#else
    a.ph_lo = 0; a.ph_hi = N_PHASES;
    hipLaunchKernelGGL(hybrid_fwd, dim3(grid), dim3(NTHR), LDS_BYTES, stream, a);
#endif
    const hipError_t le = hipPeekAtLastError();
    if (le != hipSuccess) fprintf(stderr, "kernel_launch: launch failed: %s\n", hipGetErrorName(le));
}
```

```cpp
#include <hip/hip_runtime.h>
#include <cstdio>
#include <cstdint>

#ifndef MK_MULTI
#define MK_MULTI 0
#endif

#define GAS __attribute__((address_space(1)))
#define LAS __attribute__((address_space(3)))
#define CAS __attribute__((address_space(4)))
typedef unsigned short bf16_t;
typedef short bf16x8 __attribute__((ext_vector_type(8)));
typedef short s16x4 __attribute__((ext_vector_type(4)));
typedef float f32x4 __attribute__((ext_vector_type(4)));
typedef unsigned u32x4 __attribute__((ext_vector_type(4)));
typedef unsigned u32x2 __attribute__((ext_vector_type(2)));
typedef int i32x4 __attribute__((ext_vector_type(4)));
typedef int i32x8 __attribute__((ext_vector_type(8)));

constexpr int D = 1024, NBATCH = 16, SEQ = 4096, NTOK = NBATCH * SEQ;
constexpr int NPROJ = 2560;
constexpr int NE = 256, TOPK = 8, EDIM = 256;
constexpr int NCH = 2, CHT = NTOK / NCH;
constexpr int CH_ROUTED = CHT * TOPK;
constexpr int CH_ROWS = CH_ROUTED + CHT;
constexpr int MAXTILES = CH_ROUTED / 256 + NE + CHT / 256;
constexpr float W1_PRE = 64.f, W2_PRE = 8.f, ACT_PRE = 4.f;
constexpr int E8M0_ONE = 127;
constexpr int SC_W1 = (E8M0_ONE - 6) * 0x01010101, SC_W2 = (E8M0_ONE - 3) * 0x01010101, SC_ACT = (E8M0_ONE - 2) * 0x01010101, SC_N2 = E8M0_ONE * 0x01010101;
constexpr float YSCALE = 8.f;
constexpr float EPS = 1e-6f;
constexpr float LOG2E = 1.4426950408889634f;

constexpr size_t WS_CTL = 0, CTL_BYTES = 65536;
constexpr size_t CTL_CNT = 16384;
constexpr size_t WS_MOD = 65536;
constexpr size_t WS_WSP = WS_MOD + 393216;
constexpr size_t WS_TILE = WS_WSP + 131072;
constexpr size_t TILE_TAB = (size_t)NCH * MAXTILES * 4;
constexpr size_t WS_OFFS = WS_TILE + 3 * TILE_TAB + 256;
constexpr size_t WS_WTIN = 1048576;
constexpr size_t WS_WTOUT = WS_WTIN + 5242880;
constexpr size_t WS_WTR = WS_WTOUT + 2097152;
constexpr size_t WS_TOPK_E = 9437184;
constexpr size_t WS_TOPK_G = WS_TOPK_E + 2097152;
constexpr size_t WS_TOPK_P = WS_TOPK_G + 2097152;
constexpr size_t WS_ROWTOK = WS_TOPK_P + 2097152;
constexpr size_t WS_W1T = WS_ROWTOK + 2097152;
constexpr size_t WS_W2T = WS_W1T + (size_t)257 * 524288;
constexpr size_t WS_A = WS_W2T + (size_t)257 * 262144;
constexpr size_t WS_B = WS_A + (size_t)NTOK * D * 2;
constexpr size_t WS_ACT = WS_B + (size_t)NTOK * NPROJ * 2;
constexpr size_t WS_LSE = WS_ACT;
constexpr size_t WS_H1 = WS_ACT + (size_t)(CH_ROWS + 256) * EDIM;
constexpr size_t WS_N2F8 = WS_H1 + (size_t)(NTOK / 2) * D * 2;
constexpr size_t WS_END = WS_N2F8 + (size_t)NTOK * D;
static_assert((size_t)(CH_ROWS + 256) * EDIM >= (size_t)3 * NTOK * 8 * 4, "lse fits the act region");
static_assert(WS_OFFS + 4096 <= WS_WTIN && WS_WTR + 524288 <= WS_TOPK_E && (WS_W1T % 256) == 0, "ws map");
static_assert((size_t)CH_ROWS * D <= (size_t)NTOK * NPROJ * 2, "Y chunk (fp8) fits region B");
static_assert(WS_END <= 1118000000ull, "workspace");

constexpr int LDS_BYTES = 155648;
constexpr int MISC_OFF = 153600;
constexpr int NTHR = 512;

typedef float f32x2_t __attribute__((ext_vector_type(2)));
typedef __bf16 bf16x2_t __attribute__((ext_vector_type(2)));
__device__ __forceinline__ unsigned cvt_pk_bf16(float lo, float hi) { const f32x2_t v = {lo, hi}; return __builtin_bit_cast(unsigned, __builtin_convertvector(v, bf16x2_t)); }
__device__ __forceinline__ unsigned cvt_pk_bf16_a(float lo, float hi) { unsigned r; asm("s_nop 0\n\tv_cvt_pk_bf16_f32 %0, %1, %2" : "=v"(r) : "v"(lo), "v"(hi)); return r; }
__device__ __forceinline__ float bf2f(unsigned short b) { return __builtin_bit_cast(float, (unsigned)b << 16); }
__device__ __forceinline__ float bflo(unsigned w) { return __builtin_bit_cast(float, w << 16); }
__device__ __forceinline__ float bfhi(unsigned w) { return __builtin_bit_cast(float, w & 0xffff0000u); }
template <int CTRL, int ROW_MASK = 0xf>
__device__ __forceinline__ float dpp_f(float old, float v) { return __builtin_bit_cast(float, __builtin_amdgcn_update_dpp(__builtin_bit_cast(int, old), __builtin_bit_cast(int, v), CTRL, ROW_MASK, 0xf, false)); }
__device__ __forceinline__ float wave_sum(float v) {
    v += dpp_f<0x111>(0.f, v); v += dpp_f<0x112>(0.f, v); v += dpp_f<0x114>(0.f, v); v += dpp_f<0x118>(0.f, v);
    v += dpp_f<0x142, 0xa>(0.f, v); v += dpp_f<0x143, 0xc>(0.f, v);
    return __builtin_bit_cast(float, __builtin_amdgcn_readlane(__builtin_bit_cast(int, v), 63));
}
__device__ __forceinline__ float fast_exp2(float x) { return __builtin_amdgcn_exp2f(x); }
__device__ __forceinline__ float fast_rcp(float x) { return __builtin_amdgcn_rcpf(x); }
__device__ __forceinline__ float silu_f(float x) { return x * fast_rcp(1.f + fast_exp2(-x * LOG2E)); }
__device__ __forceinline__ float gelu_f(float x) { const float y2 = 2.3022082f * (x + 0.044715f * x * x * x); return x * fast_rcp(1.f + fast_exp2(-y2)); }

#define XB_TMO      128
#define XB_XCNT(j)  (256  + 64 * (j))
#define XB_XSUB(j)  (1280 + 64 * (j))
#define XB_XGEN(j)  (2304 + 64 * (j))
#define XB_TOP      3328
#define XB_TOPGEN   3392
#define XCD_BAR_WORDS 3456
#define XB_SPIN_CAP (1u << 20)
__device__ __forceinline__ unsigned xb_ld(unsigned* p)              { return __hip_atomic_load(p, __ATOMIC_RELAXED, __HIP_MEMORY_SCOPE_AGENT); }
__device__ __forceinline__ unsigned xb_add(unsigned* p, unsigned v) { return __hip_atomic_fetch_add(p, v, __ATOMIC_RELAXED, __HIP_MEMORY_SCOPE_AGENT); }
__device__ __forceinline__ unsigned xb_xcc_id() { return (unsigned)__builtin_amdgcn_s_getreg((3 << 11) | 20) & 0xFu; }
#define XB_SPIN(cond, bar) do { unsigned _sp = 0; while (cond) { __builtin_amdgcn_s_sleep(1); \
    if ((++_sp & 255u) == 0u) { if (xb_ld(&(bar)[XB_TMO])) break; if (_sp > XB_SPIN_CAP) { atomicAdd(&(bar)[XB_TMO], 1u); break; } } } } while (0)
struct XcdBarrier { unsigned* bar; unsigned x; volatile LAS unsigned* st; };
__device__ __forceinline__ XcdBarrier xcd_barrier_post(unsigned* bar, volatile LAS unsigned* st) {
    XcdBarrier b; b.bar = bar; b.x = xb_xcc_id(); b.st = st;
    if (threadIdx.x == 0) (void)xb_add(&bar[XB_XCNT(b.x)], 1u);
    return b;
}
__device__ __forceinline__ void xcd_barrier_complete(unsigned* bar, unsigned x, unsigned& nloc, unsigned& nx) {
    const unsigned G = gridDim.x * gridDim.y * gridDim.z;
    unsigned sum, cnt, mine, sp = 0u;
    for (;;) {
        sum = 0u; cnt = 0u; mine = 0u;
#pragma unroll
        for (unsigned j = 0; j < 16; ++j) { const unsigned c = xb_ld(&bar[XB_XCNT(j)]); sum += c; cnt += (c > 0u) ? 1u : 0u; mine = (j == x) ? c : mine; }
        if (sum == G) break;
        __builtin_amdgcn_s_sleep(1);
        if ((++sp & 255u) == 0u) { if (xb_ld(&bar[XB_TMO])) break; if (sp > XB_SPIN_CAP) { atomicAdd(&bar[XB_TMO], 1u); break; } }
    }
    nloc = mine > 0u ? mine : 1u; nx = cnt > 0u ? cnt : 1u;
}
__device__ __forceinline__ void xcd_barrier(const XcdBarrier& b) {
    asm volatile("s_waitcnt vmcnt(0)" ::: "memory");
    __syncthreads();
    if (threadIdx.x == 0) {
        unsigned* bar = b.bar;
        __builtin_amdgcn_s_waitcnt(0);
        unsigned nloc = b.st[0], nx = b.st[1];
        if (nloc == 0u) { xcd_barrier_complete(bar, b.x, nloc, nx); b.st[0] = nloc; b.st[1] = nx; }
        const unsigned old = xb_add(&bar[XB_XSUB(b.x)], 1u);
        const unsigned gen = old / nloc;
        if (old + 1u == (gen + 1u) * nloc) {
            __builtin_amdgcn_fence(__ATOMIC_RELEASE, "agent");
            asm volatile("s_waitcnt vmcnt(0)" ::: "memory");
            const unsigned og = xb_add(&bar[XB_TOP], 1u);
            const unsigned tg = og / nx;
            if (og + 1u == (tg + 1u) * nx) xb_add(&bar[XB_TOPGEN], 1u);
            else XB_SPIN(xb_ld(&bar[XB_TOPGEN]) == tg, bar);
            __builtin_amdgcn_fence(__ATOMIC_ACQUIRE, "agent");
            xb_add(&bar[XB_XGEN(b.x)], 1u);
            asm volatile("s_waitcnt vmcnt(0)" ::: "memory");
        } else {
            XB_SPIN(xb_ld(&bar[XB_XGEN(b.x)]) == gen, bar);
            __builtin_amdgcn_fence(__ATOMIC_ACQUIRE, "agent");
            asm volatile("s_waitcnt vmcnt(0)" ::: "memory");
        }
    }
    __syncthreads();
}

struct Args { const float* in[23]; float* out; unsigned char* ws; int ph_lo, ph_hi; };
__device__ __forceinline__ bf16_t* h_row(float* out, unsigned char* ws, int m) {
    return m < NTOK / 2 ? (bf16_t*)((unsigned char*)out + (size_t)NTOK * D * 2) + (size_t)m * D : (bf16_t*)(ws + WS_H1) + (size_t)(m - NTOK / 2) * D; }
enum { I_X = 0, I_C, I_WADA, I_BADA, I_GMIX, I_WIN, I_LNG, I_LNB, I_WSP, I_BSP, I_GOA, I_GOS, I_WOUT, I_GFFN, I_WR, I_BR, I_WEG, I_WEU, I_WED, I_WSG, I_WSU, I_WSD, I_GFIN };

namespace pg8 {
constexpr int BM = 256, BK = 64, HALF = 128, HTB = HALF * BK * 2, STAGE_BYTES = 8 * HTB;
__device__ __forceinline__ int lds_byte(int r, int c) { const int st = (r >> 4) * 2 + (c >> 5), rr = r & 15, cc = c & 31, ob = rr * 64 + cc * 2; return st * 1024 + (ob ^ (((ob >> 9) & 1) << 5)); }
__device__ __forceinline__ void stage_rc(int b, int& R, int& C) { const int st = b / 1024, sb = b % 1024, swz = sb ^ (((sb >> 9) & 1) << 5); R = (st >> 1) * 16 + swz / 64; C = (st & 1) * 32 + (swz % 64) / 2; }
__device__ __forceinline__ int perm32(int rho) { const int n = rho >> 4, i = rho & 15; return 8 * (i >> 2) + 4 * n + (i & 3); }

struct Unit { int t, nt, row0, nv, e; };

template <int K, class Epi, class Sched, bool ALIGN_EPI, bool SP2>
__device__ __forceinline__ void gemm_phase(LAS unsigned char* lds, const int tid, const Sched& S, const Epi& E, const int probe = 0) {
    const int wid = __builtin_amdgcn_readfirstlane(tid >> 6), lane = tid & 63, wr = wid >> 2, wc = wid & 3, fr = lane & 15, fq = lane >> 4;
    constexpr int nt = K / BK;
    unsigned voffB[2];
#pragma unroll
    for (int i = 0; i < 2; ++i) { int R, C; stage_rc(tid * 16 + i * 8192, R, C);
        const int Rb = Epi::COL16 ? (64 * (R >> 5) + 16 * ((R & 15) >> 2) + 4 * ((R >> 4) & 1) + (R & 3)) : ((R & ~31) + perm32(R & 31));
        voffB[i] = (unsigned)(Rb * K + C) * 2u; }
    constexpr size_t kstep = (size_t)(BK * 2);
    constexpr size_t hstep = (size_t)HALF * K * 2;
    constexpr size_t bstep = Epi::COL16 ? (size_t)8 * K * 2 : hstep;
    const unsigned ldsw = (unsigned)wid * 1024u;
    const int aoff = lds_byte(wr * 64 + fr, fq * 8), boff = lds_byte(wc * 32 + fr, fq * 8);
#define PG8_SA(b, h) (((b) * 2 + (h)) * HTB)
#define PG8_SB(b, h) ((4 + (b) * 2 + (h)) * HTB)
#define PG8_STAGE(bufoff, gbase, voff) do { _Pragma("unroll") for (int _i = 0; _i < 2; ++_i) \
        __builtin_amdgcn_global_load_lds((const unsigned*)((const char*)(gbase) + (voff)[_i]), (LAS unsigned*)(lds + (bufoff) + ldsw + _i * 8192), 16, 0, 0); } while (0)
#define PG8_LDA(dst, b, h) do { _Pragma("unroll") for (int m = 0; m < 4; ++m) _Pragma("unroll") for (int k = 0; k < 2; ++k) dst[m][k] = *(const LAS bf16x8*)(lds + PG8_SA(b, h) + aoff + m * 2048 + k * 1024); } while (0)
#define PG8_LDB(dst, b, h) do { _Pragma("unroll") for (int n = 0; n < 2; ++n) _Pragma("unroll") for (int k = 0; k < 2; ++k) dst[n][k] = *(const LAS bf16x8*)(lds + PG8_SB(b, h) + boff + n * 2048 + k * 1024); } while (0)
#define PG8_MMA(ai, bj, At, Bt) do { if (probe & 1) break; __builtin_amdgcn_s_setprio(1); _Pragma("unroll") for (int m = 0; m < 4; ++m) _Pragma("unroll") for (int n = 0; n < 2; ++n) { \
        if constexpr (Epi::F8) { \
            const i32x8 wa_ = __builtin_shufflevector(__builtin_bit_cast(i32x4, Bt[n][0]), __builtin_bit_cast(i32x4, Bt[n][1]), 0, 1, 2, 3, 4, 5, 6, 7); \
            const i32x8 xa_ = __builtin_shufflevector(__builtin_bit_cast(i32x4, At[m][0]), __builtin_bit_cast(i32x4, At[m][1]), 0, 1, 2, 3, 4, 5, 6, 7); \
            asm volatile("v_mfma_scale_f32_16x16x128_f8f6f4 %0, %1, %2, %0, %3, %4 op_sel_hi:[0,0,0]" : "+v"(acc[ai][bj][m][n]) : "v"(wa_), "v"(xa_), "v"(scw_), "v"(scx_)); \
        } else { _Pragma("unroll") for (int k = 0; k < 2; ++k) acc[ai][bj][m][n] = __builtin_amdgcn_mfma_f32_16x16x32_bf16(Bt[n][k], At[m][k], acc[ai][bj][m][n], 0, 0, 0); } } \
        __builtin_amdgcn_s_setprio(0); } while (0)
#define PG8_WAIT_V(n) asm volatile("s_waitcnt vmcnt(" #n ")" ::: "memory")
#define PG8_WAIT_L(n) asm volatile("s_waitcnt lgkmcnt(" #n ")" ::: "memory")
#define PG8_BAR __builtin_amdgcn_s_barrier()
#define PG8_SCHED __builtin_amdgcn_sched_barrier(0)
    Unit cur, nxt; int ui = 0;
    if (!S.next(0, cur)) return;
    f32x4 acc[2][2][4][2];
#pragma unroll
    for (int a = 0; a < 2; ++a)
#pragma unroll
        for (int b = 0; b < 2; ++b)
#pragma unroll
            for (int m = 0; m < 4; ++m)
#pragma unroll
                for (int n = 0; n < 2; ++n) acc[a][b][m][n] = (f32x4){0.f, 0.f, 0.f, 0.f};
    bf16x8 At[4][2], B0[2][2], B1[2][2];
    int scw_ = Epi::SC_W, scx_ = Epi::SC_X; asm volatile("" : "+v"(scw_), "+v"(scx_));
    constexpr bool GATHER = Sched::GATHER;
    constexpr size_t ah = GATHER ? 0 : hstep;
    unsigned va[2][2], vn[2][2];
    S.a_voff(cur, va);
#define VA1 (GATHER ? va[1] : va[0])
    const char* cA = S.a_base(cur); const char* cB = S.b_base(cur);
    if constexpr (SP2) {
        PG8_STAGE(PG8_SB(0, 0), cB, voffB); PG8_STAGE(PG8_SB(0, 1), cB + bstep, voffB); PG8_STAGE(PG8_SA(0, 0), cA, va[0]); PG8_STAGE(PG8_SA(0, 1), cA + ah, VA1);
        if (wr == 1) PG8_BAR;
        PG8_WAIT_V(2); PG8_BAR;
        PG8_STAGE(PG8_SB(1, 0), cB + kstep, voffB); PG8_STAGE(PG8_SA(1, 0), cA + kstep, va[0]); PG8_STAGE(PG8_SB(1, 1), cB + bstep + kstep, voffB);
        PG8_WAIT_V(6); PG8_BAR;
    } else {
        PG8_STAGE(PG8_SB(0, 0), cB, voffB); PG8_STAGE(PG8_SA(0, 0), cA, va[0]); PG8_STAGE(PG8_SB(0, 1), cB + bstep, voffB); PG8_STAGE(PG8_SA(0, 1), cA + ah, VA1);
        if (wr == 1) PG8_BAR;
        PG8_WAIT_V(4); PG8_BAR;
        PG8_STAGE(PG8_SB(1, 0), cB + kstep, voffB); PG8_STAGE(PG8_SA(1, 0), cA + kstep, va[0]); PG8_STAGE(PG8_SB(1, 1), cB + bstep + kstep, voffB);
        PG8_WAIT_V(6); PG8_BAR;
    }
    for (;;) {
        const bool has_next = S.next(ui + 1, nxt);
        const char* nA = has_next ? S.a_base(nxt) : cA; const char* nB = has_next ? S.b_base(nxt) : cB;
        const bool full = cur.nv > 128;
        if constexpr (GATHER) { if (has_next) S.a_voff(nxt, vn); else { vn[0][0] = va[0][0]; vn[0][1] = va[0][1]; vn[1][0] = va[1][0]; vn[1][1] = va[1][1]; } }
#pragma unroll 1
        for (int t = 0; t < nt; t += 2) {
            const bool last = (t == nt - 2);
            const char* a1 = cA + (size_t)(t + 1) * kstep;
            const char* a2 = last ? nA : cA + (size_t)(t + 2) * kstep; const char* b2 = last ? nB : cB + (size_t)(t + 2) * kstep;
            const char* a3 = a2 + kstep; const char* b3 = b2 + kstep;
            unsigned v2[2][2];
            if constexpr (GATHER) { v2[0][0] = last ? vn[0][0] : va[0][0]; v2[0][1] = last ? vn[0][1] : va[0][1]; v2[1][0] = last ? vn[1][0] : va[1][0]; v2[1][1] = last ? vn[1][1] : va[1][1]; }
            else { v2[0][0] = va[0][0]; v2[0][1] = va[0][1]; v2[1][0] = va[0][0]; v2[1][1] = va[0][1]; }
            if constexpr (SP2) {
            PG8_LDB(B0, 0, 0); PG8_LDB(B1, 0, 1); PG8_SCHED; PG8_LDA(At, 0, 0); PG8_STAGE(PG8_SA(1, 1), a1 + ah, VA1);
            PG8_WAIT_V(8); PG8_WAIT_L(0); PG8_BAR; PG8_MMA(0, 0, At, B0); PG8_MMA(0, 1, At, B1); PG8_BAR; PG8_SCHED;
            PG8_LDA(At, 0, 1); PG8_STAGE(PG8_SB(0, 0), b2, voffB); PG8_STAGE(PG8_SB(0, 1), b2 + bstep, voffB); PG8_STAGE(PG8_SA(0, 0), a2, v2[0]);
            PG8_WAIT_V(8); PG8_WAIT_L(0); PG8_BAR; if (full) { PG8_MMA(1, 0, At, B0); PG8_MMA(1, 1, At, B1); } PG8_BAR; PG8_SCHED;
            PG8_LDB(B0, 1, 0); PG8_LDB(B1, 1, 1); PG8_SCHED; PG8_LDA(At, 1, 0); PG8_STAGE(PG8_SA(0, 1), a2 + ah, v2[1]);
            PG8_WAIT_V(8); PG8_WAIT_L(0); PG8_BAR; PG8_MMA(0, 0, At, B0); PG8_MMA(0, 1, At, B1); PG8_BAR; PG8_SCHED;
            PG8_LDA(At, 1, 1); PG8_STAGE(PG8_SB(1, 0), b3, voffB); PG8_STAGE(PG8_SB(1, 1), b3 + bstep, voffB); PG8_STAGE(PG8_SA(1, 0), a3, v2[0]);
            PG8_WAIT_V(8); PG8_WAIT_L(0); PG8_BAR; if (full) { PG8_MMA(1, 0, At, B0); PG8_MMA(1, 1, At, B1); } PG8_BAR; PG8_SCHED;
            } else {
            PG8_LDB(B0, 0, 0); PG8_SCHED; PG8_LDA(At, 0, 0); PG8_STAGE(PG8_SA(1, 1), a1 + ah, VA1);
            PG8_WAIT_L(8); PG8_BAR; PG8_WAIT_L(0); PG8_MMA(0, 0, At, B0); PG8_BAR; PG8_SCHED;
            PG8_LDB(B1, 0, 1); PG8_STAGE(PG8_SB(0, 0), b2, voffB);
            PG8_BAR; PG8_WAIT_L(0); PG8_MMA(0, 1, At, B1); PG8_BAR;
            PG8_LDA(At, 0, 1); PG8_STAGE(PG8_SA(0, 0), a2, v2[0]);
            PG8_BAR; PG8_WAIT_L(0); PG8_MMA(1, 0, At, B0); PG8_BAR; PG8_SCHED;
            PG8_STAGE(PG8_SB(0, 1), b2 + bstep, voffB);
            PG8_WAIT_V(6); PG8_BAR; PG8_MMA(1, 1, At, B1); PG8_BAR;
            PG8_LDB(B0, 1, 0); PG8_SCHED; PG8_LDA(At, 1, 0); PG8_STAGE(PG8_SA(0, 1), a2 + ah, v2[1]);
            PG8_WAIT_L(8); PG8_BAR; PG8_WAIT_L(0); PG8_MMA(0, 0, At, B0); PG8_BAR; PG8_SCHED;
            PG8_LDB(B1, 1, 1); PG8_STAGE(PG8_SB(1, 0), b3, voffB);
            PG8_BAR; PG8_WAIT_L(0); PG8_MMA(0, 1, At, B1); PG8_BAR;
            PG8_LDA(At, 1, 1); PG8_STAGE(PG8_SA(1, 0), a3, v2[0]);
            PG8_BAR; PG8_WAIT_L(0); PG8_MMA(1, 0, At, B0); PG8_BAR; PG8_SCHED;
            PG8_STAGE(PG8_SB(1, 1), b3 + bstep, voffB);
            PG8_WAIT_V(6); PG8_BAR; PG8_MMA(1, 1, At, B1); PG8_BAR;
            }
        }
        if constexpr (ALIGN_EPI) { if (wr == 0) PG8_BAR; }
        if constexpr (Epi::F8) asm volatile("s_nop 15\n\ts_nop 15" ::: "memory");
        if (!(probe & 2)) E(acc, cur, wr, wc, fr, fq);
        if (!has_next) break;
#pragma unroll
        for (int a = 0; a < 2; ++a)
#pragma unroll
            for (int b = 0; b < 2; ++b)
#pragma unroll
                for (int m = 0; m < 4; ++m)
#pragma unroll
                    for (int n = 0; n < 2; ++n) acc[a][b][m][n] = (f32x4){0.f, 0.f, 0.f, 0.f};
        cur = nxt; cA = nA; cB = nB; ++ui;
        if constexpr (GATHER) { va[0][0] = vn[0][0]; va[0][1] = vn[0][1]; va[1][0] = vn[1][0]; va[1][1] = vn[1][1]; }
        if constexpr (ALIGN_EPI) { if (wr == 1) PG8_BAR; }
    }
    PG8_WAIT_V(0);
    if constexpr (!ALIGN_EPI) { if (wr == 0) PG8_BAR; }
    PG8_BAR;
#undef VA1
#undef PG8_SA
#undef PG8_SB
#undef PG8_STAGE
#undef PG8_LDA
#undef PG8_LDB
#undef PG8_MMA
#undef PG8_WAIT_V
#undef PG8_WAIT_L
#undef PG8_BAR
#undef PG8_SCHED
}

template <int K> struct DenseSched {
    static constexpr bool GATHER = false;
    const char* A; const char* Bt; int nM, nN, nwg, G, c, tid;
    __device__ __forceinline__ void init(const void* A_, const void* Bt_, int M, int N, int G_, int c_, int tid_) { tid = tid_; A = (const char*)A_; Bt = (const char*)Bt_; nM = M / BM; nN = N / BM; nwg = nM * nN; G = G_; c = c_; }
    __device__ __forceinline__ bool next(int i, Unit& u) const {
        const long L = (long)i * G + c; if (L >= nwg) return false;
        int wgid = (int)L; { const int q = nwg / 8, r = nwg % 8, xcd = wgid % 8, off = wgid / 8; wgid = (xcd < r ? xcd * (q + 1) : r * (q + 1) + (xcd - r) * q) + off; }
        const int nig = 8 * nN, gid = wgid / nig, fm = gid * 8, gsz = (nM - fm) < 8 ? (nM - fm) : 8;
        u.t = fm + ((wgid % nig) % gsz); u.nt = (wgid % nig) / gsz; u.row0 = 0; u.nv = 256; u.e = 0; return true;
    }
    __device__ __forceinline__ const char* a_base(const Unit& u) const { return A + (size_t)u.t * (BM * K * 2); }
    __device__ __forceinline__ const char* b_base(const Unit& u) const { return Bt + (size_t)u.nt * (BM * K * 2); }
    __device__ __forceinline__ void a_voff(const Unit&, unsigned (&v)[2][2]) const {
#pragma unroll
        for (int i = 0; i < 2; ++i) { int R, C; stage_rc(tid * 16 + i * 8192, R, C); v[0][i] = (unsigned)(R * K + C) * 2u; v[1][i] = v[0][i] + (unsigned)(HALF * K * 2); }
    }
};
}
using pg8::Unit;

struct TileTabs { const int* te; const int* trow0; const int* tnv; int ntiles; };
constexpr int UT_OFF = pg8::STAGE_BYTES;
constexpr int UT_INFO = UT_OFF + 16, UT_TOK = UT_INFO + 64 * 16, UT_MAXU = 20;
static_assert(UT_TOK + UT_MAXU * 1024 <= MISC_OFF, "unit tables fit under the LDS control words");
template <int NTN, bool G1>
struct ExpertSched {
    static constexpr bool GATHER = G1;
    const char* A; const char* W; LAS unsigned char* lds; int n, tid;
    __device__ __forceinline__ void init(LAS unsigned char* lds_, const void* A_, const void* W_, const int* rowtok, const TileTabs& T, int chunk, int tid_) {
        lds = lds_; tid = tid_; A = (const char*)A_; W = (const char*)W_;
        const int U = T.ntiles * NTN, x8 = blockIdx.x & 7, r8 = blockIdx.x >> 3, G8 = gridDim.x >> 3;
        const int q = (((U + 7) >> 3) + NTN - 1) / NTN * NTN;
        const int lo = x8 * q + r8, hi = (x8 + 1) * q < U ? (x8 + 1) * q : U;
        int cnt = hi > lo ? (hi - lo + G8 - 1) / G8 : 0; cnt = cnt > (G1 ? UT_MAXU : 64) ? (G1 ? UT_MAXU : 64) : cnt;
        n = cnt;
        LAS int* info = (LAS int*)(lds + UT_INFO);
        if (tid < cnt) { const int L = lo + G8 * tid, t = L / NTN; info[tid * 4 + 0] = T.te[t]; info[tid * 4 + 1] = T.trow0[t]; info[tid * 4 + 2] = T.tnv[t]; info[tid * 4 + 3] = L % NTN; }
        __syncthreads();
        if constexpr (G1) {
            LAS int* tok = (LAS int*)(lds + UT_TOK);
            constexpr int TPT = UT_MAXU * 256 / NTHR;
            if (cnt > 0) {
                const int lim = cnt * 256 - 1;
                int tv[TPT], ad[TPT], ld[TPT];
#pragma unroll
                for (int k = 0; k < TPT; ++k) { const int id0 = tid + k * NTHR, idx = id0 < lim ? id0 : lim;
                    const int i = idx >> 8, rl = idx & 255; const int e = info[i * 4 + 0], row0 = info[i * 4 + 1], nv = info[i * 4 + 2];
                    const bool sh = e == NE; const int rc = rl < nv ? rl : nv - 1;
                    ad[k] = sh ? 0 : row0 + rc;
                    tv[k] = sh ? chunk * CHT + (row0 - CH_ROUTED) + rl : (rl < nv ? -1 : chunk * CHT); }
                __builtin_amdgcn_sched_barrier(0);
#pragma unroll
                for (int k = 0; k < TPT; ++k) ld[k] = rowtok[ad[k]];
                __builtin_amdgcn_sched_barrier(0);
#pragma unroll
                for (int k = 0; k < TPT; ++k) tv[k] = tv[k] < 0 ? ld[k] : tv[k];
#pragma unroll
                for (int k = 0; k < TPT; ++k) { const int idx = tid + k * NTHR; if (idx <= lim) tok[idx] = tv[k]; }
            }
            __syncthreads();
        }
    }
    __device__ __forceinline__ bool next(int i, Unit& u) const {
        if (i >= n) return false;
        const LAS int* info = (const LAS int*)(lds + UT_INFO);
        u.t = i; u.e = __builtin_amdgcn_readfirstlane(info[i * 4 + 0]); u.row0 = __builtin_amdgcn_readfirstlane(info[i * 4 + 1]);
        u.nv = __builtin_amdgcn_readfirstlane(info[i * 4 + 2]); u.nt = __builtin_amdgcn_readfirstlane(info[i * 4 + 3]); return true; }
    __device__ __forceinline__ const char* a_base(const Unit& u) const { if constexpr (G1) return A; else return A + (size_t)u.row0 * 256; }
    __device__ __forceinline__ const char* b_base(const Unit& u) const {
        if constexpr (G1) return W + ((size_t)u.e * 512 + u.nt * 256) * 1024; else return W + ((size_t)u.e * 1024 + u.nt * 256) * 256; }
    __device__ __forceinline__ void a_voff(const Unit& u, unsigned (&v)[2][2]) const {
        if constexpr (G1) {
            const LAS int* tok = (const LAS int*)(lds + UT_TOK) + u.t * 256;
#pragma unroll
            for (int i = 0; i < 2; ++i) { int R, C; pg8::stage_rc(tid * 16 + i * 8192, R, C);
#pragma unroll
                for (int h = 0; h < 2; ++h) v[h][i] = (unsigned)tok[R + 128 * h] * 1024u + (unsigned)C * 2u; }
        } else {
#pragma unroll
            for (int i = 0; i < 2; ++i) { int R, C; pg8::stage_rc(tid * 16 + i * 8192, R, C); v[0][i] = (unsigned)(R * 128 + C) * 2u; v[1][i] = v[0][i] + (unsigned)(128 * 128 * 2); }
        }
    }
};
typedef ExpertSched<2, true> Gemm1Sched;
typedef ExpertSched<4, false> Gemm2Sched;

template <bool F8_> struct EpiBf16T {
    static constexpr bool F8 = F8_; static constexpr int SC_W = SC_W1, SC_X = SC_N2;
    static constexpr bool COL16 = false;
    bf16_t* O; int ldc;
    __device__ __forceinline__ void operator()(const f32x4 (&acc)[2][2][4][2], const Unit& u, int wr, int wc, int fr, int fq) const {
        const int row0 = u.t * 256 + wr * 64 + fr, col0 = u.nt * 256 + wc * 32 + 8 * fq;
#pragma unroll
        for (int ai = 0; ai < 2; ++ai)
#pragma unroll
            for (int m = 0; m < 4; ++m) { bf16_t* rowp = O + (size_t)(row0 + ai * 128 + m * 16) * ldc + col0;
#pragma unroll
                for (int bj = 0; bj < 2; ++bj) { const f32x4 v0 = acc[ai][bj][m][0], v1 = acc[ai][bj][m][1];
                    u32x4 w; w.x = cvt_pk_bf16(v0[0], v0[1]); w.y = cvt_pk_bf16(v0[2], v0[3]); w.z = cvt_pk_bf16(v1[0], v1[1]); w.w = cvt_pk_bf16(v1[2], v1[3]);
                    *(u32x4*)(rowp + bj * 128) = w; } }
    }
};
struct EpiResH {
    static constexpr bool F8 = true; static constexpr int SC_W = SC_W1, SC_X = SC_N2;
    static constexpr bool COL16 = false;
    const float* x; const float* gate; float* out; unsigned char* ws;
    __device__ __forceinline__ void operator()(const f32x4 (&acc)[2][2][4][2], const Unit& u, int wr, int wc, int fr, int fq) const {
        const int row0 = u.t * 256 + wr * 64 + fr, col0 = u.nt * 256 + wc * 32 + 8 * fq;
        const int b = (u.t * 256) / SEQ;
        f32x4 g[2][2];
#pragma unroll
        for (int bj = 0; bj < 2; ++bj)
#pragma unroll
            for (int n = 0; n < 2; ++n) g[bj][n] = *(const f32x4*)(gate + (size_t)b * 6144 + col0 + bj * 128 + 4 * n);
        bf16_t* hb = h_row(out, ws, u.t * 256) + (size_t)(wr * 64 + fr) * D + col0;
#pragma unroll
        for (int ai = 0; ai < 2; ++ai)
#pragma unroll
            for (int mh = 0; mh < 2; ++mh) {
                f32x4 xv[2][2][2];
#pragma unroll
                for (int m2 = 0; m2 < 2; ++m2) { const size_t off = (size_t)(row0 + ai * 128 + (2 * mh + m2) * 16) * D + col0;
#pragma unroll
                    for (int bj = 0; bj < 2; ++bj) { xv[m2][bj][0] = __builtin_nontemporal_load((const f32x4*)(x + off + bj * 128)); xv[m2][bj][1] = __builtin_nontemporal_load((const f32x4*)(x + off + bj * 128 + 4)); } }
#pragma unroll
                for (int m2 = 0; m2 < 2; ++m2) { const int m = 2 * mh + m2;
#pragma unroll
                    for (int bj = 0; bj < 2; ++bj) {
                        const f32x4 h0 = xv[m2][bj][0] + g[bj][0] * acc[ai][bj][m][0], h1 = xv[m2][bj][1] + g[bj][1] * acc[ai][bj][m][1];
                        u32x4 w; w.x = cvt_pk_bf16(h0[0], h0[1]); w.y = cvt_pk_bf16(h0[2], h0[3]); w.z = cvt_pk_bf16(h1[0], h1[1]); w.w = cvt_pk_bf16(h1[2], h1[3]);
                        *(u32x4*)(hb + (size_t)(ai * 128 + m * 16) * D + bj * 128) = w; } } }
    }
};
struct EpiF32 {
    static constexpr bool F8 = false; static constexpr int SC_W = 0, SC_X = 0;
    static constexpr bool COL16 = false;
    float* O; int ldc;
    __device__ __forceinline__ void operator()(const f32x4 (&acc)[2][2][4][2], const Unit& u, int wr, int wc, int fr, int fq) const {
        const int row0 = u.t * 256 + wr * 64 + fr, col0 = u.nt * 256 + wc * 32 + 8 * fq;
#pragma unroll
        for (int ai = 0; ai < 2; ++ai)
#pragma unroll
            for (int m = 0; m < 4; ++m) { float* rowp = O + (size_t)(row0 + ai * 128 + m * 16) * ldc + col0;
#pragma unroll
                for (int bj = 0; bj < 2; ++bj)
#pragma unroll
                    for (int n = 0; n < 2; ++n) *(f32x4*)(rowp + bj * 128 + 4 * n) = acc[ai][bj][m][n]; }
    }
};
struct EpiAct {
    static constexpr bool F8 = true; static constexpr int SC_W = SC_W1, SC_X = SC_N2;
    static constexpr bool COL16 = false;
    unsigned char* act;
    __device__ __forceinline__ void operator()(const f32x4 (&acc)[2][2][4][2], const Unit& u, int wr, int wc, int fr, int fq) const {
        const int col0 = u.nt * 128 + wc * 32 + 8 * fq;
#pragma unroll
        for (int ai = 0; ai < 2; ++ai)
#pragma unroll
            for (int m = 0; m < 4; ++m) { const int rl = ai * 128 + wr * 64 + m * 16 + fr;
                f32x4 ov[2];
#pragma unroll
                for (int n = 0; n < 2; ++n) { const f32x4 g = acc[ai][0][m][n], gu = g * acc[ai][1][m][n];
                    f32x4 d; d.x = fast_exp2(g.x); d.y = fast_exp2(g.y); d.z = fast_exp2(g.z); d.w = fast_exp2(g.w);
                    d = d + 1.f;
                    f32x4 r; r.x = fast_rcp(d.x); r.y = fast_rcp(d.y); r.z = fast_rcp(d.z); r.w = fast_rcp(d.w);
                    ov[n] = gu * r; }
#pragma unroll
                for (int j = 0; j < 4; ++j) { ov[0][j] = __builtin_amdgcn_fmed3f(ov[0][j], -448.f, 448.f); ov[1][j] = __builtin_amdgcn_fmed3f(ov[1][j], -448.f, 448.f); }
                int w0 = __builtin_amdgcn_cvt_pk_fp8_f32(ov[0].x, ov[0].y, 0, false); w0 = __builtin_amdgcn_cvt_pk_fp8_f32(ov[0].z, ov[0].w, w0, true);
                int w1 = __builtin_amdgcn_cvt_pk_fp8_f32(ov[1].x, ov[1].y, 0, false); w1 = __builtin_amdgcn_cvt_pk_fp8_f32(ov[1].z, ov[1].w, w1, true);
                u32x2 w; w.x = (unsigned)w0; w.y = (unsigned)w1;
                if (rl < u.nv) *(u32x2*)(act + (size_t)(u.row0 + rl) * EDIM + col0) = w; }
    }
};
struct EpiDown {
    static constexpr bool F8 = true; static constexpr int SC_W = SC_W2, SC_X = SC_ACT;
    static constexpr bool COL16 = true;
    unsigned char* Y; LAS unsigned char* lds; int nost;
    __device__ __forceinline__ u32x4 pack(const f32x4 (&acc)[2][2][4][2], int ai, int m) const {
        u32x4 w;
#pragma unroll
        for (int bj = 0; bj < 2; ++bj) {
            f32x4 v0 = acc[ai][bj][m][0], v1 = acc[ai][bj][m][1];
#pragma unroll
            for (int j = 0; j < 4; ++j) { v0[j] = fminf(fmaxf(v0[j], -448.f), 448.f); v1[j] = fminf(fmaxf(v1[j], -448.f), 448.f); }
            int w0 = __builtin_amdgcn_cvt_pk_fp8_f32(v0[0], v0[1], 0, false); w0 = __builtin_amdgcn_cvt_pk_fp8_f32(v0[2], v0[3], w0, true);
            int w1 = __builtin_amdgcn_cvt_pk_fp8_f32(v1[0], v1[1], 0, false); w1 = __builtin_amdgcn_cvt_pk_fp8_f32(v1[2], v1[3], w1, true);
            if (bj == 0) { w.x = (unsigned)w0; w.y = (unsigned)w1; } else { w.z = (unsigned)w0; w.w = (unsigned)w1; } }
        return w;
    }
    __device__ __forceinline__ void operator()(const f32x4 (&acc)[2][2][4][2], const Unit& u, int wr, int wc, int fr, int fq) const {
        const int lane = fq * 16 + fr, wv = wr * 4 + wc;
        constexpr int B0 = 3 * pg8::HTB, B1 = UT_TOK;
        const int wofs = (32 * wr + fr) * 256 + (((4 * wc + fq) ^ fr) << 4);
        const int rr0 = 8 * wv + (lane >> 4);
        const int rofs = rr0 * 256 + (((lane & 15) ^ (rr0 & 15)) << 4), rofs4 = (rr0 + 4) * 256 + (((lane & 15) ^ ((rr0 + 4) & 15)) << 4);
        const int t0 = 64 * (rr0 >> 5) + 16 * ((rr0 >> 4) & 1) + (rr0 & 15);
        unsigned char* yp = Y + (size_t)u.row0 * D + u.nt * 256 + 16 * (lane & 15);
        { const u32x4 wa = pack(acc, 0, 0), wb = pack(acc, 0, 1); *(LAS u32x4*)(lds + B0 + wofs) = wa; *(LAS u32x4*)(lds + B0 + wofs + 16 * 256) = wb; }
#pragma unroll
        for (int sl = 0; sl < 4; ++sl) { const int ai = sl >> 1, mh = sl & 1;
            asm volatile("s_waitcnt lgkmcnt(0)" ::: "memory"); __builtin_amdgcn_s_barrier();
            const int rb = (sl & 1) ? B1 : B0, wb_ = (sl & 1) ? B0 : B1;
            const u32x4 v0 = *(const LAS u32x4*)(lds + rb + rofs), v1 = *(const LAS u32x4*)(lds + rb + rofs4);
            if (sl < 3) { const int a2 = (sl + 1) >> 1, m2 = ((sl + 1) & 1) * 2;
                const u32x4 wa = pack(acc, a2, m2), wb = pack(acc, a2, m2 + 1); *(LAS u32x4*)(lds + wb_ + wofs) = wa; *(LAS u32x4*)(lds + wb_ + wofs + 16 * 256) = wb; }
            const int rl = ai * 128 + mh * 32 + t0;
            if (!nost) { if (rl < u.nv) __builtin_nontemporal_store(v0, (u32x4*)(yp + (size_t)rl * D)); if (rl + 4 < u.nv) __builtin_nontemporal_store(v1, (u32x4*)(yp + (size_t)(rl + 4) * D)); } }
    }
};

__device__ __forceinline__ void lds_barrier() { asm volatile("s_waitcnt lgkmcnt(0)\n\ts_barrier" ::: "memory"); }

struct Frame {
    LAS unsigned char* lds; int tid, lane, wave, G, vcu;
    const CAS Args* a;
};
__device__ __forceinline__ Frame make_frame(LAS unsigned char* lds) {
    Frame F; F.lds = lds;
    int t = threadIdx.x; asm volatile("" : "+v"(t));
    F.tid = t; F.lane = t & 63; F.wave = __builtin_amdgcn_readfirstlane(t >> 6);
    const CAS Args* a = (const CAS Args*)__builtin_amdgcn_kernarg_segment_ptr(); asm volatile("" : "+s"(a)); F.a = a;
    F.G = gridDim.x; { const int bx = blockIdx.x; F.vcu = (F.G % 8 == 0) ? (bx % 8) * (F.G / 8) + bx / 8 : bx; }
    return F;
}
#define WSP(F, off, T) ((T*)((F).a->ws + (off)))

__device__ __forceinline__ void phase_mod(Frame& F) {
    LAS float* cond = (LAS float*)F.lds;
    LAS float* red = (LAS float*)(F.lds + 65536);
    const float* c = F.a->in[I_C]; const float* wada = F.a->in[I_WADA]; const float* bada = F.a->in[I_BADA];
    float* mod = WSP(F, WS_MOD, float);
    { f32x4 cv[8];
#pragma unroll
      for (int u = 0; u < 8; ++u) cv[u] = *(const f32x4*)(c + 4 * (F.tid + u * NTHR));
#pragma unroll
      for (int u = 0; u < 8; ++u) { f32x4 o; o.x = silu_f(cv[u].x); o.y = silu_f(cv[u].y); o.z = silu_f(cv[u].z); o.w = silu_f(cv[u].w); *(LAS f32x4*)(cond + 4 * (F.tid + u * NTHR)) = o; } }
    __syncthreads();
    const int jj = F.tid & 31, ks = F.tid >> 5;
    for (int cb = blockIdx.x; cb < 256; cb += F.G) {
        const int j0 = cb * 24;
        float acc[16];
#pragma unroll
        for (int b = 0; b < 16; ++b) acc[b] = 0.f;
        if (jj < 24) {
#pragma unroll 1
            for (int k0 = ks * 64; k0 < ks * 64 + 64; k0 += 32) {
                float wv[32];
#pragma unroll
                for (int u = 0; u < 32; ++u) wv[u] = __builtin_nontemporal_load(wada + (size_t)(k0 + u) * 6144 + j0 + jj);
#pragma unroll
                for (int u = 0; u < 32; ++u)
#pragma unroll
                    for (int b = 0; b < 16; ++b) acc[b] += cond[b * 1024 + k0 + u] * wv[u];
            }
        }
#pragma unroll
        for (int b = 0; b < 16; ++b) red[(ks * 16 + b) * 32 + jj] = acc[b];
        __syncthreads();
        if (F.tid < 16 * 24) { const int b = F.tid / 24, j = F.tid % 24; float s = 0.f;
            for (int k2 = 0; k2 < 16; ++k2) s += red[(k2 * 16 + b) * 32 + j];
            mod[b * 6144 + j0 + j] = s + bada[j0 + j]; }
        __syncthreads();
    }
    const float* wsp = F.a->in[I_WSP]; bf16_t* o = WSP(F, WS_WSP, bf16_t);
    for (int i = blockIdx.x * NTHR + F.tid; i < 4 * 128 * 128; i += F.G * NTHR) { const int s = i & 127, t = (i >> 7) & 127; o[i] = (bf16_t)(cvt_pk_bf16(s <= t ? wsp[i] : 0.f, 0.f) & 0xffffu); }
}

struct TItem { const float* W; bf16_t* WT; int K, N, gmode, item; float scale; bool f8; };
__device__ __forceinline__ void titem_issue(const TItem& t, int lane, LAS unsigned char* buf) {
    const int nblk = t.N / 32, kb = t.item / nblk, nb = t.item % nblk, k0 = 64 * kb, n0 = 32 * nb;
#pragma unroll
    for (int j = 0; j < 8; ++j) { const float* g = t.W + (size_t)(k0 + 8 * j + (lane >> 3)) * t.N + n0 + 4 * ((lane & 7) ^ j);
        __builtin_amdgcn_global_load_lds((const unsigned*)g, (LAS unsigned*)(buf + j * 1024), 16, 0, 2); }
}
__device__ __forceinline__ void titem_finish(const TItem& t, int lane, const LAS unsigned char* buf) {
    const int nblk = t.N / 32, kb = t.item / nblk, nb = t.item % nblk, k0 = 64 * kb, n0 = 32 * nb;
    const int d0 = t.gmode == 0 ? n0 : ((n0 >> 7) * 256 + (n0 & 127) + (t.gmode == 2 ? 128 : 0));
    const int c = lane & 7;
    const LAS float* sb = (const LAS float*)buf;
    float v[4][8];
    const float wsc = t.scale;
#pragma unroll
    for (int j = 0; j < 4; ++j) { const int n = (lane >> 3) + 8 * j; const LAS float* s = sb + (8 * c) * 32 + 4 * ((n >> 2) ^ c) + (n & 3);
#pragma unroll
        for (int q = 0; q < 8; ++q) v[j][q] = s[32 * q] * wsc; }
    if (t.f8) {
#pragma unroll
        for (int j = 0; j < 4; ++j) { const int n = (lane >> 3) + 8 * j;
            int w0 = __builtin_amdgcn_cvt_pk_fp8_f32(v[j][0], v[j][1], 0, false); w0 = __builtin_amdgcn_cvt_pk_fp8_f32(v[j][2], v[j][3], w0, true);
            int w1 = __builtin_amdgcn_cvt_pk_fp8_f32(v[j][4], v[j][5], 0, false); w1 = __builtin_amdgcn_cvt_pk_fp8_f32(v[j][6], v[j][7], w1, true);
            u32x2 o; o.x = (unsigned)w0; o.y = (unsigned)w1;
            __builtin_nontemporal_store(o, (u32x2*)((unsigned char*)t.WT + (size_t)(d0 + n) * t.K + k0 + 8 * c)); }
    } else {
#pragma unroll
        for (int j = 0; j < 4; ++j) { const int n = (lane >> 3) + 8 * j;
            u32x4 o; o.x = cvt_pk_bf16(v[j][0], v[j][1]); o.y = cvt_pk_bf16(v[j][2], v[j][3]); o.z = cvt_pk_bf16(v[j][4], v[j][5]); o.w = cvt_pk_bf16(v[j][6], v[j][7]);
            __builtin_nontemporal_store(o, (u32x4*)(t.WT + (size_t)(d0 + n) * t.K + k0 + 8 * c)); }
    }
}
typedef float f32x2v __attribute__((ext_vector_type(2)));
template <bool HB>
__device__ __forceinline__ void norm_mod_row2(const void* x0, const void* x1, const float* g, const float* sh0, const float* sc0, const float* sh1, const float* sc1, bf16_t* o0, bf16_t* o1, int lane) {
    f32x4 v0[4], v1[4]; float s0 = 0.f, s1 = 0.f;
#pragma unroll
    for (int j = 0; j < 4; ++j) {
        if (HB) { const u32x2 a = *(const u32x2*)((const bf16_t*)x0 + 4 * lane + 256 * j), b = *(const u32x2*)((const bf16_t*)x1 + 4 * lane + 256 * j);
            v0[j] = (f32x4){bflo(a.x), bfhi(a.x), bflo(a.y), bfhi(a.y)}; v1[j] = (f32x4){bflo(b.x), bfhi(b.x), bflo(b.y), bfhi(b.y)}; }
        else { v0[j] = *(const f32x4*)((const float*)x0 + 4 * lane + 256 * j); v1[j] = *(const f32x4*)((const float*)x1 + 4 * lane + 256 * j); } }
#pragma unroll
    for (int j = 0; j < 4; ++j) { s0 += (v0[j].x * v0[j].x + v0[j].y * v0[j].y) + (v0[j].z * v0[j].z + v0[j].w * v0[j].w);
                                  s1 += (v1[j].x * v1[j].x + v1[j].y * v1[j].y) + (v1[j].z * v1[j].z + v1[j].w * v1[j].w); }
    s0 = wave_sum(s0); s1 = wave_sum(s1);
    const float r0 = 1.f / sqrtf(s0 * (1.f / D) + EPS), r1 = 1.f / sqrtf(s1 * (1.f / D) + EPS);
#pragma unroll
    for (int j = 0; j < 4; ++j) { const int c0 = 4 * lane + 256 * j;
        const f32x4 gg = *(const f32x4*)(g + c0);
        const f32x4 y0 = v0[j] * r0 * gg * (*(const f32x4*)(sc0 + c0) + 1.f) + *(const f32x4*)(sh0 + c0);
        const f32x4 y1 = v1[j] * r1 * gg * (*(const f32x4*)(sc1 + c0) + 1.f) + *(const f32x4*)(sh1 + c0);
        u32x2 w0, w1; w0.x = cvt_pk_bf16(y0.x, y0.y); w0.y = cvt_pk_bf16(y0.z, y0.w); w1.x = cvt_pk_bf16(y1.x, y1.y); w1.y = cvt_pk_bf16(y1.z, y1.w);
        *(u32x2*)(o0 + c0) = w0; *(u32x2*)(o1 + c0) = w1; }
}
template <int NR, bool HB>
__device__ __forceinline__ void norm_mod_rows(const void* x, size_t xstride, const float* g, const float* sh, const float* sc, bf16_t* o, size_t ostride, int lane, unsigned char* o8 = nullptr) {
    f32x4 v[NR][4]; float ss[NR];
    f32x4 gq[4], sq4[4], hq[4];
#pragma unroll
    for (int j = 0; j < 4; ++j) { const int c0 = 4 * lane + 256 * j; gq[j] = *(const f32x4*)(g + c0); sq4[j] = *(const f32x4*)(sc + c0); hq[j] = *(const f32x4*)(sh + c0); }
    if constexpr (HB) {
        u32x2 raw[NR][4];
#pragma unroll
        for (int r = 0; r < NR; ++r)
#pragma unroll
            for (int j = 0; j < 4; ++j) raw[r][j] = __builtin_nontemporal_load((const u32x2*)((const bf16_t*)x + r * xstride + 4 * lane + 256 * j));
#pragma unroll
        for (int r = 0; r < NR; ++r)
#pragma unroll
            for (int j = 0; j < 4; ++j) v[r][j] = (f32x4){bflo(raw[r][j].x), bfhi(raw[r][j].x), bflo(raw[r][j].y), bfhi(raw[r][j].y)};
    } else {
#pragma unroll
        for (int r = 0; r < NR; ++r)
#pragma unroll
            for (int j = 0; j < 4; ++j) v[r][j] = __builtin_nontemporal_load((const f32x4*)((const float*)x + r * xstride + 4 * lane + 256 * j));
    }
#pragma unroll
    for (int r = 0; r < NR; ++r) { float s0 = 0.f;
#pragma unroll
        for (int j = 0; j < 4; ++j) s0 += (v[r][j].x * v[r][j].x + v[r][j].y * v[r][j].y) + (v[r][j].z * v[r][j].z + v[r][j].w * v[r][j].w);
        ss[r] = 1.f / sqrtf(wave_sum(s0) * (1.f / D) + EPS); }
#pragma unroll
    for (int j = 0; j < 4; ++j) { const int c0 = 4 * lane + 256 * j;
        const f32x4 gg = gq[j] * (sq4[j] + 1.f), hh = hq[j];
#pragma unroll
        for (int r = 0; r < NR; ++r) { const f32x4 y = v[r][j] * ss[r] * gg + hh;
            if (o) { u32x2 w; w.x = cvt_pk_bf16(y.x, y.y); w.y = cvt_pk_bf16(y.z, y.w); *(u32x2*)(o + r * ostride + c0) = w; }
            if (o8) { const f32x4 yc = {__builtin_amdgcn_fmed3f(y.x, -448.f, 448.f), __builtin_amdgcn_fmed3f(y.y, -448.f, 448.f), __builtin_amdgcn_fmed3f(y.z, -448.f, 448.f), __builtin_amdgcn_fmed3f(y.w, -448.f, 448.f)};
                      int q = __builtin_amdgcn_cvt_pk_fp8_f32(yc.x, yc.y, 0, false); q = __builtin_amdgcn_cvt_pk_fp8_f32(yc.z, yc.w, q, true); *(int*)(o8 + r * ostride + c0) = q; } } }
}
__device__ __forceinline__ void phase_prep(Frame& F) {
    const int gw = F.vcu * 8 + F.wave, NGW = F.G * 8;
    const float* mod = WSP(F, WS_MOD, float); bf16_t* nbuf = WSP(F, WS_A, bf16_t);
    for (int m = gw * 4; m < NTOK; m += 4 * NGW) { const int b = m / SEQ;
        norm_mod_rows<4, false>(F.a->in[I_X] + (size_t)m * D, D, F.a->in[I_GMIX], mod + b * 6144, mod + b * 6144 + 1024, nullptr, D, F.lane, (unsigned char*)nbuf + (size_t)m * D); }
    LAS unsigned char* scr = F.lds + F.wave * 16384;
    constexpr int IT_IN = 16 * 80, IT_OUT = 16 * 32, IT_R = 16 * 8;
    constexpr int NITEMS = IT_IN + IT_OUT + IT_R;
    for (int it = gw; it < NITEMS; it += NGW) {
        int r = it; TItem t;
        if (r < IT_IN) t = TItem{F.a->in[I_WIN], WSP(F, WS_WTIN, bf16_t), 1024, 2560, 0, r, W1_PRE, true};
        else if (r < IT_IN + IT_OUT) t = TItem{F.a->in[I_WOUT], WSP(F, WS_WTOUT, bf16_t), 1024, 1024, 0, r - IT_IN, W1_PRE, true};
        else t = TItem{F.a->in[I_WR], WSP(F, WS_WTR, bf16_t), 1024, 256, 0, r - IT_IN - IT_OUT, 1.f, false};
        titem_issue(t, F.lane, scr); asm volatile("s_waitcnt vmcnt(0)" ::: "memory"); titem_finish(t, F.lane, scr); asm volatile("s_waitcnt lgkmcnt(0)" ::: "memory");
    }
}
constexpr int CONV_ITEMS = 257 * 3 * 128;
__device__ __forceinline__ void convert_experts(Frame& F, int lo, int hi) {
    const int gw = F.vcu * 8 + F.wave, NGW = F.G * 8;
    LAS unsigned char* scr = F.lds + F.wave * 16384;
    unsigned char* W1t = WSP(F, WS_W1T, unsigned char); unsigned char* W2t = WSP(F, WS_W2T, unsigned char);
    const float* weg = F.a->in[I_WEG]; const float* weu = F.a->in[I_WEU]; const float* wed = F.a->in[I_WED];
    const float* wsg = F.a->in[I_WSG]; const float* wsu = F.a->in[I_WSU]; const float* wsd = F.a->in[I_WSD];
#define CONV_DESC(r, t) do { const int e_ = (r) / 384, w_ = ((r) >> 7) % 3; (t).item = (r) & 127; (t).f8 = true; (t).scale = w_ == 2 ? YSCALE * W2_PRE : (w_ == 0 ? -LOG2E * W1_PRE : -W1_PRE * ACT_PRE / LOG2E); (t).gmode = w_ == 2 ? 0 : w_ + 1; (t).K = w_ == 2 ? 256 : 1024; (t).N = w_ == 2 ? 1024 : 256; \
        (t).W = w_ == 0 ? (e_ < NE ? weg + (size_t)e_ * 262144 : wsg) : w_ == 1 ? (e_ < NE ? weu + (size_t)e_ * 262144 : wsu) : (e_ < NE ? wed + (size_t)e_ * 262144 : wsd); \
        (t).WT = (bf16_t*)(w_ == 2 ? W2t + (size_t)e_ * 262144 : W1t + (size_t)e_ * 524288); } while (0)
    constexpr int NPAIRS = CONV_ITEMS / 2;
    (void)lo; (void)hi;
#define CONV_RIDX(s_) ({ const int P_ = gw + ((s_) >> 1) * NGW, mi_ = P_ >> 6, pp_ = P_ & 63, nb_ = (mi_ % 3) == 2 ? 32 : 8; mi_ * 128 + (2 * (pp_ / nb_) + ((s_) & 1)) * nb_ + (pp_ % nb_); })
    if (gw < NPAIRS) {
        const int ns = 2 * ((NPAIRS - gw + NGW - 1) / NGW);
        int sq = 0, r = CONV_RIDX(0);
        TItem tc, tn; CONV_DESC(r, tc); tn = tc;
        int p = 0; bool first = true;
        titem_issue(tc, F.lane, scr);
        for (;;) {
            const bool more = sq + 1 < ns; const int rn = more ? CONV_RIDX(sq + 1) : r;
            if (more) { CONV_DESC(rn, tn); titem_issue(tn, F.lane, scr + (p ^ 1) * 8192); }
            if (!more) asm volatile("s_waitcnt vmcnt(0)" ::: "memory");
            else if (first) asm volatile("s_waitcnt vmcnt(8)" ::: "memory");
            else asm volatile("s_waitcnt vmcnt(12)" ::: "memory");
            titem_finish(tc, F.lane, scr + p * 8192);
            asm volatile("s_waitcnt lgkmcnt(0)" ::: "memory");
            if (!more) break;
            tc = tn; r = rn; ++sq; p ^= 1; first = false;
        }
    }
#undef CONV_RIDX
#undef CONV_DESC
    __syncthreads();
}

__device__ __forceinline__ s16x4 tr_read(LAS unsigned char* p) { return __builtin_bit_cast(s16x4, __builtin_amdgcn_ds_read_tr16_b64_v4i16((LAS s16x4*)p)); }
constexpr int ATT_ROWB = 144;
constexpr int ATT_VOFF = 256 * ATT_ROWB;
struct AttnUnit { int b, h, d, dsel, r, n; };
__device__ __forceinline__ AttnUnit attn_decode(int j) {
    AttnUnit u; const int bh = j / 96, rest = j % 96; u.b = bh >> 3; u.h = bh & 7;
    u.dsel = (rest >= 32 ? 1 : 0) + (rest >= 64 ? 1 : 0);
    const int x = rest - 32 * u.dsel, sh = 5 - 2 * u.dsel;
    u.d = 1 << (2 * u.dsel); u.r = x >> sh; u.n = x & ((1 << sh) - 1);
    return u;
}
__device__ __forceinline__ void attn_issue(const bf16_t* qkv, const AttnUnit& u, int tid, u32x4 (&kr)[4], u32x4 (&vr)[4]) {
    const char* base = (const char*)qkv + (((size_t)u.b * SEQ + u.r) * NPROJ + 512 + u.h * 64) * 2;
    const unsigned rs = (unsigned)u.d * (NPROJ * 2);
    const int i0 = 128 * (u.n - 1) + (tid >> 3); const unsigned cb = (unsigned)(tid & 7) * 16u;
#pragma unroll
    for (int jj = 0; jj < 4; ++jj) { int i = i0 + 64 * jj; i = i < 0 ? 0 : i;
        const unsigned off = __umul24((unsigned)i, rs) + cb;
        kr[jj] = *(const u32x4*)(base + off); vr[jj] = *(const u32x4*)(base + off + 1024); }
}
__device__ __forceinline__ void phase_attn(Frame& F) {
    const bf16_t* qkv = WSP(F, WS_B, bf16_t);
    bf16_t* part = (bf16_t*)F.a->out;
    float* lse = WSP(F, WS_LSE, float);
    const int tid = F.tid, w = F.wave, lane = F.lane, fr = lane & 15, fq = lane >> 4;
    const int x8 = blockIdx.x & 7, r8 = blockIdx.x >> 3, G8 = F.G >> 3;
    constexpr int PER_X = 16 * 96;
    constexpr int ABUF = 2 * ATT_VOFF;
    float ef[4];
#pragma unroll
    for (int rg = 0; rg < 4; ++rg) ef[rg] = (float)(fr - 4 * fq - rg);
    const int ql = 16 * w + fr;
    u32x4 kr[4], vr[4];
    AttnUnit un;
    bf16x8 qn0, qn1;
    int jl = r8;
    if (jl >= PER_X) return;
    AttnUnit cu = attn_decode(x8 * PER_X + jl);
    attn_issue(qkv, cu, tid, kr, vr);
    { const char* qb = (const char*)qkv + (((size_t)cu.b * SEQ + cu.r) * NPROJ + cu.h * 64) * 2; const unsigned qo = __umul24((unsigned)(128 * cu.n + ql), (unsigned)cu.d * (NPROJ * 2)) + 16u * fq;
      qn0 = *(const bf16x8*)(qb + qo); qn1 = *(const bf16x8*)(qb + qo + 64); }
#pragma unroll
    for (int jj = 0; jj < 4; ++jj) { const int ch = tid + 512 * jj, row = ch >> 3, c16 = ch & 7;
        *(LAS u32x4*)(F.lds + row * ATT_ROWB + c16 * 16) = kr[jj]; *(LAS u32x4*)(F.lds + ATT_VOFF + row * ATT_ROWB + c16 * 16) = vr[jj]; }
    const int jlast = r8 + G8 * ((PER_X - 1 - r8) / G8);
    un = attn_decode(x8 * PER_X + (jl + G8 < jlast ? jl + G8 : jlast)); attn_issue(qkv, un, tid, kr, vr);
    int buf = 0;
    for (; jl < PER_X; jl += G8) {
        lds_barrier();
        LAS unsigned char* kb = F.lds + buf * ABUF;
        const bf16x8 q0 = qn0, q1 = qn1;
        {
            LAS unsigned char* ob = F.lds + (buf ^ 1) * ABUF;
#pragma unroll
            for (int jj = 0; jj < 4; ++jj) { const int ch = tid + 512 * jj, row = ch >> 3, c16 = ch & 7;
                *(LAS u32x4*)(ob + row * ATT_ROWB + c16 * 16) = kr[jj]; *(LAS u32x4*)(ob + ATT_VOFF + row * ATT_ROWB + c16 * 16) = vr[jj]; }
        }
        const AttnUnit nu = un;
        un = attn_decode(x8 * PER_X + (jl + 2 * G8 < jlast ? jl + 2 * G8 : jlast)); attn_issue(qkv, un, tid, kr, vr);
        { const char* qb = (const char*)qkv + (((size_t)nu.b * SEQ + nu.r) * NPROJ + nu.h * 64) * 2; const unsigned qo = __umul24((unsigned)(128 * nu.n + ql), (unsigned)nu.d * (NPROJ * 2)) + 16u * fq;
          qn0 = *(const bf16x8*)(qb + qo); qn1 = *(const bf16x8*)(qb + qo + 64); }
        const unsigned qrow = __umul24((unsigned)(128 * cu.n + ql), (unsigned)cu.d);
        const float c1 = 0.125f * LOG2E;
        const float nc2 = -__builtin_amdgcn_exp2f(-(float)(cu.h + 1)) * (float)cu.d * LOG2E;
        const bool first = cu.n == 0;
        f32x4 St[9];
        const f32x4 eb = (f32x4){ef[0], ef[1], ef[2], ef[3]} * nc2;
        float mx = -INFINITY;
        bf16x8 kf[9][2];
#pragma unroll
        for (int T = 0; T < 9; ++T) { LAS unsigned char* ka = kb + (16 * (w + T) + fr) * ATT_ROWB + fq * 16; kf[T][0] = *(LAS bf16x8*)ka; kf[T][1] = *(LAS bf16x8*)(ka + 64); }
        __builtin_amdgcn_sched_barrier(0);
#pragma unroll
        for (int T = 0; T < 9; ++T) {
            f32x4 sa = (f32x4){0.f, 0.f, 0.f, 0.f};
            sa = __builtin_amdgcn_mfma_f32_16x16x32_bf16(kf[T][0], q0, sa, 0, 0, 0);
            sa = __builtin_amdgcn_mfma_f32_16x16x32_bf16(kf[T][1], q1, sa, 0, 0, 0);
            const float kT = (!first || w + T >= 8) ? nc2 * (float)(128 - 16 * T) : -INFINITY;
            sa = sa * c1 + (eb + kT);
#pragma unroll
            for (int rg = 0; rg < 4; ++rg) {
                if (T == 0) sa[rg] = ef[rg] <= 0.f ? sa[rg] : -INFINITY;
                if (T == 8) sa[rg] = ef[rg] >= 0.f ? sa[rg] : -INFINITY;
            }
            St[T] = sa;
            mx = fmaxf(mx, fmaxf(fmaxf(sa[0], sa[1]), fmaxf(sa[2], sa[3])));
        }
        mx = fmaxf(mx, __shfl_xor(mx, 16)); mx = fmaxf(mx, __shfl_xor(mx, 32));
        f32x4 lv = (f32x4){0.f, 0.f, 0.f, 0.f};
        f32x4 nmx = (f32x4){-mx, -mx, -mx, -mx}; asm volatile("" : "+v"(nmx));
#pragma unroll
        for (int T = 0; T < 9; ++T) { const f32x4 d = St[T] + nmx; f32x4 pv; pv.x = fast_exp2(d.x); pv.y = fast_exp2(d.y); pv.z = fast_exp2(d.z); pv.w = fast_exp2(d.w); St[T] = pv; lv = lv + pv; }
        float l = (lv.x + lv.y) + (lv.z + lv.w);
        l += __shfl_xor(l, 16); l += __shfl_xor(l, 32);
        f32x4 O[4];
#pragma unroll
        for (int dt = 0; dt < 4; ++dt) O[dt] = (f32x4){0.f, 0.f, 0.f, 0.f};
#pragma unroll
        for (int T = 0; T < 9; ++T) {
            u32x2 pw; pw.x = cvt_pk_bf16(St[T][0], St[T][1]); pw.y = cvt_pk_bf16(St[T][2], St[T][3]);
            const s16x4 pb = __builtin_bit_cast(s16x4, pw);
            LAS unsigned char* va = kb + ATT_VOFF + (16 * (w + T) + 4 * fq + (fr >> 2)) * ATT_ROWB + (8 * (fr & 3)) * 2;
#pragma unroll
            for (int dt = 0; dt < 4; ++dt) O[dt] = __builtin_amdgcn_mfma_f32_16x16x16bf16_1k(tr_read(va + 64 * (dt >> 1) + 8 * (dt & 1)), pb, O[dt], 0, 0, 0);
        }
        const float inv = 1.f / l;
        bf16_t* op = (bf16_t*)((char*)part + (((size_t)cu.dsel * NTOK + (size_t)cu.b * SEQ + cu.r) * 512 + cu.h * 64) * 2 + (qrow * 1024u + 16u * fq));
#pragma unroll
        for (int u2 = 0; u2 < 2; ++u2) { u32x4 o4; o4.x = cvt_pk_bf16(O[2 * u2][0] * inv, O[2 * u2][1] * inv); o4.y = cvt_pk_bf16(O[2 * u2][2] * inv, O[2 * u2][3] * inv);
            o4.z = cvt_pk_bf16(O[2 * u2 + 1][0] * inv, O[2 * u2 + 1][1] * inv); o4.w = cvt_pk_bf16(O[2 * u2 + 1][2] * inv, O[2 * u2 + 1][3] * inv); *(u32x4*)(op + 32 * u2) = o4; }
        if (fq == 0) *(float*)((char*)lse + (((size_t)cu.dsel * NTOK + (size_t)cu.b * SEQ + cu.r) * 8 + cu.h) * 4 + qrow * 32u) = mx + __builtin_amdgcn_logf(l);
        cu = nu; buf ^= 1;
    }
    __syncthreads();
}

constexpr int SGU_ROWB = 1040;
__device__ __forceinline__ void phase_sgu(Frame& F) {
    const bf16_t* qkv = WSP(F, WS_B, bf16_t);
    bf16_t* sgu = (bf16_t*)F.a->out + (size_t)3 * NTOK * 512;
    const bf16_t* Wsp = WSP(F, WS_WSP, bf16_t);
    const float* lng = F.a->in[I_LNG]; const float* lnb = F.a->in[I_LNB]; const float* bsp = F.a->in[I_BSP];
    const int w = F.wave, lane = F.lane, fr = lane & 15, fq = lane >> 4;
    for (int un = blockIdx.x; un < NTOK / 128; un += F.G) {
        const size_t tok0 = (size_t)un * 128;
        lds_barrier();
        float g8[8], b8[8];
#pragma unroll
        for (int j = 0; j < 8; ++j) { g8[j] = lng[8 * lane + j]; b8[j] = lnb[8 * lane + j]; }
#pragma unroll 1
        for (int i0 = 0; i0 < 16; i0 += 8) {
        u32x4 zrv[8];
#pragma unroll
        for (int i = 0; i < 8; ++i) zrv[i] = __builtin_nontemporal_load((const u32x4*)(qkv + (tok0 + 16 * w + i0 + i) * NPROJ + 2048 + 8 * lane));
#pragma unroll
        for (int i = 0; i < 8; ++i) { const int s = 16 * w + i0 + i;
            const u32x4 zr = zrv[i];
            float z[8]; z[0] = bflo(zr.x); z[1] = bfhi(zr.x); z[2] = bflo(zr.y); z[3] = bfhi(zr.y); z[4] = bflo(zr.z); z[5] = bfhi(zr.z); z[6] = bflo(zr.w); z[7] = bfhi(zr.w);
            float sm = 0.f;
#pragma unroll
            for (int j = 0; j < 8; ++j) { z[j] = gelu_f(z[j]); sm += z[j]; }
            const float mean = wave_sum(sm) * (1.f / 512.f); float sq = 0.f;
#pragma unroll
            for (int j = 0; j < 8; ++j) { z[j] -= mean; sq += z[j] * z[j]; }
            const float rstd = 1.f / sqrtf(wave_sum(sq) * (1.f / 512.f) + EPS);
#pragma unroll
            for (int j = 0; j < 8; ++j) z[j] = z[j] * rstd * g8[j] + b8[j];
            u32x4 o; o.x = cvt_pk_bf16_a(z[0], z[1]); o.y = cvt_pk_bf16_a(z[2], z[3]); o.z = cvt_pk_bf16_a(z[4], z[5]); o.w = cvt_pk_bf16_a(z[6], z[7]);
            *(LAS u32x4*)(F.lds + s * SGU_ROWB + lane * 16) = o; }
        }
        lds_barrier();
        const int cw = 64 * w, g = w >> 1;
        f32x4 acc[4][8];
#pragma unroll
        for (int ct = 0; ct < 4; ++ct)
#pragma unroll
            for (int tt = 0; tt < 8; ++tt) acc[ct][tt] = (f32x4){0.f, 0.f, 0.f, 0.f};
#pragma unroll
        for (int ks = 0; ks < 4; ++ks) {
            bf16x8 af[4];
#pragma unroll
            for (int ct = 0; ct < 4; ++ct) {
                LAS unsigned char* pa = F.lds + (32 * ks + 8 * fq + (fr >> 2)) * SGU_ROWB + (cw + 32 * (ct >> 1) + 8 * (fr & 3) + 4 * (ct & 1)) * 2;
                const s16x4 lo = tr_read(pa), hi = tr_read(pa + 4 * SGU_ROWB);
                af[ct].s0 = lo.x; af[ct].s1 = lo.y; af[ct].s2 = lo.z; af[ct].s3 = lo.w; af[ct].s4 = hi.x; af[ct].s5 = hi.y; af[ct].s6 = hi.z; af[ct].s7 = hi.w;
            }
            bf16x8 bfr[8];
#pragma unroll
            for (int tt = 0; tt < 8; ++tt) if (16 * tt + 15 >= 32 * ks) bfr[tt] = *(const bf16x8*)(Wsp + ((size_t)(g * 128 + 16 * tt + fr) * 128 + 32 * ks + 8 * fq));
#pragma unroll
            for (int tt = 0; tt < 8; ++tt) {
                if (16 * tt + 15 < 32 * ks) continue;
#pragma unroll
                for (int ct = 0; ct < 4; ++ct) acc[ct][tt] = __builtin_amdgcn_mfma_f32_16x16x32_bf16(af[ct], bfr[tt], acc[ct][tt], 0, 0, 0);
            }
        }
        float bsv[8];
#pragma unroll
        for (int tt = 0; tt < 8; ++tt) bsv[tt] = bsp[g * 128 + 16 * tt + fr];
#pragma unroll
        for (int th = 0; th < 2; ++th) {
            u32x4 urv[4][2];
#pragma unroll
            for (int i = 0; i < 4; ++i)
#pragma unroll
                for (int cp = 0; cp < 2; ++cp) urv[i][cp] = __builtin_nontemporal_load((const u32x4*)(qkv + (tok0 + 16 * (4 * th + i) + fr) * NPROJ + 1536 + cw + 32 * cp + 8 * fq));
#pragma unroll
            for (int i = 0; i < 4; ++i) { const int tt = 4 * th + i, t = 16 * tt + fr; const float bs = bsv[tt];
#pragma unroll
                for (int cp = 0; cp < 2; ++cp) { const int c0 = cw + 32 * cp + 8 * fq;
                    const u32x4 ur = urv[i][cp];
                    u32x4 o;
                    o.x = cvt_pk_bf16_a(gelu_f(bflo(ur.x)) * (acc[2 * cp][tt][0] + bs), gelu_f(bfhi(ur.x)) * (acc[2 * cp][tt][1] + bs));
                    o.y = cvt_pk_bf16_a(gelu_f(bflo(ur.y)) * (acc[2 * cp][tt][2] + bs), gelu_f(bfhi(ur.y)) * (acc[2 * cp][tt][3] + bs));
                    o.z = cvt_pk_bf16_a(gelu_f(bflo(ur.z)) * (acc[2 * cp + 1][tt][0] + bs), gelu_f(bfhi(ur.z)) * (acc[2 * cp + 1][tt][1] + bs));
                    o.w = cvt_pk_bf16_a(gelu_f(bflo(ur.w)) * (acc[2 * cp + 1][tt][2] + bs), gelu_f(bfhi(ur.w)) * (acc[2 * cp + 1][tt][3] + bs));
                    *(u32x4*)(sgu + (tok0 + t) * 512 + c0) = o; } }
        }
    }
    __syncthreads();
}

__device__ __forceinline__ void phase_merge(Frame& F) {
    const bf16_t* part = (const bf16_t*)F.a->out; const bf16_t* sgu = part + (size_t)3 * NTOK * 512;
    const float* lse = WSP(F, WS_LSE, float); bf16_t* mixed = WSP(F, WS_A, bf16_t);
    const float* goa = F.a->in[I_GOA]; const float* gos = F.a->in[I_GOS];
    const int lane = F.lane, gw = F.vcu * 8 + F.wave, NGW = F.G * 8, h = lane >> 3;
    const f32x4 ga0 = *(const f32x4*)(goa + 8 * lane), ga1 = *(const f32x4*)(goa + 8 * lane + 4), gs0 = *(const f32x4*)(gos + 8 * lane), gs1 = *(const f32x4*)(gos + 8 * lane + 4);
    constexpr int NT = 2;
#pragma unroll 1
    for (int mb = gw; mb < NTOK; mb += NT * NGW) {
        float lv[NT][3]; u32x4 pv[NT][3], sr[NT];
#pragma unroll
        for (int t = 0; t < NT; ++t) { const int m = mb + t * NGW;
#pragma unroll
            for (int k = 0; k < 3; ++k) { lv[t][k] = lse[((size_t)k * NTOK + m) * 8 + h]; pv[t][k] = __builtin_nontemporal_load((const u32x4*)(part + ((size_t)k * NTOK + m) * 512 + 8 * lane)); }
            sr[t] = __builtin_nontemporal_load((const u32x4*)(sgu + (size_t)m * 512 + 8 * lane)); }
        float a[NT][8], sv[NT][8], sqa[NT], sqs[NT];
#pragma unroll
        for (int t = 0; t < NT; ++t) {
            const float mx = fmaxf(lv[t][0], fmaxf(lv[t][1], lv[t][2]));
            float w0 = fast_exp2(lv[t][0] - mx), w1 = fast_exp2(lv[t][1] - mx), w2 = fast_exp2(lv[t][2] - mx);
            const float iw = 1.f / (w0 + w1 + w2); w0 *= iw; w1 *= iw; w2 *= iw;
            sqa[t] = 0.f; sqs[t] = 0.f;
#pragma unroll
            for (int j = 0; j < 4; ++j) { a[t][2 * j] = w0 * bflo(pv[t][0][j]) + w1 * bflo(pv[t][1][j]) + w2 * bflo(pv[t][2][j]); a[t][2 * j + 1] = w0 * bfhi(pv[t][0][j]) + w1 * bfhi(pv[t][1][j]) + w2 * bfhi(pv[t][2][j]);
                sv[t][2 * j] = bflo(sr[t][j]); sv[t][2 * j + 1] = bfhi(sr[t][j]); }
#pragma unroll
            for (int j = 0; j < 8; ++j) { sqa[t] += a[t][j] * a[t][j]; sqs[t] += sv[t][j] * sv[t][j]; }
        }
#pragma unroll
        for (int t = 0; t < NT; ++t) { sqa[t] = wave_sum(sqa[t]); sqs[t] = wave_sum(sqs[t]); }
#pragma unroll
        for (int t = 0; t < NT; ++t) { const int m = mb + t * NGW;
            const float rsa = 1.f / sqrtf(sqa[t] * (1.f / 512.f) + EPS), rss = 1.f / sqrtf(sqs[t] * (1.f / 512.f) + EPS);
            float oa[8], os[8];
            oa[0] = a[t][0] * rsa * ga0.x; oa[1] = a[t][1] * rsa * ga0.y; oa[2] = a[t][2] * rsa * ga0.z; oa[3] = a[t][3] * rsa * ga0.w;
            oa[4] = a[t][4] * rsa * ga1.x; oa[5] = a[t][5] * rsa * ga1.y; oa[6] = a[t][6] * rsa * ga1.z; oa[7] = a[t][7] * rsa * ga1.w;
            os[0] = sv[t][0] * rss * gs0.x; os[1] = sv[t][1] * rss * gs0.y; os[2] = sv[t][2] * rss * gs0.z; os[3] = sv[t][3] * rss * gs0.w;
            os[4] = sv[t][4] * rss * gs1.x; os[5] = sv[t][5] * rss * gs1.y; os[6] = sv[t][6] * rss * gs1.z; os[7] = sv[t][7] * rss * gs1.w;
#pragma unroll
            for (int j = 0; j < 8; ++j) { oa[j] = fminf(fmaxf(oa[j], -448.f), 448.f); os[j] = fminf(fmaxf(os[j], -448.f), 448.f); }
            u32x2 wa, wsg;
            { int w0 = __builtin_amdgcn_cvt_pk_fp8_f32(oa[0], oa[1], 0, false); w0 = __builtin_amdgcn_cvt_pk_fp8_f32(oa[2], oa[3], w0, true);
              int w1 = __builtin_amdgcn_cvt_pk_fp8_f32(oa[4], oa[5], 0, false); w1 = __builtin_amdgcn_cvt_pk_fp8_f32(oa[6], oa[7], w1, true); wa.x = (unsigned)w0; wa.y = (unsigned)w1; }
            { int w0 = __builtin_amdgcn_cvt_pk_fp8_f32(os[0], os[1], 0, false); w0 = __builtin_amdgcn_cvt_pk_fp8_f32(os[2], os[3], w0, true);
              int w1 = __builtin_amdgcn_cvt_pk_fp8_f32(os[4], os[5], 0, false); w1 = __builtin_amdgcn_cvt_pk_fp8_f32(os[6], os[7], w1, true); wsg.x = (unsigned)w0; wsg.y = (unsigned)w1; }
            unsigned char* mrow = (unsigned char*)mixed + (size_t)m * D;
            *(u32x2*)(mrow + 8 * lane) = wa;
            *(u32x2*)(mrow + 512 + 8 * lane) = wsg; }
    }
}

__device__ __forceinline__ float wave_max_bcast(float v) {
    const float ninf = -INFINITY;
    v = fmaxf(v, dpp_f<0x111>(ninf, v)); v = fmaxf(v, dpp_f<0x112>(ninf, v)); v = fmaxf(v, dpp_f<0x114>(ninf, v)); v = fmaxf(v, dpp_f<0x118>(ninf, v));
    v = fmaxf(v, dpp_f<0x142, 0xa>(ninf, v)); v = fmaxf(v, dpp_f<0x143, 0xc>(ninf, v));
    return __builtin_bit_cast(float, __builtin_amdgcn_readlane(__builtin_bit_cast(int, v), 63));
}
__device__ __forceinline__ void router_topk(Frame& F, int tile) {
    const float* logits = WSP(F, WS_B, float); const float* br = F.a->in[I_BR];
    int* tk_e = WSP(F, WS_TOPK_E, int); float* tk_g = WSP(F, WS_TOPK_G, float); int* tk_p = WSP(F, WS_TOPK_P, int);
    int* gcnt = (int*)(F.a->ws + WS_CTL + CTL_CNT);
    LAS int* hist = (LAS int*)F.lds; LAS int* base = hist + 256;
    const int lane = F.lane, w = F.wave;
    if (F.tid < 256) hist[F.tid] = 0;
    __syncthreads();
    const f32x4 bias = *(const f32x4*)(br + 4 * lane);
    f32x4 lgn = *(const f32x4*)(logits + (size_t)(tile * 256 + w * 32) * 256 + 4 * lane);
    int pe = 0, pp = 0; float pg = 0.f;
    int* dumpi = (int*)(F.a->ws + WS_B + ((size_t)128 << 20));
    for (int i = 0; i < 32; ++i) {
        const int tok = tile * 256 + w * 32 + i;
        const f32x4 lg = lgn;
        {
          const bool real = lane < 8 && i > 0; const size_t o = (size_t)(tok - 1) * 8 + lane;
          int* de = real ? tk_e + o : dumpi + lane; float* dg = real ? tk_g + o : (float*)dumpi + 64 + lane; int* dp = real ? tk_p + o : dumpi + 128 + lane;
          *de = pe; *dg = pg; *dp = pp; }
        lgn = *(const f32x4*)(logits + (size_t)(i + 1 < 32 ? tok + 1 : tok) * 256 + 4 * lane);
        float sc[4], ch[4];
#pragma unroll
        for (int j = 0; j < 4; ++j) { sc[j] = fast_rcp(1.f + fast_exp2(-lg[j] * LOG2E)); ch[j] = sc[j] + bias[j]; }
        float t1 = fmaxf(ch[0], ch[1]), t2 = fminf(ch[0], ch[1]);
        { const float a = fmaxf(ch[2], ch[3]), b = fminf(ch[2], ch[3]); const float n1 = fmaxf(t1, a), n2 = fmaxf(fminf(t1, a), fmaxf(t2, b)); t1 = n1; t2 = n2; }
        { const float a = dpp_f<0xB1>(t1, t1), b = dpp_f<0xB1>(t2, t2); const float n1 = fmaxf(t1, a), n2 = fmaxf(fminf(t1, a), fmaxf(t2, b)); t1 = n1; t2 = n2; }
        { const float a = dpp_f<0x4E>(t1, t1), b = dpp_f<0x4E>(t2, t2); const float n1 = fmaxf(t1, a), n2 = fmaxf(fminf(t1, a), fmaxf(t2, b)); t1 = n1; t2 = n2; }
        { const float a = dpp_f<0x141>(t1, t1), b = dpp_f<0x141>(t2, t2); const float n1 = fmaxf(t1, a), n2 = fmaxf(fminf(t1, a), fmaxf(t2, b)); t1 = n1; t2 = n2; }
        const float gs = t1 + t2; int ngt = 0;
#pragma unroll
        for (int j = 0; j < 8; ++j) { const float o = __builtin_bit_cast(float, __builtin_amdgcn_readlane(__builtin_bit_cast(int, gs), 8 * j)); ngt += (o > gs) ? 1 : 0; }
        const bool keep = ngt < 4;
#pragma unroll
        for (int j = 0; j < 4; ++j) ch[j] = keep ? ch[j] : -INFINITY;
        unsigned a0, a1, a2, a3;
        { unsigned kb_[4];
#pragma unroll
          for (int j = 0; j < 4; ++j) { const unsigned bts = __builtin_bit_cast(unsigned, ch[j]); kb_[j] = (bts & 0x80000000u) ? ~bts : (bts | 0x80000000u); }
          a0 = kb_[0]; a1 = kb_[1]; a2 = kb_[2]; a3 = kb_[3]; }
        float s0 = sc[0], s1 = sc[1], s2 = sc[2], s3 = sc[3]; int i0 = 0, i1 = 1, i2 = 2, i3 = 3;
#define TK_CE(x, y) do { const bool sw_ = a##y > a##x; const unsigned ta_ = sw_ ? a##y : a##x, tb_ = sw_ ? a##x : a##y; const float ts_ = sw_ ? s##y : s##x, tt_ = sw_ ? s##x : s##y; \
        const int ti_ = sw_ ? i##y : i##x, tj_ = sw_ ? i##x : i##y; a##x = ta_; a##y = tb_; s##x = ts_; s##y = tt_; i##x = ti_; i##y = tj_; } while (0)
        TK_CE(0, 1); TK_CE(2, 3); TK_CE(0, 2); TK_CE(1, 3); TK_CE(1, 2);
#undef TK_CE
        int my_e = 0; float my_s = 0.f;
#pragma unroll 2
        for (int k = 0; k < 8; ++k) {
            unsigned mv = a0;
#define TK_MX(ctrl, rm, bc) mv = __builtin_elementwise_max(mv, (unsigned)__builtin_amdgcn_update_dpp(0, (int)mv, ctrl, rm, 0xf, bc))
            TK_MX(0x111, 0xf, true); TK_MX(0x112, 0xf, true); TK_MX(0x114, 0xf, true); TK_MX(0x118, 0xf, true); TK_MX(0x142, 0xa, false); TK_MX(0x143, 0xc, false);
#undef TK_MX
            const unsigned M = (unsigned)__builtin_amdgcn_readlane((int)mv, 63);
            const unsigned long long hit = __ballot(a0 == M);
            const int owner = __builtin_ctzll(hit);
            const int be = __builtin_amdgcn_readlane(4 * lane + i0, owner);
            const float bsc = __builtin_bit_cast(float, __builtin_amdgcn_readlane(__builtin_bit_cast(int, s0), owner));
            if (lane == k) { my_e = be; my_s = bsc; }
            const bool own = lane == owner;
            a0 = own ? a1 : a0; a1 = own ? a2 : a1; a2 = own ? a3 : a2; a3 = own ? 0u : a3;
            s0 = own ? s1 : s0; s1 = own ? s2 : s1; s2 = own ? s3 : s2;
            i0 = own ? i1 : i0; i1 = own ? i2 : i1; i2 = own ? i3 : i2;
        }
        float ssum = my_s;
        ssum += dpp_f<0xB1>(0.f, ssum); ssum += dpp_f<0x4E>(0.f, ssum); ssum += dpp_f<0x141>(0.f, ssum);
        if (lane < 8) { pp = __hip_atomic_fetch_add(&hist[my_e], 1, __ATOMIC_RELAXED, __HIP_MEMORY_SCOPE_WORKGROUP); pe = my_e; pg = my_s / ssum * 2.5f; }
    }
    if (lane < 8) { const int tok = tile * 256 + w * 32 + 31; tk_e[(size_t)tok * 8 + lane] = pe; tk_g[(size_t)tok * 8 + lane] = pg; tk_p[(size_t)tok * 8 + lane] = pp; }
    __syncthreads();
    const int chunk = (tile * 256) / CHT;
    if (F.tid < 256) { const int c = hist[F.tid]; base[F.tid] = c > 0 ? atomicAdd(&gcnt[chunk * NE + F.tid], c) : 0; }
    __syncthreads();
    {
      const size_t e0 = (size_t)(tile * 256 + w * 32) * 8 + 4 * lane;
      const i32x4 e4 = *(const i32x4*)(tk_e + e0); i32x4 p4 = *(const i32x4*)(tk_p + e0);
      p4.x += base[e4.x]; p4.y += base[e4.y]; p4.z += base[e4.z]; p4.w += base[e4.w];
      *(i32x4*)(tk_p + e0) = p4; }
    __syncthreads();
}

__device__ __forceinline__ void phase_dispatch(Frame& F) {
    const int* gcnt = (const int*)(F.a->ws + WS_CTL + CTL_CNT);
    LAS int* off = (LAS int*)F.lds;
    LAS int* tst = off + NCH * NE;
    LAS int* cnt = tst + NCH * NE;
    LAS int* ntl = cnt + NCH * NE;
    for (int i = F.tid; i < NCH * NE; i += NTHR) cnt[i] = gcnt[i];
    __syncthreads();
    if (F.wave < NCH) {
        const int c = F.wave; int cv[4], tv[4], so = 0, st = 0;
#pragma unroll
        for (int j = 0; j < 4; ++j) { cv[j] = cnt[c * NE + 4 * F.lane + j]; tv[j] = (cv[j] + 255) >> 8; so += cv[j]; st += tv[j]; }
        int io = so, it = st;
#define ISCAN(v) do { v += __builtin_amdgcn_update_dpp(0, v, 0x111, 0xf, 0xf, false); v += __builtin_amdgcn_update_dpp(0, v, 0x112, 0xf, 0xf, false); v += __builtin_amdgcn_update_dpp(0, v, 0x114, 0xf, 0xf, false); \
        v += __builtin_amdgcn_update_dpp(0, v, 0x118, 0xf, 0xf, false); v += __builtin_amdgcn_update_dpp(0, v, 0x142, 0xa, 0xf, false); v += __builtin_amdgcn_update_dpp(0, v, 0x143, 0xc, 0xf, false); } while (0)
        ISCAN(io); ISCAN(it);
#undef ISCAN
        int o = io - so, t = it - st;
#pragma unroll
        for (int j = 0; j < 4; ++j) { off[c * NE + 4 * F.lane + j] = o; tst[c * NE + 4 * F.lane + j] = t; o += cv[j]; t += tv[j]; }
        if (F.lane == 63) ntl[c] = it;
    }
    __syncthreads();
    int* te = WSP(F, WS_TILE, int); int* trow0 = te + NCH * MAXTILES; int* tnv = trow0 + NCH * MAXTILES; int* ntiles = tnv + NCH * MAXTILES;
    if (blockIdx.x < NCH) { const int c = blockIdx.x;
        for (int e = F.tid; e < NE; e += NTHR) { const int n = cnt[c * NE + e], t0 = tst[c * NE + e], o = off[c * NE + e];
            for (int m = 0; m * 256 < n; ++m) { te[c * MAXTILES + t0 + m] = e; trow0[c * MAXTILES + t0 + m] = o + 256 * m; tnv[c * MAXTILES + t0 + m] = (n - 256 * m) < 256 ? (n - 256 * m) : 256; } }
        const int nr = ntl[c];
        for (int m = F.tid; m < CHT / 256; m += NTHR) { te[c * MAXTILES + nr + m] = NE; trow0[c * MAXTILES + nr + m] = CH_ROUTED + 256 * m; tnv[c * MAXTILES + nr + m] = 256; }
        if (F.tid == 0) ntiles[c] = nr + CHT / 256;
    }
    const int* tk_e = WSP(F, WS_TOPK_E, int); int* tk_p = WSP(F, WS_TOPK_P, int);
    int* rowtok = WSP(F, WS_ROWTOK, int);
    {
      constexpr int NIT = NTOK * 8 / (256 * NTHR);
      const int a0 = blockIdx.x * NTHR + F.tid, st = F.G * NTHR;
      if (F.G * NTHR * NIT == NTOK * 8) {
          int ev[NIT], pv[NIT];
#pragma unroll
          for (int k = 0; k < NIT; ++k) { ev[k] = tk_e[a0 + k * st]; pv[k] = tk_p[a0 + k * st]; }
#pragma unroll
          for (int k = 0; k < NIT; ++k) { const int a = a0 + k * st, tok = a >> 3, c = tok / CHT; const int slot = off[c * NE + ev[k]] + pv[k];
              rowtok[(size_t)c * CH_ROUTED + slot] = tok; tk_p[a] = slot; }
      } else {
          for (int a = a0; a < NTOK * 8; a += st) { const int tok = a >> 3, c = tok / CHT;
              const int e = tk_e[a], slot = off[c * NE + e] + tk_p[a];
              rowtok[(size_t)c * CH_ROUTED + slot] = tok; tk_p[a] = slot; }
      }
    }
    __syncthreads();
}

__device__ __forceinline__ void phase_combine(Frame& F, int chunk) {
    const unsigned char* Y = WSP(F, WS_B, unsigned char); const int* slot = WSP(F, WS_TOPK_P, int); const float* tkg = WSP(F, WS_TOPK_G, float);
    const float* mod = WSP(F, WS_MOD, float); const float* gf = F.a->in[I_GFIN];
    const int lane = F.lane, gw = F.vcu * 8 + F.wave, NGW = F.G * 8, c0 = 16 * lane;
    typedef float f32x2 __attribute__((ext_vector_type(2)));
    typedef int i32x4 __attribute__((ext_vector_type(4)));
    int mi = gw;
    if (mi >= CHT) return;
    f32x4 gfv[4];
#pragma unroll
    for (int i = 0; i < 4; ++i) gfv[i] = *(const f32x4*)(gf + c0 + 4 * i);
    i32x4 rn0, rn1; f32x4 gn0, gn1;
    { const size_t m = (size_t)chunk * CHT + mi; rn0 = *(const i32x4*)(slot + m * 8); rn1 = *(const i32x4*)(slot + m * 8 + 4); gn0 = *(const f32x4*)(tkg + m * 8); gn1 = *(const f32x4*)(tkg + m * 8 + 4); }
#pragma unroll 1
    for (; mi < CHT; mi += NGW) { const int m = chunk * CHT + mi, b = m / SEQ;
        const i32x4 r0 = rn0, r1 = rn1; const f32x4 g0 = gn0 * (1.f / YSCALE), g1 = gn1 * (1.f / YSCALE);
        u32x4 yv[9];
        yv[0] = __builtin_nontemporal_load((const u32x4*)(Y + (size_t)r0.x * D + c0)); yv[1] = __builtin_nontemporal_load((const u32x4*)(Y + (size_t)r0.y * D + c0)); yv[2] = __builtin_nontemporal_load((const u32x4*)(Y + (size_t)r0.z * D + c0)); yv[3] = __builtin_nontemporal_load((const u32x4*)(Y + (size_t)r0.w * D + c0));
        yv[4] = __builtin_nontemporal_load((const u32x4*)(Y + (size_t)r1.x * D + c0)); yv[5] = __builtin_nontemporal_load((const u32x4*)(Y + (size_t)r1.y * D + c0)); yv[6] = __builtin_nontemporal_load((const u32x4*)(Y + (size_t)r1.z * D + c0)); yv[7] = __builtin_nontemporal_load((const u32x4*)(Y + (size_t)r1.w * D + c0));
        yv[8] = __builtin_nontemporal_load((const u32x4*)(Y + (size_t)(CH_ROUTED + mi) * D + c0));
        float* hrow = F.a->out + (size_t)m * D;
        f32x4 g2v[4];
#pragma unroll
        for (int i = 0; i < 4; ++i) g2v[i] = *(const f32x4*)(mod + b * 6144 + 5120 + c0 + 4 * i);
        f32x4 hv[4];
        { const bf16_t* hb = h_row(F.a->out, F.a->ws, m) + c0; const u32x4 ha = __builtin_nontemporal_load((const u32x4*)hb), hc = __builtin_nontemporal_load((const u32x4*)(hb + 8));
          hv[0] = (f32x4){bflo(ha.x), bfhi(ha.x), bflo(ha.y), bfhi(ha.y)}; hv[1] = (f32x4){bflo(ha.z), bfhi(ha.z), bflo(ha.w), bfhi(ha.w)};
          hv[2] = (f32x4){bflo(hc.x), bfhi(hc.x), bflo(hc.y), bfhi(hc.y)}; hv[3] = (f32x4){bflo(hc.z), bfhi(hc.z), bflo(hc.w), bfhi(hc.w)}; }
        if (mi + NGW < CHT) { const size_t mn = (size_t)m + NGW; rn0 = *(const i32x4*)(slot + mn * 8); rn1 = *(const i32x4*)(slot + mn * 8 + 4); gn0 = *(const f32x4*)(tkg + mn * 8); gn1 = *(const f32x4*)(tkg + mn * 8 + 4); }
        const float gk[9] = {g0.x, g0.y, g0.z, g0.w, g1.x, g1.y, g1.z, g1.w, 1.f / YSCALE};
        f32x4 acc[4];
#pragma unroll
        for (int i = 0; i < 4; ++i) acc[i] = (f32x4){0.f, 0.f, 0.f, 0.f};
#pragma unroll
        for (int k = 0; k < 9; ++k)
#pragma unroll
            for (int i = 0; i < 4; ++i) { const f32x2 lo = __builtin_amdgcn_cvt_pk_f32_fp8((int)yv[k][i], false), hi = __builtin_amdgcn_cvt_pk_f32_fp8((int)yv[k][i], true);
                acc[i].x += gk[k] * lo.x; acc[i].y += gk[k] * lo.y; acc[i].z += gk[k] * hi.x; acc[i].w += gk[k] * hi.y; }
        float sq = 0.f;
#pragma unroll
        for (int i = 0; i < 4; ++i) { const f32x4 g2 = g2v[i];
            hv[i] = hv[i] + g2 * acc[i];
            sq += (hv[i].x * hv[i].x + hv[i].y * hv[i].y) + (hv[i].z * hv[i].z + hv[i].w * hv[i].w); }
        const float rs = 1.f / sqrtf(wave_sum(sq) * (1.f / D) + EPS);
#pragma unroll
        for (int i = 0; i < 4; ++i) *(f32x4*)(hrow + c0 + 4 * i) = hv[i] * rs * gfv[i];
    }
}

constexpr int N_PHASES = 9 + 3 * NCH;
#ifndef REP_MASK
#define REP_MASK 0u
#endif
#define NREP(k) (1 + (int)((REP_MASK >> (k)) & 1u))
#ifndef PROBE_KIND
#define PROBE_KIND 0
#endif
__global__ void __launch_bounds__(NTHR, 2) hybrid_fwd(Args args) {
    extern __shared__ __attribute__((aligned(16))) unsigned char lds_raw[];
    LAS unsigned char* const lds = (LAS unsigned char*)lds_raw;
    volatile LAS unsigned* MISC = (volatile LAS unsigned*)(lds + MISC_OFF);
    if (threadIdx.x < 64) MISC[threadIdx.x] = 0u;
    __syncthreads();
    XcdBarrier bar; bar.bar = (unsigned*)(args.ws + WS_CTL); bar.x = 0; bar.st = nullptr;
    const int lo = args.ph_lo, hi = args.ph_hi;
    if (hi - lo > 1) bar = xcd_barrier_post((unsigned*)(args.ws + WS_CTL), MISC + 8);
#define IN(k) (lo <= (k) && (k) < hi)
#define SEAM(k) do { if (IN(k) && IN((k) + 1)) xcd_barrier(bar); } while (0)

    if (IN(0)) { for (int rep = 0; rep < NREP(0); ++rep) { Frame F = make_frame(lds); phase_mod(F); } } SEAM(0);
    if (IN(1)) { for (int rep = 0; rep < NREP(1); ++rep) { Frame F = make_frame(lds); phase_prep(F); } } SEAM(1);
    if (IN(2)) for (int rep = 0; rep < NREP(2); ++rep) {
        const bool conv_first = (blockIdx.x >> 3) & 1;
        if (conv_first && rep == 0) { Frame F = make_frame(lds); convert_experts(F, 0, CONV_ITEMS); }
        { Frame F = make_frame(lds);
        pg8::DenseSched<512> S; S.init(F.a->ws + WS_A, F.a->ws + WS_WTIN, NTOK, NPROJ, F.G, (int)blockIdx.x, F.tid);
        EpiBf16T<true> E{WSP(F, WS_B, bf16_t), NPROJ};
        pg8::gemm_phase<512, EpiBf16T<true>, pg8::DenseSched<512>, true, true>(F.lds, F.tid, S, E); }
        if (!conv_first && rep == 0) { Frame F = make_frame(lds); convert_experts(F, 0, CONV_ITEMS); }
    } SEAM(2);
    if (IN(3)) { for (int rep = 0; rep < NREP(3); ++rep) { Frame F = make_frame(lds); phase_attn(F); } for (int rep = 0; rep < NREP(21); ++rep) { Frame F = make_frame(lds); phase_sgu(F); } } SEAM(3);
    if (IN(4)) { for (int rep = 0; rep < NREP(4); ++rep) { Frame F = make_frame(lds); phase_merge(F); } } SEAM(4);
    if (IN(5)) for (int rep = 0; rep < NREP(5); ++rep) {
        Frame F = make_frame(lds);
        pg8::DenseSched<512> S; S.init(F.a->ws + WS_A, F.a->ws + WS_WTOUT, NTOK, D, F.G, (int)blockIdx.x, F.tid);
        EpiResH E{F.a->in[I_X], WSP(F, WS_MOD, float) + 2048, F.a->out, F.a->ws};
        pg8::gemm_phase<512, EpiResH, pg8::DenseSched<512>, true, true>(F.lds, F.tid, S, E);
    } SEAM(5);
    if (IN(7)) {
        Frame F = make_frame(lds);
        pg8::DenseSched<1024> S; S.init(F.a->ws + WS_A, F.a->ws + WS_WTR, NTOK, NE, F.G, (int)blockIdx.x, F.tid);
        { const float* mod = WSP(F, WS_MOD, float); bf16_t* n2 = WSP(F, WS_A, bf16_t); Unit u0;
          for (int i = 0; S.next(i, u0); ++i) for (int r = 8 * F.wave; r < 256; r += 64) { const int m = u0.t * 256 + r, b = m / SEQ;
              norm_mod_rows<8, true>(h_row(F.a->out, F.a->ws, m), D, F.a->in[I_GFFN], mod + b * 6144 + 3072, mod + b * 6144 + 4096, n2 + (size_t)m * D, D, F.lane, WSP(F, WS_N2F8, unsigned char) + (size_t)m * D); }
          asm volatile("s_waitcnt vmcnt(0)" ::: "memory"); __syncthreads(); }
        EpiF32 E{WSP(F, WS_B, float), NE};
        pg8::gemm_phase<1024, EpiF32, pg8::DenseSched<1024>, true, true>(F.lds, F.tid, S, E);
        asm volatile("s_waitcnt vmcnt(0)" ::: "memory"); __syncthreads();
        Unit u; for (int i = 0; S.next(i, u); ++i) router_topk(F, u.t);
    } SEAM(7);
    if (IN(8)) { Frame F = make_frame(lds); phase_dispatch(F); } SEAM(8);
    const bool comb_late = (blockIdx.x >> 4) & 1;
#pragma unroll
    for (int c = 0; c < NCH; ++c) {
        if (IN(9 + 3 * c)) for (int rep = 0; rep < NREP(9); ++rep) {
            Frame F = make_frame(lds);
            const int* te = WSP(F, WS_TILE, int);
            TileTabs T; T.te = te + c * MAXTILES; T.trow0 = te + NCH * MAXTILES + c * MAXTILES; T.tnv = te + 2 * NCH * MAXTILES + c * MAXTILES;
            T.ntiles = __builtin_amdgcn_readfirstlane((te + 3 * NCH * MAXTILES)[c]);
            Gemm1Sched S; S.init(F.lds, F.a->ws + WS_N2F8, F.a->ws + WS_W1T, WSP(F, WS_ROWTOK, int) + (size_t)c * CH_ROUTED, T, c, F.tid);
            EpiAct E{WSP(F, WS_ACT, unsigned char)};
            pg8::gemm_phase<512, EpiAct, Gemm1Sched, true, true>(F.lds, F.tid, S, E, (NREP(9) > 1 && rep == 0) ? PROBE_KIND : 0);
        }
        if (c > 0 && comb_late && IN(11 + 3 * (c - 1))) { Frame F = make_frame(lds); phase_combine(F, c - 1); }
        SEAM(9 + 3 * c);
        if (IN(10 + 3 * c)) for (int rep = 0; rep < NREP(10); ++rep) {
            Frame F = make_frame(lds);
            const int* te = WSP(F, WS_TILE, int);
            TileTabs T; T.te = te + c * MAXTILES; T.trow0 = te + NCH * MAXTILES + c * MAXTILES; T.tnv = te + 2 * NCH * MAXTILES + c * MAXTILES;
            T.ntiles = __builtin_amdgcn_readfirstlane((te + 3 * NCH * MAXTILES)[c]);
            Gemm2Sched S; S.init(F.lds, F.a->ws + WS_ACT, F.a->ws + WS_W2T, nullptr, T, c, F.tid);
            EpiDown E{WSP(F, WS_B, unsigned char), F.lds, (NREP(10) > 1 && rep == 0 && (PROBE_KIND & 4)) ? 1 : 0};
            pg8::gemm_phase<128, EpiDown, Gemm2Sched, true, true>(F.lds, F.tid, S, E, (NREP(10) > 1 && rep == 0) ? PROBE_KIND : 0);
        } SEAM(10 + 3 * c);
        if (IN(11 + 3 * c) && !(c + 1 < NCH && comb_late)) { Frame F = make_frame(lds); phase_combine(F, c); }
    }
#undef IN
#undef SEAM
}

extern "C" void kernel_launch(void* const* d_in, const int* in_sizes, int n_in, void* d_out, int out_size, void* d_ws, size_t ws_size, hipStream_t stream) {
    static int grid = 0;
    if (grid == 0) {
        if (n_in != 23 || out_size != NTOK * D || ws_size < WS_END) { fprintf(stderr, "kernel_launch: unexpected shapes (n_in %d out %d ws %zu need %zu)\n", n_in, out_size, ws_size, (size_t)WS_END); grid = -1; return; }
        int dev = 0, cus = 0, per_cu = 0;
        if (hipGetDevice(&dev) != hipSuccess || hipDeviceGetAttribute(&cus, hipDeviceAttributeMultiprocessorCount, dev) != hipSuccess) { grid = -1; return; }
        if (hipFuncSetAttribute((const void*)hybrid_fwd, hipFuncAttributeMaxDynamicSharedMemorySize, LDS_BYTES) != hipSuccess) { fprintf(stderr, "kernel_launch: hipFuncSetAttribute failed\n"); grid = -1; return; }
        if (hipOccupancyMaxActiveBlocksPerMultiprocessor(&per_cu, (const void*)hybrid_fwd, NTHR, LDS_BYTES) != hipSuccess || per_cu < 1) fprintf(stderr, "kernel_launch: occupancy query says %d\n", per_cu);
        (void)hipGetLastError();
        grid = cus & ~7;
        if (grid <= 0) { grid = -1; return; }
    }
    if (grid < 0) return;
    if (hipMemsetAsync((char*)d_ws + WS_CTL, 0, CTL_BYTES, stream) != hipSuccess) return;
    Args a{};
    for (int i = 0; i < 23; ++i) a.in[i] = (const float*)d_in[i];
    a.out = (float*)d_out; a.ws = (unsigned char*)d_ws;
#if MK_MULTI
    for (int p = 0; p < N_PHASES; ++p) { a.ph_lo = p; a.ph_hi = p + 1; hipLaunchKernelGGL(hybrid_fwd, dim3(grid), dim3(NTHR), LDS_BYTES, stream, a); }
#else
    a.ph_lo = 0; a.ph_hi = N_PHASES;
    hipLaunchKernelGGL(hybrid_fwd, dim3(grid), dim3(NTHR), LDS_BYTES, stream, a);
#endif
    const hipError_t le = hipPeekAtLastError();
    if (le != hipSuccess) fprintf(stderr, "kernel_launch: launch failed: %s\n", hipGetErrorName(le));
}
```
